# Optimizing an MI355X kernel written in HIP

```python
import jax, jax.numpy as jnp
from jax import lax
import numpy as np

D_MODEL = 1024
BATCH = 2
SEQ = 8192
DEPTH = 4

SWA_HEADS = 8
SWA_KV_HEADS = 2
SWA_HEAD_DIM = 64
SWA_WINDOW = 128
SWA_BLOCK = 128
ROPE_THETA = 10000.0
GLA_HEADS = 4
GLA_DK = D_MODEL // 2 // GLA_HEADS
GLA_DV = D_MODEL // GLA_HEADS
GLA_GATE_RANK = 16
GLA_TAU = 16.0
GLA_CHUNK = 64
D_FF = 2816
EPS = 1e-6

SWA_Q_W = SWA_HEADS * SWA_HEAD_DIM
SWA_KV_W = SWA_KV_HEADS * SWA_HEAD_DIM
GLA_K_W = GLA_HEADS * GLA_DK
GLA_V_W = GLA_HEADS * GLA_DV
IN_SPLITS = (SWA_Q_W, SWA_KV_W, SWA_KV_W, GLA_K_W, GLA_K_W, GLA_V_W, GLA_V_W, GLA_GATE_RANK, D_MODEL, D_MODEL)
IN_COLS = sum(IN_SPLITS)

kernel_name = "hybrid_swa_sink_gla_macaron"


def rmsnorm(x, g):
    xf = x.astype(jnp.float32)
    y = xf * lax.rsqrt(jnp.mean(xf * xf, axis=-1, keepdims=True) + EPS)
    return (y * g.astype(jnp.float32)).astype(x.dtype)


def swiglu(h, w_gate, w_up, w_down):
    return (jax.nn.silu(h @ w_gate) * (h @ w_up)) @ w_down


def split_cols(z, sizes):
    idx = np.cumsum(np.array(sizes))[:-1].tolist()
    return jnp.split(z, idx, axis=-1)


def rope_tables(T):
    inv_freq = ROPE_THETA ** (-jnp.arange(0, SWA_HEAD_DIM, 2, dtype=jnp.float32) / SWA_HEAD_DIM)
    ang = jnp.arange(T, dtype=jnp.float32)[:, None] * inv_freq[None, :]
    return jnp.cos(ang), jnp.sin(ang)


def apply_rope(x, cos, sin):
    x1, x2 = jnp.split(x, 2, axis=-1)
    c = cos[None, :, None, :]
    s = sin[None, :, None, :]
    return jnp.concatenate([x1 * c - x2 * s, x2 * c + x1 * s], axis=-1)


def swa_attention(q, k, v, q_gain, k_gain, sinks, cos, sin):
    B, T = q.shape[0], q.shape[1]
    G = SWA_HEADS // SWA_KV_HEADS
    nb = T // SWA_BLOCK
    q = apply_rope(rmsnorm(q, q_gain).astype(jnp.float32), cos, sin)
    k = apply_rope(rmsnorm(k, k_gain).astype(jnp.float32), cos, sin)
    v = v.astype(jnp.float32)
    q = q.reshape(B, nb, SWA_BLOCK, SWA_KV_HEADS, G, SWA_HEAD_DIM)
    k = k.reshape(B, nb, SWA_BLOCK, SWA_KV_HEADS, SWA_HEAD_DIM)
    v = v.reshape(B, nb, SWA_BLOCK, SWA_KV_HEADS, SWA_HEAD_DIM)

    def band(t):
        prev = jnp.pad(t[:, :-1], ((0, 0), (1, 0), (0, 0), (0, 0), (0, 0)))
        return jnp.concatenate([prev, t], axis=2)

    kb, vb = band(k), band(v)
    s = jnp.einsum('bnqhgd,bnkhd->bnhgqk', q, kb) * (SWA_HEAD_DIM ** -0.5)
    i = jnp.arange(SWA_BLOCK)[:, None]
    j = jnp.arange(2 * SWA_BLOCK)[None, :]
    rel = i + SWA_BLOCK - j
    blk = jnp.arange(nb)[:, None, None]
    valid = (rel >= 0) & (rel < SWA_WINDOW) & ((blk > 0) | (j >= SWA_BLOCK))
    s = jnp.where(valid[None, :, None, None], s, -jnp.inf)
    sink = sinks.astype(jnp.float32).reshape(1, 1, SWA_KV_HEADS, G, 1, 1)
    m = jnp.maximum(jnp.max(s, axis=-1, keepdims=True), sink)
    p = jnp.exp(s - m)
    denom = jnp.sum(p, axis=-1, keepdims=True) + jnp.exp(sink - m)
    o = jnp.einsum('bnhgqk,bnkhd->bnqhgd', p / denom, vb)
    return o.reshape(B, T, SWA_Q_W)


def gla_attention(q, k, v, log_a):
    B, T = q.shape[0], q.shape[1]
    nc = T // GLA_CHUNK

    def chunks(t, d):
        return t.astype(jnp.float32).reshape(B, nc, GLA_CHUNK, GLA_HEADS, d).transpose(1, 0, 3, 2, 4)

    qc = chunks(q, GLA_DK) * (GLA_DK ** -0.5)
    kc = chunks(k, GLA_DK)
    vc = chunks(v, GLA_DV)
    gc = chunks(log_a, GLA_DK)
    causal = jnp.tril(jnp.ones((GLA_CHUNK, GLA_CHUNK), dtype=bool))[:, :, None]

    def step(S, inp):
        qi, ki, vi, gi = inp
        b = jnp.cumsum(gi, axis=-2)
        b_last = b[:, :, -1:, :]
        o_inter = jnp.einsum('bhtc,bhcv->bhtv', qi * jnp.exp(b), S)
        diff = b[:, :, :, None, :] - b[:, :, None, :, :]
        decay = jnp.exp(jnp.where(causal, diff, -jnp.inf))
        attn = jnp.einsum('bhtsc,bhsc->bhts', qi[:, :, :, None, :] * decay, ki)
        o_intra = jnp.einsum('bhts,bhsv->bhtv', attn, vi)
        S = jnp.exp(b_last[:, :, 0, :])[..., None] * S + jnp.einsum('bhsc,bhsv->bhcv', ki * jnp.exp(b_last - b), vi)
        return S, o_inter + o_intra

    S0 = jnp.zeros((B, GLA_HEADS, GLA_DK, GLA_DV), jnp.float32)
    _, o = lax.scan(step, S0, (qc, kc, vc, gc))
    return o.transpose(1, 0, 3, 2, 4).reshape(B, T, GLA_HEADS, GLA_DV)


def setup_inputs(seed: int = 0) -> dict:
    key = jax.random.key(seed)
    ks = jax.random.split(key, 24)
    L, D = DEPTH, D_MODEL

    def w(k, shape, fan_in):
        return jax.random.normal(k, shape, jnp.float32) * (fan_in ** -0.5)

    def gain(k, shape):
        return 1.0 + 0.02 * jax.random.normal(k, shape, jnp.float32)

    return {
        "x": jax.random.normal(ks[0], (BATCH, SEQ, D), jnp.float32),
        "ffn1_norm": gain(ks[1], (L, D)),
        "ffn1_w_gate": w(ks[2], (L, D, D_FF), D),
        "ffn1_w_up": w(ks[3], (L, D, D_FF), D),
        "ffn1_w_down": w(ks[4], (L, D_FF, D), D_FF),
        "mix_norm": gain(ks[5], (L, D)),
        "w_in": w(ks[6], (L, D, IN_COLS), D),
        "swa_q_norm": gain(ks[7], (L, SWA_HEAD_DIM)),
        "swa_k_norm": gain(ks[8], (L, SWA_HEAD_DIM)),
        "swa_sinks": 0.5 * jax.random.normal(ks[9], (L, SWA_HEADS), jnp.float32),
        "gla_w_gate": w(ks[10], (L, GLA_GATE_RANK, GLA_K_W), GLA_GATE_RANK),
        "gla_gate_bias": 0.1 * jax.random.normal(ks[11], (L, GLA_K_W), jnp.float32),
        "gla_out_norm": gain(ks[12], (L, GLA_V_W)),
        "w_proj_a": w(ks[13], (L, SWA_Q_W, D), SWA_Q_W),
        "w_proj_b": w(ks[14], (L, GLA_V_W, D), GLA_V_W),
        "w_out": w(ks[15], (L, D, D), D),
        "ffn2_norm": gain(ks[16], (L, D)),
        "ffn2_w_gate": w(ks[17], (L, D, D_FF), D),
        "ffn2_w_up": w(ks[18], (L, D, D_FF), D),
        "ffn2_w_down": w(ks[19], (L, D_FF, D), D_FF),
    }


def reference(x, ffn1_norm, ffn1_w_gate, ffn1_w_up, ffn1_w_down, mix_norm, w_in,
              swa_q_norm, swa_k_norm, swa_sinks, gla_w_gate, gla_gate_bias, gla_out_norm,
              w_proj_a, w_proj_b, w_out, ffn2_norm, ffn2_w_gate, ffn2_w_up, ffn2_w_down):
    B, T = x.shape[0], x.shape[1]
    cos, sin = rope_tables(T)
    for l in range(DEPTH):
        h = rmsnorm(x, ffn1_norm[l])
        x = x + 0.5 * swiglu(h, ffn1_w_gate[l], ffn1_w_up[l], ffn1_w_down[l])

        h = rmsnorm(x, mix_norm[l])
        z = h @ w_in[l]
        q_a, k_a, v_a, q_b, k_b, v_b, r_b, g_lr, gate_a, gate_b = split_cols(z, IN_SPLITS)

        o_a = swa_attention(q_a.reshape(B, T, SWA_HEADS, SWA_HEAD_DIM),
                            k_a.reshape(B, T, SWA_KV_HEADS, SWA_HEAD_DIM),
                            v_a.reshape(B, T, SWA_KV_HEADS, SWA_HEAD_DIM),
                            swa_q_norm[l], swa_k_norm[l], swa_sinks[l], cos, sin).astype(x.dtype)

        log_a = jax.nn.log_sigmoid((g_lr @ gla_w_gate[l] + gla_gate_bias[l]).astype(jnp.float32)) / GLA_TAU
        o_b = gla_attention(q_b.reshape(B, T, GLA_HEADS, GLA_DK),
                            k_b.reshape(B, T, GLA_HEADS, GLA_DK),
                            v_b.reshape(B, T, GLA_HEADS, GLA_DV),
                            log_a.reshape(B, T, GLA_HEADS, GLA_DK))
        o_b = rmsnorm(o_b, gla_out_norm[l].reshape(GLA_HEADS, GLA_DV)).reshape(B, T, GLA_V_W).astype(x.dtype)
        o_b = o_b * jax.nn.silu(r_b)

        y_a = o_a @ w_proj_a[l]
        y_b = o_b @ w_proj_b[l]
        merged = jax.nn.sigmoid(gate_a) * y_a + jax.nn.sigmoid(gate_b) * y_b
        x = x + merged @ w_out[l]

        h = rmsnorm(x, ffn2_norm[l])
        x = x + 0.5 * swiglu(h, ffn2_w_gate[l], ffn2_w_up[l], ffn2_w_down[l])
    return x
```

```cpp
#include <hip/hip_runtime.h>
#include <hip/hip_bf16.h>
#include <cstdio>
#include <cstdint>
#include <cmath>

#ifndef DBG
#define DBG 0
#endif
#ifndef MULTI
#define MULTI 1
#endif

constexpr int BATCH = 2, SEQ = 8192, DM = 1024, DEPTH = 4, M = BATCH * SEQ;
constexpr int FF = 2816, NGU = 2 * FF;
constexpr int IN_COLS = 5904, NIN = 6144;
constexpr int QAW = 512, KVW = 128, GKW = 512, GVW = 1024;
constexpr float EPS = 1e-6f;
constexpr float LOG2E = 1.4426950408889634f;
namespace pg8 {
#define PG8_LAS __attribute__((address_space(3)))
typedef unsigned short bf16_t;
typedef short bf16x8 __attribute__((ext_vector_type(8)));
typedef float f32x4 __attribute__((ext_vector_type(4)));
typedef unsigned u32x4 __attribute__((ext_vector_type(4)));
constexpr int BM = 256, BK = 64, HALF = 128, HTB = HALF * BK * 2  , STAGE_BYTES = 8 * HTB, NXCD = 8, WGM = 8;

__host__ __device__ __forceinline__ int lds_byte(int r, int c) { const int st = (r >> 4) * 2 + (c >> 5), rr = r & 15, cc = c & 31, ob = rr * 64 + cc * 2; return st * 1024 + (ob ^ (((ob >> 9) & 1) << 5)); }
__host__ __device__ __forceinline__ void stage_rc(int b, int& R, int& C) { const int st = b / 1024, sb = b % 1024, swz = sb ^ (((sb >> 9) & 1) << 5); R = (st >> 1) * 16 + swz / 64; C = (st & 1) * 32 + (swz % 64) / 2; }
__host__ __device__ __forceinline__ int perm32(int rho) { const int n = rho >> 4, i = rho & 15; return 8 * (i >> 2) + 4 * n + (i & 3); }

struct Unit { int pm, pn; };
struct Gemm { const bf16_t* A; const bf16_t* Bt; int M, N, K; };

struct StaticOrder {
    int nM, nN, nwg, G, c;
    __host__ __device__ void init(int M, int N, int G_, int c_) { nM = M / BM; nN = N / BM; nwg = nM * nN; G = G_; c = c_; }
    __host__ __device__ bool next(int i, Unit& u) const {
        const long L = (long)i * G + c; if (L >= nwg) return false;
        int wgid = (int)L; { const int q = nwg / NXCD, r = nwg % NXCD, xcd = wgid % NXCD, off = wgid / NXCD; wgid = (xcd < r ? xcd * (q + 1) : r * (q + 1) + (xcd - r) * q) + off; }
        const int nig = WGM * nN, gid = wgid / nig, fm = gid * WGM, gsz = (nM - fm) < WGM ? (nM - fm) : WGM;
        u.pm = fm + ((wgid % nig) % gsz); u.pn = (wgid % nig) / gsz; return true;
    }
    __device__ __forceinline__ void a_ready(const Unit&) const {}
    __device__ __forceinline__ void done(const Unit&) const {}
};

typedef float f32x2 __attribute__((ext_vector_type(2)));
typedef __bf16 bf16x2v __attribute__((ext_vector_type(2)));
__device__ __forceinline__ unsigned cvt_pk_bf16(float lo, float hi) { f32x2 v = {lo, hi}; bf16x2v b = __builtin_convertvector(v, bf16x2v); return __builtin_bit_cast(unsigned, b); }
__device__ __forceinline__ float silu_f(float g) { return g * __builtin_amdgcn_rcpf(1.f + __builtin_amdgcn_exp2f(-1.4426950408889634f * g)); }
__device__ __forceinline__ float sigm_f(float g) { return __builtin_amdgcn_rcpf(1.f + __builtin_amdgcn_exp2f(-1.4426950408889634f * g)); }
__device__ __forceinline__ float bf_lo(unsigned w) { return __builtin_bit_cast(float, w << 16); }
__device__ __forceinline__ float bf_hi(unsigned w) { return __builtin_bit_cast(float, w & 0xffff0000u); }
__device__ __forceinline__ float row_rstd(const float* stats, int row) {
    const f32x4* p = (const f32x4*)(stats + (size_t)row * 16);
    const f32x4 a = p[0], b = p[1], c = p[2], d = p[3]; const f32x4 s = (a + b) + (c + d);
    return __builtin_amdgcn_rsqf(((s[0] + s[1]) + (s[2] + s[3])) * (1.0f / 1024.0f) + 1e-6f);
}
__device__ __forceinline__ u32x4 pack8(const f32x4 v0, const f32x4 v1) { u32x4 w; w.x = cvt_pk_bf16(v0[0], v0[1]); w.y = cvt_pk_bf16(v0[2], v0[3]); w.z = cvt_pk_bf16(v1[0], v1[1]); w.w = cvt_pk_bf16(v1[2], v1[3]); return w; }

struct EpiGU {
    static constexpr bool PERM = true, AFTER_DRAIN = false;
    bf16_t* H; const float* stats;
    __device__ __forceinline__ void operator()(const f32x4 (&acc)[2][2][4][2], const Unit& u, int wr, int wc, int fr, int fq) const {
        const int row0 = u.pm * BM + wr * 64 + fr, col0 = u.pn * 128 + wc * 32 + 8 * fq;
#pragma unroll
        for (int ai = 0; ai < 2; ++ai)
#pragma unroll
            for (int m = 0; m < 4; ++m) { const int row = row0 + ai * HALF + m * 16; const float rs = row_rstd(stats, row);
                f32x4 o[2];
#pragma unroll
                for (int n = 0; n < 2; ++n) { const f32x4 g = acc[ai][0][m][n] * rs, up = acc[ai][1][m][n] * rs;
#pragma unroll
                    for (int e = 0; e < 4; ++e) o[n][e] = silu_f(g[e]) * up[e]; }
                *(u32x4*)(H + (size_t)row * 2816 + col0) = pack8(o[0], o[1]); asm volatile("" ::: "memory"); }
    }
};
struct EpiRes {
    static constexpr bool PERM = true, AFTER_DRAIN = false;
    float* X; bf16_t* XB; float* stats; float scale;
    __device__ __forceinline__ void operator()(const f32x4 (&acc)[2][2][4][2], const Unit& u, int wr, int wc, int fr, int fq) const {
        const int row0 = u.pm * BM + wr * 64 + fr, col0 = u.pn * BM + wc * 32 + 8 * fq;
#pragma unroll
        for (int ai = 0; ai < 2; ++ai)
#pragma unroll
            for (int m = 0; m < 4; ++m) { const int row = row0 + ai * HALF + m * 16; float ss = 0.f;
#pragma unroll
                for (int bj = 0; bj < 2; ++bj) { float* xp = X + (size_t)row * 1024 + col0 + bj * HALF;
                    const f32x4 x0 = *(const f32x4*)xp, x1 = *(const f32x4*)(xp + 4);
                    const f32x4 v0 = x0 + acc[ai][bj][m][0] * scale, v1 = x1 + acc[ai][bj][m][1] * scale;
                    *(f32x4*)xp = v0; *(f32x4*)(xp + 4) = v1;
                    *(u32x4*)(XB + (size_t)row * 1024 + col0 + bj * HALF) = pack8(v0, v1);
                    ss += ((v0[0] * v0[0] + v0[1] * v0[1]) + (v0[2] * v0[2] + v0[3] * v0[3])) + ((v1[0] * v1[0] + v1[1] * v1[1]) + (v1[2] * v1[2] + v1[3] * v1[3])); }
                ss += __shfl_xor(ss, 16); ss += __shfl_xor(ss, 32);
                if (fq == 0) stats[(size_t)row * 16 + u.pn * 4 + wc] = ss; asm volatile("" ::: "memory"); }
    }
};
struct EpiIn {
    static constexpr bool PERM = true, AFTER_DRAIN = false;
    const float* stats; const float* ropec; const float* ropes; const float* qgain; const float* kgain;
    bf16_t *QA, *KA, *VA, *QB, *KB, *VB, *RB, *GA, *GB; float* GLR;
    template <int ACT> __device__ __forceinline__ void plain(const f32x4 (&acc)[2][2][4][2], const Unit& u, int wr, int wc, int fr, int fq, bf16_t* dst, int pitch, int colt, float sc) const {
        const int row0 = u.pm * BM + wr * 64 + fr, col0 = colt + wc * 32 + 8 * fq;
#pragma unroll
        for (int ai = 0; ai < 2; ++ai)
#pragma unroll
            for (int m = 0; m < 4; ++m) { const int row = row0 + ai * HALF + m * 16; const float rs = row_rstd(stats, row) * sc;
#pragma unroll
                for (int bj = 0; bj < 2; ++bj) { f32x4 v0 = acc[ai][bj][m][0] * rs, v1 = acc[ai][bj][m][1] * rs;
                    if (ACT == 1) {
#pragma unroll
                        for (int e = 0; e < 4; ++e) { v0[e] = silu_f(v0[e]); v1[e] = silu_f(v1[e]); } }
                    if (ACT == 2) {
#pragma unroll
                        for (int e = 0; e < 4; ++e) { v0[e] = sigm_f(v0[e]); v1[e] = sigm_f(v1[e]); } }
                    *(u32x4*)(dst + (size_t)row * pitch + col0 + bj * HALF) = pack8(v0, v1); } asm volatile("" ::: "memory"); }
    }
    __device__ __forceinline__ void normrope(const f32x4 (&acc)[2][2][4][2], const Unit& u, int wr, int fr, int fq, bf16_t* dst, int pitch, int colh, const float* gain, float osc) const {
        const int row0 = u.pm * BM + wr * 64 + fr;
#pragma unroll
        for (int ai = 0; ai < 2; ++ai)
#pragma unroll
            for (int m = 0; m < 4; ++m) { const int row = row0 + ai * HALF + m * 16; const float rs = row_rstd(stats, row); const int t = row & (SEQ - 1);
                f32x4 v[2][2]; float ss = 0.f;
#pragma unroll
                for (int bj = 0; bj < 2; ++bj)
#pragma unroll
                    for (int n = 0; n < 2; ++n) { v[bj][n] = acc[ai][bj][m][n] * rs; const f32x4 q = v[bj][n]; ss += (q[0] * q[0] + q[1] * q[1]) + (q[2] * q[2] + q[3] * q[3]); }
                ss += __shfl_xor(ss, 16); ss += __shfl_xor(ss, 32);
                const float rn = __builtin_amdgcn_rsqf(ss * (1.0f / 64.0f) + 1e-6f);
                f32x4 o1[2], o2[2];
#pragma unroll
                for (int n = 0; n < 2; ++n) { const int d = 8 * fq + 4 * n;
                    const f32x4 g1 = *(const f32x4*)(gain + d), g2 = *(const f32x4*)(gain + 32 + d);
                    const f32x4 c = *(const f32x4*)(ropec + (size_t)t * 32 + d), s = *(const f32x4*)(ropes + (size_t)t * 32 + d);
                    const f32x4 x1 = v[0][n] * rn * g1, x2 = v[1][n] * rn * g2;
                    o1[n] = (x1 * c - x2 * s) * osc; o2[n] = (x2 * c + x1 * s) * osc; }
                bf16_t* p = dst + (size_t)row * pitch + colh + 8 * fq;
                *(u32x4*)p = pack8(o1[0], o1[1]); *(u32x4*)(p + 32) = pack8(o2[0], o2[1]); asm volatile("" ::: "memory"); }
    }
    __device__ __forceinline__ void operator()(const f32x4 (&acc)[2][2][4][2], const Unit& u, int wr, int wc, int fr, int fq) const {
        const int pn = u.pn;
        if (pn < 2) { normrope(acc, u, wr, fr, fq, QA, 512, (4 * pn + wc) * 64, qgain, 0.125f * 1.4426950408889634f); }
        else if (pn == 2) {
            if (wc < 2) normrope(acc, u, wr, fr, fq, KA, 128, wc * 64, kgain, 1.0f);
            else {
                const int row0 = u.pm * BM + wr * 64 + fr;
#pragma unroll
                for (int ai = 0; ai < 2; ++ai)
#pragma unroll
                    for (int m = 0; m < 4; ++m) { const int row = row0 + ai * HALF + m * 16; const float rs = row_rstd(stats, row);
#pragma unroll
                        for (int bj = 0; bj < 2; ++bj) *(u32x4*)(VA + (size_t)row * 128 + (wc - 2) * 64 + bj * 32 + 8 * fq) = pack8(acc[ai][bj][m][0] * rs, acc[ai][bj][m][1] * rs); } }
        }
        else if (pn < 5)  plain<0>(acc, u, wr, wc, fr, fq, QB, 512, (pn - 3) * 256, 0.08838834764831845f);
        else if (pn < 7)  plain<0>(acc, u, wr, wc, fr, fq, KB, 512, (pn - 5) * 256, 1.0f);
        else if (pn < 11) plain<0>(acc, u, wr, wc, fr, fq, VB, 1024, (pn - 7) * 256, 1.0f);
        else if (pn < 15) plain<1>(acc, u, wr, wc, fr, fq, RB, 1024, (pn - 11) * 256, 1.0f);
        else if (pn < 19) plain<2>(acc, u, wr, wc, fr, fq, GA, 1024, (pn - 15) * 256, 1.0f);
        else if (pn < 23) plain<2>(acc, u, wr, wc, fr, fq, GB, 1024, (pn - 19) * 256, 1.0f);
        else { if (wc == 0 && fq < 2) { const int row0 = u.pm * BM + wr * 64 + fr;
#pragma unroll
                for (int ai = 0; ai < 2; ++ai)
#pragma unroll
                    for (int m = 0; m < 4; ++m) { const int row = row0 + ai * HALF + m * 16; const float rs = row_rstd(stats, row);
                        float* p = GLR + (size_t)row * 16 + 8 * fq; *(f32x4*)p = acc[ai][0][m][0] * rs; *(f32x4*)(p + 4) = acc[ai][0][m][1] * rs; } } }
    }
};
struct EpiPA {
    static constexpr bool PERM = true, AFTER_DRAIN = false;
    bf16_t* MG;
    __device__ __forceinline__ void operator()(const f32x4 (&acc)[2][2][4][2], const Unit& u, int wr, int wc, int fr, int fq) const {
        const int row0 = u.pm * BM + wr * 64 + fr, col0 = u.pn * BM + wc * 32 + 8 * fq;
#pragma unroll
        for (int ai = 0; ai < 2; ++ai)
#pragma unroll
            for (int m = 0; m < 4; ++m) { const int row = row0 + ai * HALF + m * 16;
#pragma unroll
                for (int bj = 0; bj < 2; ++bj) { u32x4* p = (u32x4*)(MG + (size_t)row * 1024 + col0 + bj * HALF); const u32x4 g = *p;
                    const f32x4 g0 = {bf_lo(g.x), bf_hi(g.x), bf_lo(g.y), bf_hi(g.y)}, g1 = {bf_lo(g.z), bf_hi(g.z), bf_lo(g.w), bf_hi(g.w)};
                    *p = pack8(acc[ai][bj][m][0] * g0, acc[ai][bj][m][1] * g1); } asm volatile("" ::: "memory"); }
    }
};
struct EpiPB {
    static constexpr bool PERM = true, AFTER_DRAIN = false;
    bf16_t* MG; const bf16_t* GB;
    __device__ __forceinline__ void operator()(const f32x4 (&acc)[2][2][4][2], const Unit& u, int wr, int wc, int fr, int fq) const {
        const int row0 = u.pm * BM + wr * 64 + fr, col0 = u.pn * BM + wc * 32 + 8 * fq;
#pragma unroll
        for (int ai = 0; ai < 2; ++ai)
#pragma unroll
            for (int m = 0; m < 4; ++m) { const int row = row0 + ai * HALF + m * 16;
#pragma unroll
                for (int bj = 0; bj < 2; ++bj) { const size_t off = (size_t)row * 1024 + col0 + bj * HALF; u32x4* p = (u32x4*)(MG + off); const u32x4 a = *p, g = *(const u32x4*)(GB + off);
                    const f32x4 a0 = {bf_lo(a.x), bf_hi(a.x), bf_lo(a.y), bf_hi(a.y)}, a1 = {bf_lo(a.z), bf_hi(a.z), bf_lo(a.w), bf_hi(a.w)};
                    const f32x4 g0 = {bf_lo(g.x), bf_hi(g.x), bf_lo(g.y), bf_hi(g.y)}, g1 = {bf_lo(g.z), bf_hi(g.z), bf_lo(g.w), bf_hi(g.w)};
                    *p = pack8(a0 + acc[ai][bj][m][0] * g0, a1 + acc[ai][bj][m][1] * g1); } asm volatile("" ::: "memory"); }
    }
};

template <class Epi, class Sched, bool ALIGN_EPI = false, bool SP2 = false>
__device__ __forceinline__ void gemm_phase(PG8_LAS unsigned char* lds, const Gemm g, const Sched& S, const Epi& E) {
    int tid_l = threadIdx.x; asm volatile("" : "+v"(tid_l));
    const int tid = tid_l, wid = __builtin_amdgcn_readfirstlane(tid >> 6), lane = tid & 63, wr = wid >> 2, wc = wid & 3, fr = lane & 15, fq = lane >> 4;
    const int K = g.K, nt = K / BK;
    unsigned voffA[2], voffB[2];
#pragma unroll
    for (int i = 0; i < 2; ++i) { int R, C; stage_rc(tid * 16 + i * 8192, R, C); const int Rb = Epi::PERM ? ((R & ~31) + perm32(R & 31)) : R;
        voffA[i] = (unsigned)(R * K + C) * 2u; voffB[i] = (unsigned)(Rb * K + C) * 2u; }
    const size_t kstep = (size_t)(BK * 2);
    const size_t hstep = (size_t)HALF * K * 2;
    const size_t tstep = 2 * hstep;
    const unsigned ldsw = (unsigned)wid * 1024u;
    const int aoff = lds_byte(wr * 64 + fr, fq * 8), boff = lds_byte(wc * 32 + fr, fq * 8);
#define PG8_SA(b, h) (((b) * 2 + (h)) * HTB)
#define PG8_SB(b, h) ((4 + (b) * 2 + (h)) * HTB)
#define PG8_STAGE(bufoff, gbase, voff) do { _Pragma("unroll") for (int _i = 0; _i < 2; ++_i) \
        __builtin_amdgcn_global_load_lds((const unsigned*)((const char*)(gbase) + (voff)[_i]), (PG8_LAS unsigned*)(lds + (bufoff) + ldsw + _i * 8192), 16, 0, 0); } while (0)
#define PG8_LDA(dst, b, h) do { _Pragma("unroll") for (int m = 0; m < 4; ++m) _Pragma("unroll") for (int k = 0; k < 2; ++k) dst[m][k] = *(const PG8_LAS bf16x8*)(lds + PG8_SA(b, h) + aoff + m * 2048 + k * 1024); } while (0)
#define PG8_LDB(dst, b, h) do { _Pragma("unroll") for (int n = 0; n < 2; ++n) _Pragma("unroll") for (int k = 0; k < 2; ++k) dst[n][k] = *(const PG8_LAS bf16x8*)(lds + PG8_SB(b, h) + boff + n * 2048 + k * 1024); } while (0)
#define PG8_MMA(ai, bj, At, Bt) do { __builtin_amdgcn_s_setprio(1); _Pragma("unroll") for (int m = 0; m < 4; ++m) _Pragma("unroll") for (int n = 0; n < 2; ++n) _Pragma("unroll") for (int k = 0; k < 2; ++k) \
        acc[ai][bj][m][n] = __builtin_amdgcn_mfma_f32_16x16x32_bf16(Bt[n][k], At[m][k], acc[ai][bj][m][n], 0, 0, 0); __builtin_amdgcn_s_setprio(0); } while (0)
#define PG8_WAIT_V(n) asm volatile("s_waitcnt vmcnt(" #n ")" ::: "memory")
#define PG8_WAIT_L(n) asm volatile("s_waitcnt lgkmcnt(" #n ")" ::: "memory")
#define PG8_BAR __builtin_amdgcn_s_barrier()
#define PG8_SCHED __builtin_amdgcn_sched_barrier(0)
    Unit cur, nxt; int ui = 0;
    if (!S.next(0, cur)) return;
    f32x4 acc[2][2][4][2];
#pragma unroll
    for (int a = 0; a < 2; ++a)
#pragma unroll
        for (int b = 0; b < 2; ++b)
#pragma unroll
            for (int m = 0; m < 4; ++m)
#pragma unroll
                for (int n = 0; n < 2; ++n) acc[a][b][m][n] = (f32x4){0.f, 0.f, 0.f, 0.f};
    bf16x8 At[4][2], B0[2][2], B1[2][2];
    const char* cA = (const char*)g.A + (size_t)cur.pm * tstep; const char* cB = (const char*)g.Bt + (size_t)cur.pn * tstep;
    S.a_ready(cur);
    if constexpr (SP2) {
        PG8_STAGE(PG8_SB(0, 0), cB, voffB); PG8_STAGE(PG8_SB(0, 1), cB + hstep, voffB); PG8_STAGE(PG8_SA(0, 0), cA, voffA); PG8_STAGE(PG8_SA(0, 1), cA + hstep, voffA);
        if (wr == 1) PG8_BAR;
        PG8_WAIT_V(2); PG8_BAR;
        PG8_STAGE(PG8_SB(1, 0), cB + kstep, voffB); PG8_STAGE(PG8_SA(1, 0), cA + kstep, voffA); PG8_STAGE(PG8_SB(1, 1), cB + hstep + kstep, voffB);
        PG8_WAIT_V(6); PG8_BAR;
    } else {
        PG8_STAGE(PG8_SB(0, 0), cB, voffB); PG8_STAGE(PG8_SA(0, 0), cA, voffA); PG8_STAGE(PG8_SB(0, 1), cB + hstep, voffB); PG8_STAGE(PG8_SA(0, 1), cA + hstep, voffA);
        if (wr == 1) PG8_BAR;
        PG8_WAIT_V(4); PG8_BAR;
        PG8_STAGE(PG8_SB(1, 0), cB + kstep, voffB); PG8_STAGE(PG8_SA(1, 0), cA + kstep, voffA); PG8_STAGE(PG8_SB(1, 1), cB + hstep + kstep, voffB);
        PG8_WAIT_V(6); PG8_BAR;
    }
    for (;;) {
        const bool has_next = S.next(ui + 1, nxt);
        const char* nA = has_next ? (const char*)g.A + (size_t)nxt.pm * tstep : cA; const char* nB = has_next ? (const char*)g.Bt + (size_t)nxt.pn * tstep : cB;
        for (int t = 0; t < nt; t += 2) {
            const bool last = (t == nt - 2);
            const char* a1 = cA + (size_t)(t + 1) * kstep;
            const char* a2 = last ? nA : cA + (size_t)(t + 2) * kstep; const char* b2 = last ? nB : cB + (size_t)(t + 2) * kstep;
            const char* a3 = a2 + kstep; const char* b3 = b2 + kstep;
            if (last && has_next) S.a_ready(nxt);
            if constexpr (SP2) {
            PG8_LDB(B0, 0, 0); PG8_LDB(B1, 0, 1); PG8_SCHED; PG8_LDA(At, 0, 0); PG8_STAGE(PG8_SA(1, 1), a1 + hstep, voffA);
            PG8_WAIT_V(8); PG8_WAIT_L(0); PG8_BAR; PG8_MMA(0, 0, At, B0); PG8_MMA(0, 1, At, B1); PG8_BAR; PG8_SCHED;
            PG8_LDA(At, 0, 1); PG8_STAGE(PG8_SB(0, 0), b2, voffB); PG8_STAGE(PG8_SB(0, 1), b2 + hstep, voffB); PG8_STAGE(PG8_SA(0, 0), a2, voffA);
            PG8_WAIT_V(8); PG8_WAIT_L(0); PG8_BAR; PG8_MMA(1, 0, At, B0); PG8_MMA(1, 1, At, B1); PG8_BAR; PG8_SCHED;
            PG8_LDB(B0, 1, 0); PG8_LDB(B1, 1, 1); PG8_SCHED; PG8_LDA(At, 1, 0); PG8_STAGE(PG8_SA(0, 1), a2 + hstep, voffA);
            PG8_WAIT_V(8); PG8_WAIT_L(0); PG8_BAR; PG8_MMA(0, 0, At, B0); PG8_MMA(0, 1, At, B1); PG8_BAR; PG8_SCHED;
            PG8_LDA(At, 1, 1); PG8_STAGE(PG8_SB(1, 0), b3, voffB); PG8_STAGE(PG8_SB(1, 1), b3 + hstep, voffB); PG8_STAGE(PG8_SA(1, 0), a3, voffA);
            PG8_WAIT_V(8); PG8_WAIT_L(0); PG8_BAR; PG8_MMA(1, 0, At, B0); PG8_MMA(1, 1, At, B1); PG8_BAR; PG8_SCHED;
            } else {
            PG8_LDB(B0, 0, 0); PG8_SCHED; PG8_LDA(At, 0, 0); PG8_STAGE(PG8_SA(1, 1), a1 + hstep, voffA);
            PG8_WAIT_L(8); PG8_BAR; PG8_WAIT_L(0); PG8_MMA(0, 0, At, B0); PG8_BAR; PG8_SCHED;
            PG8_LDB(B1, 0, 1); PG8_STAGE(PG8_SB(0, 0), b2, voffB);
            PG8_BAR; PG8_WAIT_L(0); PG8_MMA(0, 1, At, B1); PG8_BAR;
            PG8_LDA(At, 0, 1); PG8_STAGE(PG8_SA(0, 0), a2, voffA);
            PG8_BAR; PG8_WAIT_L(0); PG8_MMA(1, 0, At, B0); PG8_BAR; PG8_SCHED;
            PG8_STAGE(PG8_SB(0, 1), b2 + hstep, voffB);
            PG8_WAIT_V(6); PG8_BAR; PG8_MMA(1, 1, At, B1); PG8_BAR;
            PG8_LDB(B0, 1, 0); PG8_SCHED; PG8_LDA(At, 1, 0); PG8_STAGE(PG8_SA(0, 1), a2 + hstep, voffA);
            PG8_WAIT_L(8); PG8_BAR; PG8_WAIT_L(0); PG8_MMA(0, 0, At, B0); PG8_BAR; PG8_SCHED;
            PG8_LDB(B1, 1, 1); PG8_STAGE(PG8_SB(1, 0), b3, voffB);
            PG8_BAR; PG8_WAIT_L(0); PG8_MMA(0, 1, At, B1); PG8_BAR;
            PG8_LDA(At, 1, 1); PG8_STAGE(PG8_SA(1, 0), a3, voffA);
            PG8_BAR; PG8_WAIT_L(0); PG8_MMA(1, 0, At, B0); PG8_BAR; PG8_SCHED;
            PG8_STAGE(PG8_SB(1, 1), b3 + hstep, voffB);
            PG8_WAIT_V(6); PG8_BAR; PG8_MMA(1, 1, At, B1); PG8_BAR;
            }
        }
        if constexpr (ALIGN_EPI) { if (wr == 0) PG8_BAR; }
        if constexpr (!Epi::AFTER_DRAIN) { E(acc, cur, wr, wc, fr, fq); S.done(cur); }
        if (!has_next) break;
#pragma unroll
        for (int a = 0; a < 2; ++a)
#pragma unroll
            for (int b = 0; b < 2; ++b)
#pragma unroll
                for (int m = 0; m < 4; ++m)
#pragma unroll
                    for (int n = 0; n < 2; ++n) acc[a][b][m][n] = (f32x4){0.f, 0.f, 0.f, 0.f};
        cur = nxt; cA = nA; cB = nB; ++ui;
        if constexpr (ALIGN_EPI) { if (wr == 1) PG8_BAR; }
    }
    PG8_WAIT_V(0);
    if constexpr (!ALIGN_EPI) { if (wr == 0) PG8_BAR; }
    PG8_BAR;
    if constexpr (Epi::AFTER_DRAIN) { E.fused(acc, cur, wr, wc, fr, fq, lds, wid, lane); S.done(cur); }
#undef PG8_SA
#undef PG8_SB
#undef PG8_STAGE
#undef PG8_LDA
#undef PG8_LDB
#undef PG8_MMA
#undef PG8_WAIT_V
#undef PG8_WAIT_L
#undef PG8_BAR
#undef PG8_SCHED
}
}
#define GAS __attribute__((address_space(1)))
#define LAS __attribute__((address_space(3)))
typedef unsigned short bf16;
typedef unsigned v4u __attribute__((ext_vector_type(4)));
typedef float f32x4 __attribute__((ext_vector_type(4)));
typedef short bf16x8 __attribute__((ext_vector_type(8)));
typedef GAS unsigned gu32;
typedef GAS unsigned long long gu64;
#define RLX_AGENT __ATOMIC_RELAXED, __HIP_MEMORY_SCOPE_AGENT
#define LDS_WAIT() asm volatile("s_waitcnt lgkmcnt(0)" ::: "memory")
#define VM_WAIT() asm volatile("s_waitcnt vmcnt(0)" ::: "memory")
__device__ __forceinline__ unsigned long long rt() { return __builtin_amdgcn_s_memrealtime(); }
__device__ __forceinline__ unsigned f2bf(float f) { unsigned u = __builtin_bit_cast(unsigned, f); return (u + 0x7fffu + ((u >> 16) & 1u)) >> 16; }
__device__ __forceinline__ unsigned pk2(float lo, float hi) { return f2bf(lo) | (f2bf(hi) << 16); }

#define XB_TMO      128
#define XB_XCNT(j)  (256  + 64 * (j))
#define XB_XSUB(j)  (1280 + 64 * (j))
#define XB_XGEN(j)  (2304 + 64 * (j))
#define XB_TOP      3328
#define XB_TOPGEN   3392
#define XCD_BAR_WORDS 3456
#define XB_SPIN_CAP (1u << 18)

__device__ __forceinline__ unsigned xb_ld(unsigned* p)              { return __hip_atomic_load(p, __ATOMIC_RELAXED, __HIP_MEMORY_SCOPE_AGENT); }
__device__ __forceinline__ unsigned xb_add(unsigned* p, unsigned v) { return __hip_atomic_fetch_add(p, v, __ATOMIC_RELAXED, __HIP_MEMORY_SCOPE_AGENT); }
__device__ __forceinline__ unsigned xb_xcc_id() { return (unsigned)__builtin_amdgcn_s_getreg((3 << 11) | 20) & 0xFu; }
#define XB_SPIN(cond, bar) do { unsigned _sp = 0; while (cond) { __builtin_amdgcn_s_sleep(1); \
    if ((++_sp & 255u) == 0u) { if (xb_ld(&(bar)[XB_TMO])) break; if (_sp > XB_SPIN_CAP) { atomicAdd(&(bar)[XB_TMO], 1u); break; } } } } while (0)

struct XcdBarrier {
    unsigned* bar; unsigned x;
    volatile LAS unsigned* st;
};

__device__ __forceinline__ XcdBarrier xcd_barrier_post(unsigned* bar, volatile LAS unsigned* st) {
    XcdBarrier b; b.bar = bar; b.x = xb_xcc_id(); b.st = st;
    if (threadIdx.x == 0) (void)xb_add(&bar[XB_XCNT(b.x)], 1u);
    return b;
}
__device__ __forceinline__ void xcd_barrier_complete(unsigned* bar, unsigned x, unsigned& nloc, unsigned& nx) {
    const unsigned G = gridDim.x * gridDim.y * gridDim.z;
    unsigned sum, cnt, mine, sp = 0u;
    for (;;) {
        sum = 0u; cnt = 0u; mine = 0u;
#pragma unroll
        for (unsigned j = 0; j < 16; ++j) { const unsigned c = xb_ld(&bar[XB_XCNT(j)]); sum += c; cnt += (c > 0u) ? 1u : 0u; mine = (j == x) ? c : mine; }
        if (sum == G) break;
        __builtin_amdgcn_s_sleep(1);
        if ((++sp & 255u) == 0u) { if (xb_ld(&bar[XB_TMO])) break; if (sp > XB_SPIN_CAP) { atomicAdd(&bar[XB_TMO], 1u); break; } }
    }
    nloc = mine > 0u ? mine : 1u; nx = cnt > 0u ? cnt : 1u;
}

__device__ __forceinline__ void xcd_barrier(const XcdBarrier& b) {
    asm volatile("s_waitcnt vmcnt(0)" ::: "memory");
    __syncthreads();
    if (threadIdx.x == 0) {
        unsigned* bar = b.bar;
        __builtin_amdgcn_s_waitcnt(0);
        unsigned nloc = b.st[0], nx = b.st[1];
        if (nloc == 0u) { xcd_barrier_complete(bar, b.x, nloc, nx); b.st[0] = nloc; b.st[1] = nx; }
        const unsigned old = xb_add(&bar[XB_XSUB(b.x)], 1u);
        const unsigned gen = old / nloc;
        if (old + 1u == (gen + 1u) * nloc) {
            __builtin_amdgcn_fence(__ATOMIC_RELEASE, "agent");
            asm volatile("s_waitcnt vmcnt(0)" ::: "memory");
            const unsigned og = xb_add(&bar[XB_TOP], 1u);
            const unsigned tg = og / nx;
            if (og + 1u == (tg + 1u) * nx) xb_add(&bar[XB_TOPGEN], 1u);
            else XB_SPIN(xb_ld(&bar[XB_TOPGEN]) == tg, bar);
            __builtin_amdgcn_fence(__ATOMIC_ACQUIRE, "agent");
            xb_add(&bar[XB_XGEN(b.x)], 1u);
            asm volatile("s_waitcnt vmcnt(0)" ::: "memory");
        } else {
            XB_SPIN(xb_ld(&bar[XB_XGEN(b.x)]) == gen, bar);
            __builtin_amdgcn_fence(__ATOMIC_ACQUIRE, "agent");
            asm volatile("s_waitcnt vmcnt(0)" ::: "memory");
        }
    }
    __syncthreads();
}
typedef unsigned u32x4 __attribute__((ext_vector_type(4)));

typedef short s16x4 __attribute__((ext_vector_type(4)));
typedef float f32x16 __attribute__((ext_vector_type(16)));
typedef float f32x2_t __attribute__((ext_vector_type(2)));
typedef __bf16 bf16x2_t __attribute__((ext_vector_type(2)));
typedef short v4i16_t __attribute__((ext_vector_type(4)));
typedef unsigned u32x2 __attribute__((ext_vector_type(2)));
#define MFMA32(a, b, c) __builtin_amdgcn_mfma_f32_32x32x16_bf16((a), (b), (c), 0, 0, 0)
__device__ __forceinline__ int crow(int r, int hi) { return (r & 3) + 8 * (r >> 2) + 4 * hi; }
__device__ __forceinline__ unsigned cvtpk(float lo, float hi) { f32x2_t v = {lo, hi}; bf16x2_t b = __builtin_convertvector(v, bf16x2_t); return __builtin_bit_cast(unsigned, b); }
__device__ __forceinline__ s16x4 tr_rd(LAS const unsigned char* p) { return __builtin_bit_cast(s16x4, __builtin_amdgcn_ds_read_tr16_b64_v4i16((LAS v4i16_t*)p)); }
__device__ __forceinline__ bf16x8 cat8(s16x4 lo, s16x4 hi) { return __builtin_shufflevector(lo, hi, 0, 1, 2, 3, 4, 5, 6, 7); }
__device__ __forceinline__ bf16x8 pack_step(const f32x16& x, int s) {
    u32x4 p; p.x = cvtpk(x[8 * s], x[8 * s + 1]); p.y = cvtpk(x[8 * s + 2], x[8 * s + 3]); p.z = cvtpk(x[8 * s + 4], x[8 * s + 5]); p.w = cvtpk(x[8 * s + 6], x[8 * s + 7]);
    return __builtin_bit_cast(bf16x8, p);
}
__device__ __forceinline__ bf16x8 row_frag(LAS const unsigned char* p) { const s16x4 lo = *(LAS const s16x4*)p, hi = *(LAS const s16x4*)(p + 16); return cat8(lo, hi); }

namespace swa {
constexpr int KOFF = 0, VOFF = 3 * 8192, LDS_NEED = 6 * 8192, NUNITS = BATCH * 2 * (SEQ / 64);
__device__ __forceinline__ void unit(int un, const bf16* QA, const bf16* KA, const bf16* VA, bf16* OA, const float* sinks, LAS unsigned char* lds, int tid) {
    const int lane = tid & 63, r32 = lane & 31, hi = lane >> 5, w = __builtin_amdgcn_readfirstlane(tid >> 6);
    const int i = un & 127, hk = (un >> 7) & 1, b = un >> 8;
    const size_t rowb = (size_t)b * SEQ;
#pragma unroll
    for (int jt = 0; jt < 3; ++jt) {
        const int ti = i - 2 + jt; u32x4 kv = {0u, 0u, 0u, 0u}, vv = {0u, 0u, 0u, 0u};
        if (ti >= 0) {
            kv = *(const u32x4*)(KA + (rowb + ti * 64 + (tid & 63)) * 128 + hk * 64 + (tid >> 6) * 8);
            vv = *(const u32x4*)(VA + (rowb + ti * 64 + 16 * (w & 3) + (lane >> 2)) * 128 + hk * 64 + (w >> 2) * 32 + (lane & 3) * 8);
        }
        *(LAS u32x4*)(lds + KOFF + jt * 8192 + (tid >> 6) * 1024 + (tid & 63) * 16) = kv;
        *(LAS u32x4*)(lds + VOFF + jt * 8192 + tid * 16) = vv;
    }
    const int hq = 4 * hk + (w >> 1), qh = w & 1;
    const bf16* qp = QA + (rowb + 64 * i + 32 * qh + r32) * 512 + hq * 64 + hi * 8;
    bf16x8 qr[4];
#pragma unroll
    for (int d0 = 0; d0 < 4; ++d0) qr[d0] = *(const bf16x8*)(qp + d0 * 16);
    const float sink2 = sinks[hq] * LOG2E;
    __syncthreads();
    f32x16 p[5];
    const int tq = 64 * i + 32 * qh + r32;
    float mx = -INFINITY;
#pragma unroll
    for (int j = 0; j < 5; ++j) {
        const int st = qh + j, jt = st >> 1, kh = st & 1;
        f32x16 a = {};
#pragma unroll
        for (int d0 = 0; d0 < 4; ++d0) { const bf16x8 kf = *(LAS const bf16x8*)(lds + KOFF + jt * 8192 + (2 * d0 + hi) * 1024 + (32 * kh + r32) * 16); a = MFMA32(kf, qr[d0], a); }
        const int tk0 = 64 * (i - 2) + 32 * st;
#pragma unroll
        for (int r = 0; r < 16; ++r) { const int tk = tk0 + crow(r, hi); const bool ok = (tk >= 0) && (tk <= tq) && (tq - tk < 128); a[r] = ok ? a[r] : -INFINITY; mx = fmaxf(mx, a[r]); }
        p[j] = a;
    }
    mx = fmaxf(mx, __shfl_xor(mx, 32));
    const float mm = fmaxf(mx, sink2);
    float sum = 0.f;
#pragma unroll
    for (int j = 0; j < 5; ++j)
#pragma unroll
        for (int r = 0; r < 16; ++r) { const float e = __builtin_amdgcn_exp2f(p[j][r] - mm); p[j][r] = e; sum += e; }
    sum += __shfl_xor(sum, 32);
    const float inv = 1.0f / (sum + __builtin_amdgcn_exp2f(sink2 - mm));
    f32x16 o[2] = {{}, {}};
    LAS const unsigned char* vb = lds + VOFF + ((lane >> 4) & 1) * 32 + (lane & 3) * 8 + (4 * hi + ((lane & 15) >> 2)) * 64;
#pragma unroll
    for (int j = 0; j < 5; ++j) {
        const int st = qh + j, jt = st >> 1, kh = st & 1;
#pragma unroll
        for (int s = 0; s < 2; ++s) { const bf16x8 pf = pack_step(p[j], s); const int ks = 2 * kh + s;
#pragma unroll
            for (int d0 = 0; d0 < 2; ++d0) { LAS const unsigned char* vp = vb + jt * 8192 + d0 * 4096 + ks * 1024; const bf16x8 vf = cat8(tr_rd(vp), tr_rd(vp + 512)); o[d0] = MFMA32(vf, pf, o[d0]); } }
    }
    bf16* op = OA + (rowb + 64 * i + 32 * qh + r32) * 512 + hq * 64 + 4 * hi;
#pragma unroll
    for (int d0 = 0; d0 < 2; ++d0)
#pragma unroll
        for (int g = 0; g < 4; ++g) { u32x2 wv; wv.x = cvtpk(o[d0][4 * g] * inv, o[d0][4 * g + 1] * inv); wv.y = cvtpk(o[d0][4 * g + 2] * inv, o[d0][4 * g + 3] * inv); *(u32x2*)(op + 32 * d0 + 8 * g) = wv; }
    __syncthreads();
}
}

namespace gla {
constexpr int PQ = 264, PK3 = 320, PV = 576, PA = 136;
constexpr int O_Q1 = 0, O_Q2 = 16896, O_K2 = 33792, O_K3 = 50688, O_V = 71168, O_A = 108032, O_GLR = 116736, O_TOT = 120832, O_DV = 122880, O_PART = 123392, LDS_NEED = 125440;
constexpr int NSEG = 32, CPS = 4, NUNITS = 8 * NSEG, SELEMS = 128 * 256;
__device__ __forceinline__ unsigned short f2bf(float f) { unsigned u = __builtin_bit_cast(unsigned, f); return (unsigned short)((u + 0x7fffu + ((u >> 16) & 1u)) >> 16); }
__device__ __forceinline__ float bf2f(unsigned short h) { return __builtin_bit_cast(float, (unsigned)h << 16); }
__device__ __forceinline__ float logsig(float x) { return fminf(x, 0.f) - __logf(1.f + __expf(-fabsf(x))); }

template <bool FULL> __device__ __forceinline__ void load_chunk(const bf16* QB, const bf16* KB, const bf16* VB, const float* GLR, size_t r0, int h, LAS unsigned char* lds, int tid) {
#pragma unroll
    for (int i = 0; i < 2; ++i) { const int p = tid + 512 * i, row = p >> 4, c = p & 15;
        const u32x4 kv = *(const u32x4*)(KB + (r0 + row) * 512 + h * 128 + c * 8);
        LAS u32x2* kd = (LAS u32x2*)(lds + O_K2 + row * PQ + c * 16); kd[0] = (u32x2){kv.x, kv.y}; kd[1] = (u32x2){kv.z, kv.w};
        if (FULL) { const u32x4 qv = *(const u32x4*)(QB + (r0 + row) * 512 + h * 128 + c * 8);
            LAS u32x2* qd = (LAS u32x2*)(lds + O_Q1 + row * PQ + c * 16); qd[0] = (u32x2){qv.x, qv.y}; qd[1] = (u32x2){qv.z, qv.w}; } }
#pragma unroll
    for (int i = 0; i < 4; ++i) { const int p = tid + 512 * i, row = p >> 5, c = p & 31;
        *(LAS u32x4*)(lds + O_V + row * PV + c * 16) = *(const u32x4*)(VB + (r0 + row) * 1024 + h * 256 + c * 8); }
    if (tid < 256) *(LAS f32x4*)(lds + O_GLR + tid * 16) = *(const f32x4*)(GLR + r0 * 16 + tid * 4);
}
template <bool FULL> __device__ __forceinline__ float prep(LAS unsigned char* lds, const float (&wg)[16], float bias, int tid) {
    const int col = tid & 127, tq = tid >> 7;
    __syncthreads();
    float bl[16]; float run = 0.f;
#pragma unroll
    for (int i = 0; i < 16; ++i) { LAS const f32x4* g = (LAS const f32x4*)(lds + O_GLR + (16 * tq + i) * 64); const f32x4 g0 = g[0], g1 = g[1], g2 = g[2], g3 = g[3];
        float x = bias;
        x += g0[0] * wg[0]; x += g0[1] * wg[1]; x += g0[2] * wg[2]; x += g0[3] * wg[3]; x += g1[0] * wg[4]; x += g1[1] * wg[5]; x += g1[2] * wg[6]; x += g1[3] * wg[7];
        x += g2[0] * wg[8]; x += g2[1] * wg[9]; x += g2[2] * wg[10]; x += g2[3] * wg[11]; x += g3[0] * wg[12]; x += g3[1] * wg[13]; x += g3[2] * wg[14]; x += g3[3] * wg[15];
        run += logsig(x) * 0.0625f; bl[i] = run; }
    LAS float* TOT = (LAS float*)(lds + O_TOT);
    TOT[tq * 128 + col] = run;
    __syncthreads();
    const float t0 = TOT[col], t1 = TOT[128 + col], t2 = TOT[256 + col], t3 = TOT[384 + col];
    const float pre = (tq > 0 ? t0 : 0.f) + (tq > 1 ? t1 : 0.f) + (tq > 2 ? t2 : 0.f), rref = t0 + t1, blast = (t0 + t1) + (t2 + t3);
#pragma unroll
    for (int i = 0; i < 16; ++i) { const int t = 16 * tq + i; const float b = pre + bl[i];
        const float k = bf2f(*(LAS const unsigned short*)(lds + O_K2 + t * PQ + col * 2));
        *(LAS unsigned short*)(lds + O_K3 + t * PK3 + col * 2) = f2bf(k * __expf(blast - b));
        if (FULL) { const float q = bf2f(*(LAS const unsigned short*)(lds + O_Q1 + t * PQ + col * 2));
            const float e2 = __expf(b - rref);
            *(LAS unsigned short*)(lds + O_Q1 + t * PQ + col * 2) = f2bf(q * __expf(b));
            *(LAS unsigned short*)(lds + O_Q2 + t * PQ + col * 2) = f2bf(q * e2);
            *(LAS unsigned short*)(lds + O_K2 + t * PQ + col * 2) = f2bf(k * __builtin_amdgcn_rcpf(e2)); } }
    if (tq == 3) ((LAS float*)(lds + O_DV))[col] = __expf(blast);
    return blast;
}
__device__ __forceinline__ void state_update(f32x16 (&S)[4], LAS unsigned char* lds, int w, int lane) {
    const int hi = lane >> 5, i16 = lane & 15, g16 = (lane >> 4) & 1;
    LAS const float* DVp = (LAS const float*)(lds + O_DV);
#pragma unroll
    for (int tile = 0; tile < 4; ++tile)
#pragma unroll
        for (int r = 0; r < 16; ++r) S[tile][r] *= DVp[32 * tile + crow(r, hi)];
    LAS const unsigned char* vb = lds + O_V + (4 * hi + (i16 >> 2)) * PV + (32 * w + 16 * g16 + 4 * (i16 & 3)) * 2;
    LAS const unsigned char* kb = lds + O_K3 + (4 * hi + (i16 >> 2)) * PK3 + (16 * g16 + 4 * (i16 & 3)) * 2;
#pragma unroll
    for (int ks = 0; ks < 4; ++ks) { const bf16x8 vf = cat8(tr_rd(vb + ks * 16 * PV), tr_rd(vb + (ks * 16 + 8) * PV));
#pragma unroll
        for (int tile = 0; tile < 4; ++tile) { const bf16x8 kf = cat8(tr_rd(kb + ks * 16 * PK3 + tile * 64), tr_rd(kb + (ks * 16 + 8) * PK3 + tile * 64)); S[tile] = MFMA32(kf, vf, S[tile]); } }
}
struct Tensors { const bf16 *QB, *KB, *VB, *RB; bf16* OB; const float *GLR, *wgate, *gbias, *onorm; float *R, *SST, *DSEG; };

__device__ __forceinline__ void g1_unit(int un, const Tensors& T, LAS unsigned char* lds, int tid) {
    const int lane = tid & 63, w = __builtin_amdgcn_readfirstlane(tid >> 6), col = tid & 127;
    const int chain = un >> 5, seg = un & 31, b = chain >> 2, h = chain & 3;
    float wg[16];
#pragma unroll
    for (int j = 0; j < 16; ++j) wg[j] = T.wgate[j * 512 + h * 128 + col];
    const float bias = T.gbias[h * 128 + col];
    f32x16 S[4] = {{}, {}, {}, {}}; float bsum = 0.f;
    for (int c = 0; c < CPS; ++c) {
        const size_t r0 = (size_t)b * SEQ + (size_t)(seg * CPS + c) * 64;
        load_chunk<false>(T.QB, T.KB, T.VB, T.GLR, r0, h, lds, tid);
        bsum += prep<false>(lds, wg, bias, tid);
        __syncthreads();
        state_update(S, lds, w, lane);
        __syncthreads();
    }
    float* Rp = T.R + (size_t)un * SELEMS + tid;
#pragma unroll
    for (int tile = 0; tile < 4; ++tile)
#pragma unroll
        for (int r = 0; r < 16; ++r) Rp[(tile * 16 + r) * 512] = S[tile][r];
    if (tid >= 384) T.DSEG[un * 128 + col] = __expf(bsum);
}
__device__ __forceinline__ void g2_scan(const Tensors& T, int gtid, int gthreads) {
    for (int e = gtid; e < 8 * SELEMS; e += gthreads) {
        const int chain = e >> 15, idx = e & (SELEMS - 1), reg = idx >> 9, ln = idx & 63;
        const int dk = 32 * (reg >> 4) + crow(reg & 15, ln >> 5);
        const float* Rp = T.R + (size_t)chain * NSEG * SELEMS + idx; float* Sp = T.SST + (size_t)chain * NSEG * SELEMS + idx; const float* Dp = T.DSEG + chain * NSEG * 128 + dk;
        float s = 0.f;
#pragma unroll 8
        for (int sg = 0; sg < NSEG; ++sg) { Sp[(size_t)sg * SELEMS] = s; s = Dp[sg * 128] * s + Rp[(size_t)sg * SELEMS]; }
    }
}
__device__ __forceinline__ void g3_unit(int un, const Tensors& T, LAS unsigned char* lds, int tid) {
    const int lane = tid & 63, r32 = lane & 31, hi = lane >> 5, w = __builtin_amdgcn_readfirstlane(tid >> 6), col = tid & 127, i16 = lane & 15, g16 = (lane >> 4) & 1;
    const int chain = un >> 5, seg = un & 31, b = chain >> 2, h = chain & 3;
    float wg[16];
#pragma unroll
    for (int j = 0; j < 16; ++j) wg[j] = T.wgate[j * 512 + h * 128 + col];
    const float bias = T.gbias[h * 128 + col];
    f32x16 S[4];
    { const float* Sp = T.SST + (size_t)un * SELEMS + tid;
#pragma unroll
      for (int tile = 0; tile < 4; ++tile)
#pragma unroll
          for (int r = 0; r < 16; ++r) S[tile][r] = Sp[(tile * 16 + r) * 512]; }
    float gn[16];
#pragma unroll
    for (int r = 0; r < 16; ++r) gn[r] = T.onorm[h * 256 + 32 * w + crow(r, hi)];
    for (int c = 0; c < CPS; ++c) {
        const size_t r0 = (size_t)b * SEQ + (size_t)(seg * CPS + c) * 64;
        load_chunk<true>(T.QB, T.KB, T.VB, T.GLR, r0, h, lds, tid);
        (void)prep<true>(lds, wg, bias, tid);
        __syncthreads();
        if (w < 3) { const int tt = (w >= 1), st = (w == 2); f32x16 d = {};
            LAS const unsigned char* kp = lds + O_K2 + (32 * st + r32) * PQ + 8 * hi; LAS const unsigned char* qp = lds + O_Q2 + (32 * tt + r32) * PQ + 8 * hi;
#pragma unroll
            for (int kc = 0; kc < 8; ++kc) d = MFMA32(row_frag(kp + kc * 32), row_frag(qp + kc * 32), d);
            const int t = 32 * tt + r32;
#pragma unroll
            for (int g = 0; g < 4; ++g) { const int s0 = 32 * st + 8 * g + 4 * hi; float v[4];
#pragma unroll
                for (int e = 0; e < 4; ++e) v[e] = (s0 + e <= t) ? d[4 * g + e] : 0.f;
                *(LAS u32x2*)(lds + O_A + t * PA + s0 * 2) = (u32x2){cvtpk(v[0], v[1]), cvtpk(v[2], v[3])}; } }
        f32x16 o[2] = {{}, {}};
#pragma unroll
        for (int tile = 0; tile < 4; ++tile)
#pragma unroll
            for (int s = 0; s < 2; ++s) { const bf16x8 sf = pack_step(S[tile], s);
#pragma unroll
                for (int tt = 0; tt < 2; ++tt) o[tt] = MFMA32(sf, row_frag(lds + O_Q1 + (32 * tt + r32) * PQ + (32 * tile + 16 * s + 4 * hi) * 2), o[tt]); }
        __syncthreads();
        LAS const unsigned char* vb = lds + O_V + (4 * hi + (i16 >> 2)) * PV + (32 * w + 16 * g16 + 4 * (i16 & 3)) * 2;
#pragma unroll
        for (int ks = 0; ks < 4; ++ks) { const bf16x8 vf = cat8(tr_rd(vb + ks * 16 * PV), tr_rd(vb + (ks * 16 + 8) * PV));
            if (ks < 2) o[0] = MFMA32(vf, row_frag(lds + O_A + r32 * PA + (16 * ks + 4 * hi) * 2), o[0]);
            o[1] = MFMA32(vf, row_frag(lds + O_A + (32 + r32) * PA + (16 * ks + 4 * hi) * 2), o[1]); }
        state_update(S, lds, w, lane);
        LAS float* PART = (LAS float*)(lds + O_PART);
#pragma unroll
        for (int tt = 0; tt < 2; ++tt) { float ss = 0.f;
#pragma unroll
            for (int r = 0; r < 16; ++r) ss += o[tt][r] * o[tt][r];
            ss += __shfl_xor(ss, 32); if (hi == 0) PART[w * 64 + 32 * tt + r32] = ss; }
        __syncthreads();
#pragma unroll
        for (int tt = 0; tt < 2; ++tt) { const int t = 32 * tt + r32; float tot = 0.f;
#pragma unroll
            for (int ww = 0; ww < 8; ++ww) tot += PART[ww * 64 + t];
            const float rstd = __builtin_amdgcn_rsqf(tot * (1.0f / 256.0f) + 1e-6f);
            const size_t base = (r0 + t) * 1024 + h * 256 + 32 * w + 4 * hi;
#pragma unroll
            for (int g = 0; g < 4; ++g) { const u32x2 rr = *(const u32x2*)(T.RB + base + 8 * g);
                const float v0 = o[tt][4 * g] * rstd * gn[4 * g] * __builtin_bit_cast(float, rr.x << 16), v1 = o[tt][4 * g + 1] * rstd * gn[4 * g + 1] * __builtin_bit_cast(float, rr.x & 0xffff0000u);
                const float v2 = o[tt][4 * g + 2] * rstd * gn[4 * g + 2] * __builtin_bit_cast(float, rr.y << 16), v3 = o[tt][4 * g + 3] * rstd * gn[4 * g + 3] * __builtin_bit_cast(float, rr.y & 0xffff0000u);
                *(u32x2*)(T.OB + base + 8 * g) = (u32x2){cvtpk(v0, v1), cvtpk(v2, v3)}; } }
        __syncthreads();
    }
}
}

constexpr size_t MiB = 1u << 20;
constexpr size_t WS_CTL = 0, CTL_ZERO_BYTES = 1 * MiB;
constexpr size_t WS_ROPEC = 1 * MiB, WS_ROPES = 2 * MiB;
constexpr size_t WS_STATS = 3 * MiB;
constexpr size_t WS_GLR = 4 * MiB;
constexpr size_t WS_DSEG = 5 * MiB;
constexpr size_t WS_WGU1 = 6 * MiB, WS_WD1 = 17 * MiB, WS_WIN = 23 * MiB, WS_WPA = 35 * MiB, WS_WPB = 36 * MiB, WS_WOUT = 38 * MiB, WS_WGU2 = 40 * MiB, WS_WD2 = 51 * MiB;
constexpr size_t WS_XB = 57 * MiB;
constexpr size_t WS_ZH = 89 * MiB;
constexpr size_t Z_QA = WS_ZH, Z_KA = WS_ZH + 16 * MiB, Z_VA = WS_ZH + 20 * MiB, Z_QB = WS_ZH + 24 * MiB, Z_KB = WS_ZH + 40 * MiB, Z_VB = WS_ZH + 56 * MiB, Z_RB = WS_ZH + 88 * MiB, Z_GA = WS_ZH + 120 * MiB, Z_GB = WS_ZH + 152 * MiB;
constexpr size_t WS_R = 273 * MiB, WS_SST = 305 * MiB, WS_END = 337 * MiB;
constexpr size_t WS_DBG = 337 * MiB;
constexpr int CW_BAR = 4096, CW_DBG = 16384;
constexpr int RING_BYTES = 131072, MISC_OFF = RING_BYTES + 320, LDS_BYTES = 147456;
static_assert(swa::LDS_NEED <= RING_BYTES && gla::LDS_NEED <= RING_BYTES, "phase scratch fits the ring region");

__device__ __forceinline__ void conv_item(const float* W, int ldw, int c0, int nvalid, const float* gain, int k0, bf16* WT, int drow0, int K, LAS float* scr, int lane) {
#pragma unroll 8
    for (int i = 0; i < 32; ++i) { const int kk = 2 * i + (lane >> 5), cc = lane & 31; float v = 0.f;
        if (cc < nvalid) { v = W[(size_t)(k0 + kk) * ldw + c0 + cc]; if (gain) v *= gain[k0 + kk]; }
        scr[kk * 33 + cc] = v; }
    asm volatile("s_waitcnt lgkmcnt(0)" ::: "memory");
    const int c = lane & 7;
#pragma unroll
    for (int j = 0; j < 4; ++j) { const int n = (lane >> 3) + 8 * j; const LAS float* s = scr + (8 * c) * 33 + n;
        v4u o; o.x = pk2(s[0 * 33], s[1 * 33]); o.y = pk2(s[2 * 33], s[3 * 33]); o.z = pk2(s[4 * 33], s[5 * 33]); o.w = pk2(s[6 * 33], s[7 * 33]);
        *(v4u*)(WT + (size_t)(drow0 + n) * K + k0 + 8 * c) = o; }
    asm volatile("s_waitcnt lgkmcnt(0)" ::: "memory");
}
__device__ __forceinline__ void conv_phase(const float* const* in, int l, unsigned char* ws, LAS unsigned char* lds, int gw, int ngw, int wave, int lane) {
    LAS float* scr = (LAS float*)(lds + wave * 16384);
    constexpr int I_GU = 16 * 176, I_D = 44 * 32, I_IN = 16 * 192, I_PA = 8 * 32, I_PB = 16 * 32, I_OUT = 16 * 32;
    constexpr int NIT = 2 * I_GU + 2 * I_D + I_IN + I_PA + I_PB + I_OUT;
    for (int it = gw; it < NIT; it += ngw) {
        int r = it;
        if (r < 2 * I_GU) { const int second = r >= I_GU; r -= second * I_GU; const int kb = r / 176, dg = r % 176, tile = dg >> 3, bj = (dg >> 2) & 1, wc = dg & 3;
            const float* src = in[(second ? 17 : 2) + bj] + (size_t)l * DM * FF;
            conv_item(src, FF, 128 * tile + 32 * wc, 32, in[second ? 16 : 1] + (size_t)l * DM, 64 * kb, (bf16*)(ws + (second ? WS_WGU2 : WS_WGU1)), 32 * dg, DM, scr, lane); continue; }
        r -= 2 * I_GU;
        if (r < 2 * I_D) { const int second = r >= I_D; r -= second * I_D; const int kb = r / 32, dg = r % 32;
            conv_item(in[second ? 19 : 4] + (size_t)l * FF * DM, DM, 32 * dg, 32, nullptr, 64 * kb, (bf16*)(ws + (second ? WS_WD2 : WS_WD1)), 32 * dg, FF, scr, lane); continue; }
        r -= 2 * I_D;
        if (r < I_IN) { const int kb = r / 192, dg = r % 192, tile = dg >> 3, bj = (dg >> 2) & 1, wc = dg & 3; int c0, nv = 32;
            if (tile < 2) c0 = 64 * (4 * tile + wc) + 32 * bj;
            else if (tile == 2) c0 = (wc < 2 ? 512 + 64 * wc : 640 + 64 * (wc - 2)) + 32 * bj;
            else if (tile < 15) c0 = 32 * dg;
            else if (tile < 23) c0 = 32 * dg + 16;
            else { c0 = 3840; nv = (dg == 184) ? 16 : 0; }
            conv_item(in[6] + (size_t)l * DM * IN_COLS, IN_COLS, c0, nv, in[5] + (size_t)l * DM, 64 * kb, (bf16*)(ws + WS_WIN), 32 * dg, DM, scr, lane); continue; }
        r -= I_IN;
        if (r < I_PA) { const int kb = r / 32, dg = r % 32; conv_item(in[13] + (size_t)l * QAW * DM, DM, 32 * dg, 32, nullptr, 64 * kb, (bf16*)(ws + WS_WPA), 32 * dg, QAW, scr, lane); continue; }
        r -= I_PA;
        if (r < I_PB) { const int kb = r / 32, dg = r % 32; conv_item(in[14] + (size_t)l * GVW * DM, DM, 32 * dg, 32, nullptr, 64 * kb, (bf16*)(ws + WS_WPB), 32 * dg, GVW, scr, lane); continue; }
        r -= I_PB;
        { const int kb = r / 32, dg = r % 32; conv_item(in[15] + (size_t)l * DM * DM, DM, 32 * dg, 32, nullptr, 64 * kb, (bf16*)(ws + WS_WOUT), 32 * dg, DM, scr, lane); }
    }
}
__device__ __forceinline__ float wave_sum(float v) {
#pragma unroll
    for (int o = 1; o < 64; o <<= 1) v += __shfl_xor(v, o);
    return v;
}
__device__ __forceinline__ void prologue_phase(const float* x, float* X, bf16* XB, float* stats, float* ropec, float* ropes, const float* invf, int gw, int ngw, int lane, int gtid, int gthreads) {
    for (int m = gw; m < M; m += ngw) {
        const f32x4* xr = (const f32x4*)(x + (size_t)m * DM) + lane; f32x4* xo = (f32x4*)(X + (size_t)m * DM) + lane;
        unsigned long long* o8 = (unsigned long long*)(XB + (size_t)m * DM) + lane;
        float s = 0.f;
#pragma unroll
        for (int j = 0; j < 4; ++j) { const f32x4 v = xr[64 * j]; xo[64 * j] = v; s += (v.x * v.x + v.y * v.y) + (v.z * v.z + v.w * v.w);
            o8[64 * j] = (unsigned long long)pk2(v.x, v.y) | ((unsigned long long)pk2(v.z, v.w) << 32); }
        s = wave_sum(s);
        if (lane < 16) stats[(size_t)m * 16 + lane] = (lane == 0) ? s : 0.f;
    }
    for (int e = gtid; e < SEQ * 32; e += gthreads) { const int t = e >> 5, i = e & 31;
        const float ang = (float)t * invf[i];
        const double a = (double)ang, q = __builtin_rint(a * 0.63661977236758134308), r = __builtin_fma(-q, 6.123233995736766036e-17, __builtin_fma(-q, 1.57079632679489655800, a)), r2 = r * r;
        const double sn = r * (1.0 - r2 / 6.0 * (1.0 - r2 / 20.0 * (1.0 - r2 / 42.0 * (1.0 - r2 / 72.0 * (1.0 - r2 / 110.0 * (1.0 - r2 / 156.0 * (1.0 - r2 / 210.0 * (1.0 - r2 / 272.0))))))));
        const double cs = 1.0 - r2 / 2.0 * (1.0 - r2 / 12.0 * (1.0 - r2 / 30.0 * (1.0 - r2 / 56.0 * (1.0 - r2 / 90.0 * (1.0 - r2 / 132.0 * (1.0 - r2 / 182.0 * (1.0 - r2 / 240.0)))))));
        const int qi = (int)q & 3;
        const double c = (qi == 0) ? cs : (qi == 1) ? -sn : (qi == 2) ? -cs : sn, s_ = (qi == 0) ? sn : (qi == 1) ? cs : (qi == 2) ? -sn : -cs;
        ropec[e] = (float)c; ropes[e] = (float)s_; }
}

struct Args { const float* in[20]; float* out; unsigned char* ws; float invf[32]; int s_lo, s_hi, ph_lo, ph_hi, do_pro, pad; };
enum { PH_CONV = 0, PH_GU = 1, PH_DN = 2, PH_IN = 3, PH_X1 = 4, PH_SCAN = 5, PH_G3 = 6, PH_PROJ = 7, PH_OUT = 8, N_PH = 9 };
#ifndef PHMASK
#define PHMASK 0x3ff
#endif
#define P_X     (args.out)
#define P_XB    ((bf16*)(ws + WS_XB))
#define P_STATS ((float*)(ws + WS_STATS))
#define P_HID   ((bf16*)(ws + WS_ZH))
#define P_QA    ((bf16*)(ws + Z_QA))
#define P_KA    ((bf16*)(ws + Z_KA))
#define P_VA    ((bf16*)(ws + Z_VA))
#define P_QB    ((bf16*)(ws + Z_QB))
#define P_KB    ((bf16*)(ws + Z_KB))
#define P_VB    ((bf16*)(ws + Z_VB))
#define P_RB    ((bf16*)(ws + Z_RB))
#define P_GA    ((bf16*)(ws + Z_GA))
#define P_GB    ((bf16*)(ws + Z_GB))
#define P_GLR   ((float*)(ws + WS_GLR))
#define P_ROPEC ((float*)(ws + WS_ROPEC))
#define P_ROPES ((float*)(ws + WS_ROPES))
#define PHASE_WS() unsigned char* ws = ws0; asm volatile("" : "+s"(ws))
#define PHASE_IDS() PHASE_WS(); int tid = tid0; asm volatile("" : "+v"(tid)); const int lane = tid & 63, wave = __builtin_amdgcn_readfirstlane(tid >> 6); const int gw = vcu * 8 + wave, gtid = vcu * 512 + tid; (void)lane; (void)gw; (void)gtid
#define GLA_TENSORS() gla::Tensors GT{P_QB, P_KB, P_VB, P_RB, P_VB, P_GLR, args.in[10] + (size_t)l * 16 * GKW, args.in[11] + (size_t)l * GKW, args.in[12] + (size_t)l * GVW, (float*)(ws + WS_R), (float*)(ws + WS_SST), (float*)(ws + WS_DSEG)}
__global__ void __launch_bounds__(512, 2) mega_fwd(Args args) {
    extern __shared__ __attribute__((aligned(16))) unsigned char lds_raw[];
    LAS unsigned char* lds = (LAS unsigned char*)lds_raw;
    volatile LAS unsigned* MISC = (volatile LAS unsigned*)(lds + MISC_OFF);
    const int tid0 = threadIdx.x;
    const int G = gridDim.x, bx = blockIdx.x, vcu = (G % 8 == 0) ? (bx % 8) * (G / 8) + bx / 8 : bx;
    const int ngw = G * 8, gthreads = G * 512;
    unsigned char* const ws0 = args.ws;
    for (int u = tid0; u < (LDS_BYTES - RING_BYTES) / 4; u += 512) ((LAS unsigned*)(lds + RING_BYTES))[u] = 0u;
    __syncthreads();
#if !MULTI
    XcdBarrier bar = xcd_barrier_post((unsigned*)(ws0 + WS_CTL) + CW_BAR, MISC + 8);
#define GRID_BAR() xcd_barrier(bar)
#else
    (void)MISC;
#define GRID_BAR() do { } while (0)
#endif
    if (((PHMASK >> 9) & 1) && args.do_pro) { PHASE_IDS(); prologue_phase(args.in[0], P_X, P_XB, P_STATS, P_ROPEC, P_ROPES, args.invf, gw, ngw, lane, gtid, gthreads); }
    const int lo = args.ph_lo, hi = args.ph_hi;
#define IN(k) (((PHMASK >> (k)) & 1) && lo <= (k) && (k) < hi)
    for (int st = args.s_lo; st < args.s_hi; ++st) {
        const int l = st >> 1, odd = st & 1;
        if (!odd && IN(PH_CONV)) {
            PHASE_IDS();
            conv_phase(args.in, l, ws, lds, gw, ngw, wave, lane);
            GRID_BAR();
        }
        if (IN(PH_GU)) { PHASE_WS();
            pg8::Gemm g{P_XB, (const bf16*)(ws + (odd ? WS_WGU2 : WS_WGU1)), M, NGU, DM}; pg8::StaticOrder S; S.init(M, NGU, G, bx);
            pg8::EpiGU E{P_HID, P_STATS};
            pg8::gemm_phase<pg8::EpiGU, pg8::StaticOrder, true, true>(lds, g, S, E);
            GRID_BAR();
        }
        if (IN(PH_DN)) { PHASE_WS();
            pg8::Gemm g{P_HID, (const bf16*)(ws + (odd ? WS_WD2 : WS_WD1)), M, DM, FF}; pg8::StaticOrder S; S.init(M, DM, G, bx);
            pg8::EpiRes E{P_X, P_XB, P_STATS, 0.5f};
            pg8::gemm_phase<pg8::EpiRes, pg8::StaticOrder, false, true>(lds, g, S, E);
            GRID_BAR();
        }
        if (!odd) {
            if (IN(PH_IN)) { PHASE_WS();
                pg8::Gemm g{P_XB, (const bf16*)(ws + WS_WIN), M, NIN, DM}; pg8::StaticOrder S; S.init(M, NIN, G, bx);
                pg8::EpiIn E{P_STATS, P_ROPEC, P_ROPES, args.in[7] + l * 64, args.in[8] + l * 64, P_QA, P_KA, P_VA, P_QB, P_KB, P_VB, P_RB, P_GA, P_GB, P_GLR};
                pg8::gemm_phase<pg8::EpiIn, pg8::StaticOrder, true, true>(lds, g, S, E);
                GRID_BAR();
            }
            if (IN(PH_X1)) {
                { PHASE_IDS(); GLA_TENSORS(); for (int un = vcu; un < gla::NUNITS; un += G) gla::g1_unit(un, GT, lds, tid); }
                { PHASE_IDS(); for (int un = vcu; un < swa::NUNITS; un += G) swa::unit(un, P_QA, P_KA, P_VA, P_QA, args.in[9] + l * 8, lds, tid); }
                GRID_BAR();
            }
            if (IN(PH_SCAN)) { PHASE_IDS(); GLA_TENSORS(); gla::g2_scan(GT, gtid, gthreads); GRID_BAR(); }
            if (IN(PH_G3)) { PHASE_IDS(); GLA_TENSORS(); for (int un = vcu; un < gla::NUNITS; un += G) gla::g3_unit(un, GT, lds, tid); GRID_BAR(); }
            if (IN(PH_PROJ)) { PHASE_WS();
                { pg8::Gemm g{P_QA, (const bf16*)(ws + WS_WPA), M, DM, QAW}; pg8::StaticOrder S; S.init(M, DM, G, bx); pg8::EpiPA E{P_GA};
                  pg8::gemm_phase<pg8::EpiPA, pg8::StaticOrder, false, true>(lds, g, S, E); }
                __syncthreads();
                { pg8::Gemm g{P_VB, (const bf16*)(ws + WS_WPB), M, DM, GVW}; pg8::StaticOrder S; S.init(M, DM, G, bx); pg8::EpiPB E{P_GA, P_GB};
                  pg8::gemm_phase<pg8::EpiPB, pg8::StaticOrder, false, true>(lds, g, S, E); }
                GRID_BAR();
            }
            if (IN(PH_OUT)) { PHASE_WS();
                pg8::Gemm g{P_GA, (const bf16*)(ws + WS_WOUT), M, DM, DM}; pg8::StaticOrder S; S.init(M, DM, G, bx);
                pg8::EpiRes E{P_X, P_XB, P_STATS, 1.0f};
                pg8::gemm_phase<pg8::EpiRes, pg8::StaticOrder, false, true>(lds, g, S, E);
                GRID_BAR();
            }
        }
    }
#undef IN
}
constexpr size_t WS_DBG_END = WS_END;
constexpr size_t WS_NEED = (DBG ? WS_DBG_END : WS_END);

extern "C" void kernel_launch(void* const* d_in, const int* in_sizes, int n_in, void* d_out, int out_size, void* d_ws, size_t ws_size, hipStream_t stream) {
    static int grid = 0;
    if (grid == 0) {
        if (n_in != 20 || in_sizes[0] != M * DM || out_size != M * DM || ws_size < WS_NEED) {
            fprintf(stderr, "kernel_launch: built for 20 inputs, x/out of %d floats, >= %zu bytes of workspace; got n_in %d, in0 %d, out %d, ws %zu; nothing launched\n", M * DM, (size_t)WS_NEED, n_in, n_in > 0 ? in_sizes[0] : -1, out_size, ws_size); grid = -1; return; }
        int dev = 0, cus = 0, per_cu = 0;
        if (hipGetDevice(&dev) != hipSuccess || hipDeviceGetAttribute(&cus, hipDeviceAttributeMultiprocessorCount, dev) != hipSuccess) { fprintf(stderr, "kernel_launch: device query failed\n"); grid = -1; return; }
        if (hipFuncSetAttribute((const void*)mega_fwd, hipFuncAttributeMaxDynamicSharedMemorySize, LDS_BYTES) != hipSuccess) { fprintf(stderr, "kernel_launch: hipFuncSetAttribute failed\n"); grid = -1; return; }
        if (hipOccupancyMaxActiveBlocksPerMultiprocessor(&per_cu, (const void*)mega_fwd, 512, LDS_BYTES) != hipSuccess || per_cu < 1)
            fprintf(stderr, "kernel_launch: note: occupancy query reports %d workgroups per CU\n", per_cu);
        (void)hipGetLastError();
        grid = cus;
    }
    if (grid < 0) return;
    if (hipMemsetAsync((char*)d_ws + WS_CTL, 0, CTL_ZERO_BYTES, stream) != hipSuccess) { fprintf(stderr, "kernel_launch: memset failed\n"); return; }
    Args a{};
    for (int i = 0; i < 20; ++i) a.in[i] = (const float*)d_in[i];
    a.out = (float*)d_out; a.ws = (unsigned char*)d_ws;
    for (int i = 0; i < 32; ++i) a.invf[i] = (float)pow(10000.0, -(double)(2 * i) / 64.0);
#if !MULTI
    a.s_lo = 0; a.s_hi = 2 * DEPTH; a.ph_lo = 0; a.ph_hi = N_PH; a.do_pro = 1;
    hipLaunchKernelGGL(mega_fwd, dim3(grid), dim3(512), LDS_BYTES, stream, a);
#else
    a.s_lo = 0; a.s_hi = 0; a.ph_lo = 0; a.ph_hi = 0; a.do_pro = 1;
    hipLaunchKernelGGL(mega_fwd, dim3(grid), dim3(512), LDS_BYTES, stream, a);
    a.do_pro = 0;
    for (int st = 0; st < 2 * DEPTH; ++st)
        for (int ph = 0; ph < N_PH; ++ph) {
            if ((st & 1) && (ph == PH_CONV || ph >= PH_IN)) continue;
            a.s_lo = st; a.s_hi = st + 1; a.ph_lo = ph; a.ph_hi = ph + 1;
#if DBG
            dbg_before(a, st, ph, stream);
#endif
            hipLaunchKernelGGL(mega_fwd, dim3(grid), dim3(512), LDS_BYTES, stream, a);
#if DBG
            dbg_after(a, st, ph, stream);
#endif
        }
#if DBG
    hipLaunchKernelGGL(dbg_report, dim3(1024), dim3(256), 0, stream, (const float*)((unsigned char*)d_ws + WS_CTL) + CW_DBG, (float*)d_out);
#endif
#endif
    const hipError_t le = hipPeekAtLastError();
    if (le != hipSuccess) fprintf(stderr, "kernel_launch: launch failed: %s (grid %d)\n", hipGetErrorName(le), grid);
}
```

```cpp
#include <hip/hip_runtime.h>
#include <hip/hip_bf16.h>
#include <cstdio>
#include <cstdint>
#include <cmath>

#ifndef DBG
#define DBG 0
#endif
#ifndef MULTI
#define MULTI 0
#endif

constexpr int BATCH = 2, SEQ = 8192, DM = 1024, DEPTH = 4, M = BATCH * SEQ;
constexpr int FF = 2816, NGU = 2 * FF;
constexpr int IN_COLS = 5904, NIN = 6144;
constexpr int QAW = 512, KVW = 128, GKW = 512, GVW = 1024;
constexpr float EPS = 1e-6f;
constexpr float LOG2E = 1.4426950408889634f;
namespace pg8 {
#define PG8_LAS __attribute__((address_space(3)))
typedef unsigned short bf16_t;
typedef short bf16x8 __attribute__((ext_vector_type(8)));
typedef float f32x4 __attribute__((ext_vector_type(4)));
typedef unsigned u32x4 __attribute__((ext_vector_type(4)));
constexpr int BM = 256, BK = 64, HALF = 128, HTB = HALF * BK * 2  , STAGE_BYTES = 8 * HTB, NXCD = 8, WGM = 8;

__host__ __device__ __forceinline__ int lds_byte(int r, int c) { const int st = (r >> 4) * 2 + (c >> 5), rr = r & 15, cc = c & 31, ob = rr * 64 + cc * 2; return st * 1024 + (ob ^ (((ob >> 9) & 1) << 5)); }
__host__ __device__ __forceinline__ void stage_rc(int b, int& R, int& C) { const int st = b / 1024, sb = b % 1024, swz = sb ^ (((sb >> 9) & 1) << 5); R = (st >> 1) * 16 + swz / 64; C = (st & 1) * 32 + (swz % 64) / 2; }
__host__ __device__ __forceinline__ int perm32(int rho) { const int n = rho >> 4, i = rho & 15; return 8 * (i >> 2) + 4 * n + (i & 3); }

struct Unit { int pm, pn; };
struct Gemm { const bf16_t* A; const bf16_t* Bt; int M, N, K; };

struct StaticOrder {
    int nM, nN, nwg, G, c;
    __host__ __device__ void init(int M, int N, int G_, int c_) { nM = M / BM; nN = N / BM; nwg = nM * nN; G = G_; c = c_; }
    __host__ __device__ bool next(int i, Unit& u) const {
        const long L = (long)i * G + c; if (L >= nwg) return false;
        int wgid = (int)L; { const int q = nwg / NXCD, r = nwg % NXCD, xcd = wgid % NXCD, off = wgid / NXCD; wgid = (xcd < r ? xcd * (q + 1) : r * (q + 1) + (xcd - r) * q) + off; }
        const int nig = WGM * nN, gid = wgid / nig, fm = gid * WGM, gsz = (nM - fm) < WGM ? (nM - fm) : WGM;
        u.pm = fm + ((wgid % nig) % gsz); u.pn = (wgid % nig) / gsz; return true;
    }
    __device__ __forceinline__ void a_ready(const Unit&) const {}
    __device__ __forceinline__ void done(const Unit&) const {}
};

typedef float f32x2 __attribute__((ext_vector_type(2)));
typedef __bf16 bf16x2v __attribute__((ext_vector_type(2)));
__device__ __forceinline__ unsigned cvt_pk_bf16(float lo, float hi) { f32x2 v = {lo, hi}; bf16x2v b = __builtin_convertvector(v, bf16x2v); return __builtin_bit_cast(unsigned, b); }
__device__ __forceinline__ float silu_f(float g) { return g * __builtin_amdgcn_rcpf(1.f + __builtin_amdgcn_exp2f(-1.4426950408889634f * g)); }
__device__ __forceinline__ float sigm_f(float g) { return __builtin_amdgcn_rcpf(1.f + __builtin_amdgcn_exp2f(-1.4426950408889634f * g)); }
__device__ __forceinline__ float bf_lo(unsigned w) { return __builtin_bit_cast(float, w << 16); }
__device__ __forceinline__ float bf_hi(unsigned w) { return __builtin_bit_cast(float, w & 0xffff0000u); }
__device__ __forceinline__ float row_rstd(const float* stats, int row) {
    const f32x4* p = (const f32x4*)(stats + (size_t)row * 16);
    const f32x4 a = p[0], b = p[1], c = p[2], d = p[3]; const f32x4 s = (a + b) + (c + d);
    return __builtin_amdgcn_rsqf(((s[0] + s[1]) + (s[2] + s[3])) * (1.0f / 1024.0f) + 1e-6f);
}
__device__ __forceinline__ u32x4 pack8(const f32x4 v0, const f32x4 v1) { u32x4 w; w.x = cvt_pk_bf16(v0[0], v0[1]); w.y = cvt_pk_bf16(v0[2], v0[3]); w.z = cvt_pk_bf16(v1[0], v1[1]); w.w = cvt_pk_bf16(v1[2], v1[3]); return w; }

__device__ __forceinline__ void rows_rstd(float (&rs)[8], const PG8_LAS float* tab, int rl0) {
#pragma unroll
    for (int i = 0; i < 8; ++i) rs[i] = tab[rl0 + (i >> 2) * HALF + (i & 3) * 16];
}
struct EpiGU {
    static constexpr bool PERM = true, AFTER_DRAIN = false;
    bf16_t* H; const PG8_LAS float* rtab;
    __device__ __forceinline__ void operator()(const f32x4 (&acc)[2][2][4][2], const Unit& u, int wr, int wc, int fr, int fq) const {
        const int row0 = u.pm * BM + wr * 64 + fr, col0 = u.pn * 128 + wc * 32 + 8 * fq;
        float rs[8]; rows_rstd(rs, rtab, wr * 64 + fr);
#pragma unroll
        for (int ai = 0; ai < 2; ++ai)
#pragma unroll
            for (int m = 0; m < 4; ++m) { const int row = row0 + ai * HALF + m * 16; const float r = rs[ai * 4 + m];
                f32x4 o[2];
#pragma unroll
                for (int n = 0; n < 2; ++n) { const f32x4 g = acc[ai][0][m][n] * r, up = acc[ai][1][m][n] * r;
#pragma unroll
                    for (int e = 0; e < 4; ++e) o[n][e] = silu_f(g[e]) * up[e]; }
                *(u32x4*)(H + (size_t)row * 2816 + col0) = pack8(o[0], o[1]); }
    }
};
struct EpiRes {
    static constexpr bool PERM = true, AFTER_DRAIN = false;
    const float* Xin; float* X; bf16_t* XB; float* stats; float scale;
    __device__ __forceinline__ void operator()(const f32x4 (&acc)[2][2][4][2], const Unit& u, int wr, int wc, int fr, int fq) const {
        const int row0 = u.pm * BM + wr * 64 + fr, col0 = u.pn * BM + wc * 32 + 8 * fq;
        f32x4 xa[2][2][2];
#define EPI_LDX(buf, it) do { const float* xp_ = Xin + (size_t)(row0 + ((it) >> 2) * HALF + ((it) & 3) * 16) * 1024 + col0; \
            xa[buf][0][0] = *(const f32x4*)xp_; xa[buf][0][1] = *(const f32x4*)(xp_ + 4); xa[buf][1][0] = *(const f32x4*)(xp_ + HALF); xa[buf][1][1] = *(const f32x4*)(xp_ + HALF + 4); } while (0)
        EPI_LDX(0, 0);
#pragma unroll
        for (int it = 0; it < 8; ++it) { const int ai = it >> 2, m = it & 3, row = row0 + ai * HALF + m * 16, cb = it & 1;
            if (it < 7) EPI_LDX(cb ^ 1, it + 1);
            asm volatile("" ::: "memory");
            float ss = 0.f;
#pragma unroll
            for (int bj = 0; bj < 2; ++bj) { float* xp = X + (size_t)row * 1024 + col0 + bj * HALF;
                const f32x4 v0 = xa[cb][bj][0] + acc[ai][bj][m][0] * scale, v1 = xa[cb][bj][1] + acc[ai][bj][m][1] * scale;
                *(f32x4*)xp = v0; *(f32x4*)(xp + 4) = v1;
                *(u32x4*)(XB + (size_t)row * 1024 + col0 + bj * HALF) = pack8(v0, v1);
                ss += ((v0[0] * v0[0] + v0[1] * v0[1]) + (v0[2] * v0[2] + v0[3] * v0[3])) + ((v1[0] * v1[0] + v1[1] * v1[1]) + (v1[2] * v1[2] + v1[3] * v1[3])); }
            ss += __shfl_xor(ss, 16); ss += __shfl_xor(ss, 32);
            if (fq == 0) stats[(size_t)row * 16 + u.pn * 4 + wc] = ss; }
#undef EPI_LDX
    }
};
constexpr size_t EPI_MiB = 1u << 20, EPI_ROPEC = 1 * EPI_MiB, EPI_ROPES = 2 * EPI_MiB, EPI_STATS = 3 * EPI_MiB, EPI_GLR = 4 * EPI_MiB, EPI_ZH = 140 * EPI_MiB;
constexpr size_t EPI_QA = EPI_ZH, EPI_KA = EPI_ZH + 16 * EPI_MiB, EPI_VA = EPI_ZH + 20 * EPI_MiB, EPI_QB = EPI_ZH + 24 * EPI_MiB, EPI_KB = EPI_ZH + 40 * EPI_MiB, EPI_VB = EPI_ZH + 56 * EPI_MiB, EPI_RB = EPI_ZH + 88 * EPI_MiB, EPI_GA = EPI_ZH + 120 * EPI_MiB, EPI_GB = EPI_ZH + 152 * EPI_MiB;
struct EpiIn {
    static constexpr bool PERM = true, AFTER_DRAIN = false;
    unsigned char* ws; const float* qgain; const float* kgain; const PG8_LAS float* rtab;
    template <int ACT> __device__ __forceinline__ void plain(const f32x4 (&acc)[2][2][4][2], const Unit& u, int wr, int wc, int fr, int fq, bf16_t* dst, int pitch, int colt, float sc) const {
        const int row0 = u.pm * BM + wr * 64 + fr, col0 = colt + wc * 32 + 8 * fq;
        float rs[8]; rows_rstd(rs, rtab, wr * 64 + fr);
#pragma unroll
        for (int ai = 0; ai < 2; ++ai)
#pragma unroll
            for (int m = 0; m < 4; ++m) { const int row = row0 + ai * HALF + m * 16; const float r = rs[ai * 4 + m] * sc;
#pragma unroll
                for (int bj = 0; bj < 2; ++bj) { f32x4 v0 = acc[ai][bj][m][0] * r, v1 = acc[ai][bj][m][1] * r;
                    if (ACT == 1) {
#pragma unroll
                        for (int e = 0; e < 4; ++e) { v0[e] = silu_f(v0[e]); v1[e] = silu_f(v1[e]); } }
                    if (ACT == 2) {
#pragma unroll
                        for (int e = 0; e < 4; ++e) { v0[e] = sigm_f(v0[e]); v1[e] = sigm_f(v1[e]); } }
                    *(u32x4*)(dst + (size_t)row * pitch + col0 + bj * HALF) = pack8(v0, v1); } }
    }
    __device__ __forceinline__ void normrope(const f32x4 (&acc)[2][2][4][2], const Unit& u, int wr, int fr, int fq, bf16_t* dst, int pitch, int colh, const float* gain, float osc) const {
        const int row0 = u.pm * BM + wr * 64 + fr;
        const float* ropec = (const float*)(ws + EPI_ROPEC); const float* ropes = (const float*)(ws + EPI_ROPES);
        float rs[8]; rows_rstd(rs, rtab, wr * 64 + fr);
        f32x4 cs[2][2][2];
#define EPI_LDR(buf, it) do { const size_t t_ = (size_t)((row0 + ((it) >> 2) * HALF + ((it) & 3) * 16) & (SEQ - 1)) * 32 + 8 * fq; \
            cs[buf][0][0] = *(const f32x4*)(ropec + t_); cs[buf][0][1] = *(const f32x4*)(ropes + t_); cs[buf][1][0] = *(const f32x4*)(ropec + t_ + 4); cs[buf][1][1] = *(const f32x4*)(ropes + t_ + 4); } while (0)
#pragma unroll
        for (int it = 0; it < 8; ++it) { const int ai = it >> 2, m = it & 3, row = row0 + ai * HALF + m * 16, cb = it & 1;
            EPI_LDR(cb, it);
            const float r = rs[it]; float ss = 0.f;
            f32x4 g1[2], g2[2];
#pragma unroll
            for (int n = 0; n < 2; ++n) { g1[n] = *(const f32x4*)(gain + 8 * fq + 4 * n); g2[n] = *(const f32x4*)(gain + 32 + 8 * fq + 4 * n); }
#pragma unroll
            for (int bj = 0; bj < 2; ++bj)
#pragma unroll
                for (int n = 0; n < 2; ++n) { const f32x4 q = acc[ai][bj][m][n]; ss += (q[0] * q[0] + q[1] * q[1]) + (q[2] * q[2] + q[3] * q[3]); }
            ss += __shfl_xor(ss, 16); ss += __shfl_xor(ss, 32);
            const float sc2 = osc * r * __builtin_amdgcn_rsqf(ss * (r * r) * (1.0f / 64.0f) + 1e-6f);
            f32x4 o1[2], o2[2];
#pragma unroll
            for (int n = 0; n < 2; ++n) { const f32x4 c = cs[cb][n][0], sn = cs[cb][n][1];
                const f32x4 x1 = acc[ai][0][m][n] * sc2 * g1[n], x2 = acc[ai][1][m][n] * sc2 * g2[n];
                o1[n] = x1 * c - x2 * sn; o2[n] = x2 * c + x1 * sn; }
            bf16_t* p = dst + (size_t)row * pitch + colh + 8 * fq;
            *(u32x4*)p = pack8(o1[0], o1[1]); *(u32x4*)(p + 32) = pack8(o2[0], o2[1]); }
#undef EPI_LDR
    }
    __device__ __forceinline__ void operator()(const f32x4 (&acc)[2][2][4][2], const Unit& u, int wr, int wc, int fr, int fq) const {
        const int pn = u.pn;
        if (pn < 2) { normrope(acc, u, wr, fr, fq, (bf16_t*)(ws + EPI_QA), 512, (4 * pn + wc) * 64, qgain, 0.125f * 1.4426950408889634f); }
        else if (pn == 2) {
            if (wc < 2) normrope(acc, u, wr, fr, fq, (bf16_t*)(ws + EPI_KA), 128, wc * 64, kgain, 1.0f);
            else {
                const int row0 = u.pm * BM + wr * 64 + fr;
                float rs[8]; rows_rstd(rs, rtab, wr * 64 + fr);
#pragma unroll
                for (int ai = 0; ai < 2; ++ai)
#pragma unroll
                    for (int m = 0; m < 4; ++m) { const int row = row0 + ai * HALF + m * 16; const float r = rs[ai * 4 + m];
#pragma unroll
                        for (int bj = 0; bj < 2; ++bj) *(u32x4*)((bf16_t*)(ws + EPI_VA) + (size_t)row * 128 + (wc - 2) * 64 + bj * 32 + 8 * fq) = pack8(acc[ai][bj][m][0] * r, acc[ai][bj][m][1] * r); } }
        }
        else if (pn < 5)  plain<0>(acc, u, wr, wc, fr, fq, (bf16_t*)(ws + EPI_QB), 512, (pn - 3) * 256, 0.08838834764831845f);
        else if (pn < 7)  plain<0>(acc, u, wr, wc, fr, fq, (bf16_t*)(ws + EPI_KB), 512, (pn - 5) * 256, 1.0f);
        else if (pn < 11) plain<0>(acc, u, wr, wc, fr, fq, (bf16_t*)(ws + EPI_VB), 1024, (pn - 7) * 256, 1.0f);
        else if (pn < 15) plain<1>(acc, u, wr, wc, fr, fq, (bf16_t*)(ws + EPI_RB), 1024, (pn - 11) * 256, 1.0f);
        else if (pn < 19) plain<2>(acc, u, wr, wc, fr, fq, (bf16_t*)(ws + EPI_GA), 1024, (pn - 15) * 256, 1.0f);
        else if (pn < 23) plain<2>(acc, u, wr, wc, fr, fq, (bf16_t*)(ws + EPI_GB), 1024, (pn - 19) * 256, 1.0f);
        else { if (wc == 0 && fq < 2) { const int row0 = u.pm * BM + wr * 64 + fr; float rs[8]; rows_rstd(rs, rtab, wr * 64 + fr);
#pragma unroll
                for (int ai = 0; ai < 2; ++ai)
#pragma unroll
                    for (int m = 0; m < 4; ++m) { const int row = row0 + ai * HALF + m * 16; const float r = rs[ai * 4 + m];
                        float* p = (float*)(ws + EPI_GLR) + (size_t)row * 16 + 8 * fq; *(f32x4*)p = acc[ai][0][m][0] * r; *(f32x4*)(p + 4) = acc[ai][0][m][1] * r; } } }
    }
};
struct EpiPA {
    static constexpr bool PERM = true, AFTER_DRAIN = false;
    bf16_t* MG;
    __device__ __forceinline__ void operator()(const f32x4 (&acc)[2][2][4][2], const Unit& u, int wr, int wc, int fr, int fq) const {
        const int row0 = u.pm * BM + wr * 64 + fr, col0 = u.pn * BM + wc * 32 + 8 * fq;
        u32x4 gb[2][2];
#define EPI_LDG(buf, it) do { const bf16_t* p_ = MG + (size_t)(row0 + ((it) >> 2) * HALF + ((it) & 3) * 16) * 1024 + col0; gb[buf][0] = *(const u32x4*)p_; gb[buf][1] = *(const u32x4*)(p_ + HALF); } while (0)
        EPI_LDG(0, 0);
#pragma unroll
        for (int it = 0; it < 8; ++it) { const int ai = it >> 2, m = it & 3, row = row0 + ai * HALF + m * 16, cb = it & 1;
            if (it < 7) EPI_LDG(cb ^ 1, it + 1);
            asm volatile("" ::: "memory");
#pragma unroll
            for (int bj = 0; bj < 2; ++bj) { const u32x4 g = gb[cb][bj];
                const f32x4 g0 = {bf_lo(g.x), bf_hi(g.x), bf_lo(g.y), bf_hi(g.y)}, g1 = {bf_lo(g.z), bf_hi(g.z), bf_lo(g.w), bf_hi(g.w)};
                *(u32x4*)(MG + (size_t)row * 1024 + col0 + bj * HALF) = pack8(acc[ai][bj][m][0] * g0, acc[ai][bj][m][1] * g1); } }
#undef EPI_LDG
    }
};
struct EpiPB {
    static constexpr bool PERM = true, AFTER_DRAIN = false;
    bf16_t* MG; const bf16_t* GB;
    __device__ __forceinline__ void operator()(const f32x4 (&acc)[2][2][4][2], const Unit& u, int wr, int wc, int fr, int fq) const {
        const int row0 = u.pm * BM + wr * 64 + fr, col0 = u.pn * BM + wc * 32 + 8 * fq;
        u32x4 ab[2][2], gb[2][2];
#define EPI_LDG(buf, it) do { const size_t o_ = (size_t)(row0 + ((it) >> 2) * HALF + ((it) & 3) * 16) * 1024 + col0; ab[buf][0] = *(const u32x4*)(MG + o_); ab[buf][1] = *(const u32x4*)(MG + o_ + HALF); \
            gb[buf][0] = *(const u32x4*)(GB + o_); gb[buf][1] = *(const u32x4*)(GB + o_ + HALF); } while (0)
        EPI_LDG(0, 0);
#pragma unroll
        for (int it = 0; it < 8; ++it) { const int ai = it >> 2, m = it & 3, row = row0 + ai * HALF + m * 16, cb = it & 1;
            if (it < 7) EPI_LDG(cb ^ 1, it + 1);
            asm volatile("" ::: "memory");
#pragma unroll
            for (int bj = 0; bj < 2; ++bj) { const u32x4 a = ab[cb][bj], g = gb[cb][bj];
                const f32x4 a0 = {bf_lo(a.x), bf_hi(a.x), bf_lo(a.y), bf_hi(a.y)}, a1 = {bf_lo(a.z), bf_hi(a.z), bf_lo(a.w), bf_hi(a.w)};
                const f32x4 g0 = {bf_lo(g.x), bf_hi(g.x), bf_lo(g.y), bf_hi(g.y)}, g1 = {bf_lo(g.z), bf_hi(g.z), bf_lo(g.w), bf_hi(g.w)};
                *(u32x4*)(MG + (size_t)row * 1024 + col0 + bj * HALF) = pack8(a0 + acc[ai][bj][m][0] * g0, a1 + acc[ai][bj][m][1] * g1); } }
#undef EPI_LDG
    }
};

template <class Epi, class Sched, bool ALIGN_EPI = false, bool SP2 = false>
__device__ __forceinline__ void gemm_phase(PG8_LAS unsigned char* lds, const Gemm g, const Sched& S, const Epi& E) {
    int tid_l = threadIdx.x; asm volatile("" : "+v"(tid_l));
    const int tid = tid_l, wid = __builtin_amdgcn_readfirstlane(tid >> 6), lane = tid & 63, wr = wid >> 2, wc = wid & 3, fr = lane & 15, fq = lane >> 4;
    const int K = g.K, nt = K / BK;
    unsigned voffA[2], voffB[2];
#pragma unroll
    for (int i = 0; i < 2; ++i) { int R, C; stage_rc(tid * 16 + i * 8192, R, C); const int Rb = Epi::PERM ? ((R & ~31) + perm32(R & 31)) : R;
        voffA[i] = (unsigned)(R * K + C) * 2u; voffB[i] = (unsigned)(Rb * K + C) * 2u; }
    const size_t kstep = (size_t)(BK * 2);
    const size_t hstep = (size_t)HALF * K * 2;
    const size_t tstep = 2 * hstep;
    const unsigned ldsw = (unsigned)wid * 1024u;
    const int aoff = lds_byte(wr * 64 + fr, fq * 8), boff = lds_byte(wc * 32 + fr, fq * 8);
#define PG8_SA(b, h) (((b) * 2 + (h)) * HTB)
#define PG8_SB(b, h) ((4 + (b) * 2 + (h)) * HTB)
#define PG8_STAGE(bufoff, gbase, voff) do { _Pragma("unroll") for (int _i = 0; _i < 2; ++_i) \
        __builtin_amdgcn_global_load_lds((const unsigned*)((const char*)(gbase) + (voff)[_i]), (PG8_LAS unsigned*)(lds + (bufoff) + ldsw + _i * 8192), 16, 0, 0); } while (0)
#define PG8_LDA(dst, b, h) do { _Pragma("unroll") for (int m = 0; m < 4; ++m) _Pragma("unroll") for (int k = 0; k < 2; ++k) dst[m][k] = *(const PG8_LAS bf16x8*)(lds + PG8_SA(b, h) + aoff + m * 2048 + k * 1024); } while (0)
#define PG8_LDB(dst, b, h) do { _Pragma("unroll") for (int n = 0; n < 2; ++n) _Pragma("unroll") for (int k = 0; k < 2; ++k) dst[n][k] = *(const PG8_LAS bf16x8*)(lds + PG8_SB(b, h) + boff + n * 2048 + k * 1024); } while (0)
#define PG8_MMA(ai, bj, At, Bt) do { __builtin_amdgcn_s_setprio(1); _Pragma("unroll") for (int m = 0; m < 4; ++m) _Pragma("unroll") for (int n = 0; n < 2; ++n) _Pragma("unroll") for (int k = 0; k < 2; ++k) \
        acc[ai][bj][m][n] = __builtin_amdgcn_mfma_f32_16x16x32_bf16(Bt[n][k], At[m][k], acc[ai][bj][m][n], 0, 0, 0); __builtin_amdgcn_s_setprio(0); } while (0)
#define PG8_WAIT_V(n) asm volatile("s_waitcnt vmcnt(" #n ")" ::: "memory")
#define PG8_WAIT_L(n) asm volatile("s_waitcnt lgkmcnt(" #n ")" ::: "memory")
#define PG8_BAR __builtin_amdgcn_s_barrier()
#define PG8_SCHED __builtin_amdgcn_sched_barrier(0)
    Unit cur, nxt; int ui = 0;
    if (!S.next(0, cur)) return;
    f32x4 acc[2][2][4][2];
#pragma unroll
    for (int a = 0; a < 2; ++a)
#pragma unroll
        for (int b = 0; b < 2; ++b)
#pragma unroll
            for (int m = 0; m < 4; ++m)
#pragma unroll
                for (int n = 0; n < 2; ++n) acc[a][b][m][n] = (f32x4){0.f, 0.f, 0.f, 0.f};
    bf16x8 At[4][2], B0[2][2], B1[2][2];
    const char* cA = (const char*)g.A + (size_t)cur.pm * tstep; const char* cB = (const char*)g.Bt + (size_t)cur.pn * tstep;
    S.a_ready(cur);
    if constexpr (SP2) {
        PG8_STAGE(PG8_SB(0, 0), cB, voffB); PG8_STAGE(PG8_SB(0, 1), cB + hstep, voffB); PG8_STAGE(PG8_SA(0, 0), cA, voffA); PG8_STAGE(PG8_SA(0, 1), cA + hstep, voffA);
        if (wr == 1) PG8_BAR;
        PG8_WAIT_V(2); PG8_BAR;
        PG8_STAGE(PG8_SB(1, 0), cB + kstep, voffB); PG8_STAGE(PG8_SA(1, 0), cA + kstep, voffA); PG8_STAGE(PG8_SB(1, 1), cB + hstep + kstep, voffB);
        PG8_WAIT_V(6); PG8_BAR;
    } else {
        PG8_STAGE(PG8_SB(0, 0), cB, voffB); PG8_STAGE(PG8_SA(0, 0), cA, voffA); PG8_STAGE(PG8_SB(0, 1), cB + hstep, voffB); PG8_STAGE(PG8_SA(0, 1), cA + hstep, voffA);
        if (wr == 1) PG8_BAR;
        PG8_WAIT_V(4); PG8_BAR;
        PG8_STAGE(PG8_SB(1, 0), cB + kstep, voffB); PG8_STAGE(PG8_SA(1, 0), cA + kstep, voffA); PG8_STAGE(PG8_SB(1, 1), cB + hstep + kstep, voffB);
        PG8_WAIT_V(6); PG8_BAR;
    }
    for (;;) {
        const bool has_next = S.next(ui + 1, nxt);
        const char* nA = has_next ? (const char*)g.A + (size_t)nxt.pm * tstep : cA; const char* nB = has_next ? (const char*)g.Bt + (size_t)nxt.pn * tstep : cB;
        for (int t = 0; t < nt; t += 2) {
            const bool last = (t == nt - 2);
            const char* a1 = cA + (size_t)(t + 1) * kstep;
            const char* a2 = last ? nA : cA + (size_t)(t + 2) * kstep; const char* b2 = last ? nB : cB + (size_t)(t + 2) * kstep;
            const char* a3 = a2 + kstep; const char* b3 = b2 + kstep;
            if (last && has_next) S.a_ready(nxt);
            if constexpr (SP2) {
            PG8_LDB(B0, 0, 0); PG8_LDB(B1, 0, 1); PG8_SCHED; PG8_LDA(At, 0, 0); PG8_STAGE(PG8_SA(1, 1), a1 + hstep, voffA);
            PG8_WAIT_V(8); PG8_WAIT_L(0); PG8_BAR; PG8_MMA(0, 0, At, B0); PG8_MMA(0, 1, At, B1); PG8_BAR; PG8_SCHED;
            PG8_LDA(At, 0, 1); PG8_STAGE(PG8_SB(0, 0), b2, voffB); PG8_STAGE(PG8_SB(0, 1), b2 + hstep, voffB); PG8_STAGE(PG8_SA(0, 0), a2, voffA);
            PG8_WAIT_V(8); PG8_WAIT_L(0); PG8_BAR; PG8_MMA(1, 0, At, B0); PG8_MMA(1, 1, At, B1); PG8_BAR; PG8_SCHED;
            PG8_LDB(B0, 1, 0); PG8_LDB(B1, 1, 1); PG8_SCHED; PG8_LDA(At, 1, 0); PG8_STAGE(PG8_SA(0, 1), a2 + hstep, voffA);
            PG8_WAIT_V(8); PG8_WAIT_L(0); PG8_BAR; PG8_MMA(0, 0, At, B0); PG8_MMA(0, 1, At, B1); PG8_BAR; PG8_SCHED;
            PG8_LDA(At, 1, 1); PG8_STAGE(PG8_SB(1, 0), b3, voffB); PG8_STAGE(PG8_SB(1, 1), b3 + hstep, voffB); PG8_STAGE(PG8_SA(1, 0), a3, voffA);
            PG8_WAIT_V(8); PG8_WAIT_L(0); PG8_BAR; PG8_MMA(1, 0, At, B0); PG8_MMA(1, 1, At, B1); PG8_BAR; PG8_SCHED;
            } else {
            PG8_LDB(B0, 0, 0); PG8_SCHED; PG8_LDA(At, 0, 0); PG8_STAGE(PG8_SA(1, 1), a1 + hstep, voffA);
            PG8_WAIT_L(8); PG8_BAR; PG8_WAIT_L(0); PG8_MMA(0, 0, At, B0); PG8_BAR; PG8_SCHED;
            PG8_LDB(B1, 0, 1); PG8_STAGE(PG8_SB(0, 0), b2, voffB);
            PG8_BAR; PG8_WAIT_L(0); PG8_MMA(0, 1, At, B1); PG8_BAR;
            PG8_LDA(At, 0, 1); PG8_STAGE(PG8_SA(0, 0), a2, voffA);
            PG8_BAR; PG8_WAIT_L(0); PG8_MMA(1, 0, At, B0); PG8_BAR; PG8_SCHED;
            PG8_STAGE(PG8_SB(0, 1), b2 + hstep, voffB);
            PG8_WAIT_V(6); PG8_BAR; PG8_MMA(1, 1, At, B1); PG8_BAR;
            PG8_LDB(B0, 1, 0); PG8_SCHED; PG8_LDA(At, 1, 0); PG8_STAGE(PG8_SA(0, 1), a2 + hstep, voffA);
            PG8_WAIT_L(8); PG8_BAR; PG8_WAIT_L(0); PG8_MMA(0, 0, At, B0); PG8_BAR; PG8_SCHED;
            PG8_LDB(B1, 1, 1); PG8_STAGE(PG8_SB(1, 0), b3, voffB);
            PG8_BAR; PG8_WAIT_L(0); PG8_MMA(0, 1, At, B1); PG8_BAR;
            PG8_LDA(At, 1, 1); PG8_STAGE(PG8_SA(1, 0), a3, voffA);
            PG8_BAR; PG8_WAIT_L(0); PG8_MMA(1, 0, At, B0); PG8_BAR; PG8_SCHED;
            PG8_STAGE(PG8_SB(1, 1), b3 + hstep, voffB);
            PG8_WAIT_V(6); PG8_BAR; PG8_MMA(1, 1, At, B1); PG8_BAR;
            }
        }
        if constexpr (ALIGN_EPI) { if (wr == 0) PG8_BAR; }
        if constexpr (!Epi::AFTER_DRAIN) { E(acc, cur, wr, wc, fr, fq); S.done(cur); }
        if (!has_next) break;
#pragma unroll
        for (int a = 0; a < 2; ++a)
#pragma unroll
            for (int b = 0; b < 2; ++b)
#pragma unroll
                for (int m = 0; m < 4; ++m)
#pragma unroll
                    for (int n = 0; n < 2; ++n) acc[a][b][m][n] = (f32x4){0.f, 0.f, 0.f, 0.f};
        cur = nxt; cA = nA; cB = nB; ++ui;
        if constexpr (ALIGN_EPI) { if (wr == 1) PG8_BAR; }
    }
    PG8_WAIT_V(0);
    if constexpr (!ALIGN_EPI) { if (wr == 0) PG8_BAR; }
    PG8_BAR;
    if constexpr (Epi::AFTER_DRAIN) { E.fused(acc, cur, wr, wc, fr, fq, lds, wid, lane); S.done(cur); }
#undef PG8_SA
#undef PG8_SB
#undef PG8_STAGE
#undef PG8_LDA
#undef PG8_LDB
#undef PG8_MMA
#undef PG8_WAIT_V
#undef PG8_WAIT_L
#undef PG8_BAR
#undef PG8_SCHED
}
}
#define GAS __attribute__((address_space(1)))
#define LAS __attribute__((address_space(3)))
typedef unsigned short bf16;
typedef unsigned v4u __attribute__((ext_vector_type(4)));
typedef float f32x4 __attribute__((ext_vector_type(4)));
typedef short bf16x8 __attribute__((ext_vector_type(8)));
typedef GAS unsigned gu32;
typedef GAS unsigned long long gu64;
#define RLX_AGENT __ATOMIC_RELAXED, __HIP_MEMORY_SCOPE_AGENT
#define LDS_WAIT() asm volatile("s_waitcnt lgkmcnt(0)" ::: "memory")
#define VM_WAIT() asm volatile("s_waitcnt vmcnt(0)" ::: "memory")
__device__ __forceinline__ unsigned long long rt() { return __builtin_amdgcn_s_memrealtime(); }
__device__ __forceinline__ unsigned f2bf(float f) { unsigned u = __builtin_bit_cast(unsigned, f); return (u + 0x7fffu + ((u >> 16) & 1u)) >> 16; }
__device__ __forceinline__ unsigned pk2(float lo, float hi) { return f2bf(lo) | (f2bf(hi) << 16); }

#define XB_TMO      128
#define XB_XCNT(j)  (256  + 64 * (j))
#define XB_XSUB(j)  (1280 + 64 * (j))
#define XB_XGEN(j)  (2304 + 64 * (j))
#define XB_TOP      3328
#define XB_TOPGEN   3392
#define XCD_BAR_WORDS 3456
#define XB_SPIN_CAP (1u << 18)

__device__ __forceinline__ unsigned xb_ld(unsigned* p)              { return __hip_atomic_load(p, __ATOMIC_RELAXED, __HIP_MEMORY_SCOPE_AGENT); }
__device__ __forceinline__ unsigned xb_add(unsigned* p, unsigned v) { return __hip_atomic_fetch_add(p, v, __ATOMIC_RELAXED, __HIP_MEMORY_SCOPE_AGENT); }
__device__ __forceinline__ unsigned xb_xcc_id() { return (unsigned)__builtin_amdgcn_s_getreg((3 << 11) | 20) & 0xFu; }
#define XB_SPIN(cond, bar) do { unsigned _sp = 0; while (cond) { __builtin_amdgcn_s_sleep(1); \
    if ((++_sp & 255u) == 0u) { if (xb_ld(&(bar)[XB_TMO])) break; if (_sp > XB_SPIN_CAP) { atomicAdd(&(bar)[XB_TMO], 1u); break; } } } } while (0)

struct XcdBarrier {
    unsigned* bar; unsigned x;
    volatile LAS unsigned* st;
};

__device__ __forceinline__ XcdBarrier xcd_barrier_post(unsigned* bar, volatile LAS unsigned* st) {
    XcdBarrier b; b.bar = bar; b.x = xb_xcc_id(); b.st = st;
    if (threadIdx.x == 0) (void)xb_add(&bar[XB_XCNT(b.x)], 1u);
    return b;
}
__device__ __forceinline__ void xcd_barrier_complete(unsigned* bar, unsigned x, unsigned& nloc, unsigned& nx) {
    const unsigned G = gridDim.x * gridDim.y * gridDim.z;
    unsigned sum, cnt, mine, sp = 0u;
    for (;;) {
        sum = 0u; cnt = 0u; mine = 0u;
#pragma unroll
        for (unsigned j = 0; j < 16; ++j) { const unsigned c = xb_ld(&bar[XB_XCNT(j)]); sum += c; cnt += (c > 0u) ? 1u : 0u; mine = (j == x) ? c : mine; }
        if (sum == G) break;
        __builtin_amdgcn_s_sleep(1);
        if ((++sp & 255u) == 0u) { if (xb_ld(&bar[XB_TMO])) break; if (sp > XB_SPIN_CAP) { atomicAdd(&bar[XB_TMO], 1u); break; } }
    }
    nloc = mine > 0u ? mine : 1u; nx = cnt > 0u ? cnt : 1u;
}

__device__ __noinline__ void xcd_barrier_fn(unsigned* bbar, unsigned bx_, volatile LAS unsigned* bst) {
    XcdBarrier b; b.bar = bbar; b.x = bx_; b.st = bst;
    asm volatile("s_waitcnt vmcnt(0)" ::: "memory");
    __syncthreads();
    if (threadIdx.x == 0) {
        unsigned* bar = b.bar;
        __builtin_amdgcn_s_waitcnt(0);
        unsigned nloc = b.st[0], nx = b.st[1];
        if (nloc == 0u) { xcd_barrier_complete(bar, b.x, nloc, nx); b.st[0] = nloc; b.st[1] = nx; }
        const unsigned old = xb_add(&bar[XB_XSUB(b.x)], 1u);
        const unsigned gen = old / nloc;
        if (old + 1u == (gen + 1u) * nloc) {
            __builtin_amdgcn_fence(__ATOMIC_RELEASE, "agent");
            asm volatile("s_waitcnt vmcnt(0)" ::: "memory");
            const unsigned og = xb_add(&bar[XB_TOP], 1u);
            const unsigned tg = og / nx;
            if (og + 1u == (tg + 1u) * nx) xb_add(&bar[XB_TOPGEN], 1u);
            else XB_SPIN(xb_ld(&bar[XB_TOPGEN]) == tg, bar);
            __builtin_amdgcn_fence(__ATOMIC_ACQUIRE, "agent");
            xb_add(&bar[XB_XGEN(b.x)], 1u);
            asm volatile("s_waitcnt vmcnt(0)" ::: "memory");
        } else {
            XB_SPIN(xb_ld(&bar[XB_XGEN(b.x)]) == gen, bar);
            __builtin_amdgcn_fence(__ATOMIC_ACQUIRE, "agent");
            asm volatile("s_waitcnt vmcnt(0)" ::: "memory");
        }
    }
    __syncthreads();
}

__device__ __forceinline__ void xcd_barrier(const XcdBarrier& b) { xcd_barrier_fn(b.bar, b.x, b.st); }
typedef unsigned u32x4 __attribute__((ext_vector_type(4)));

typedef short s16x4 __attribute__((ext_vector_type(4)));
typedef float f32x16 __attribute__((ext_vector_type(16)));
typedef float f32x2_t __attribute__((ext_vector_type(2)));
typedef __bf16 bf16x2_t __attribute__((ext_vector_type(2)));
typedef short v4i16_t __attribute__((ext_vector_type(4)));
typedef unsigned u32x2 __attribute__((ext_vector_type(2)));
#define MFMA32(a, b, c) __builtin_amdgcn_mfma_f32_32x32x16_bf16((a), (b), (c), 0, 0, 0)
__device__ __forceinline__ int crow(int r, int hi) { return (r & 3) + 8 * (r >> 2) + 4 * hi; }
__device__ __forceinline__ unsigned cvtpk(float lo, float hi) { f32x2_t v = {lo, hi}; bf16x2_t b = __builtin_convertvector(v, bf16x2_t); return __builtin_bit_cast(unsigned, b); }
__device__ __forceinline__ s16x4 tr_rd(LAS const unsigned char* p) { return __builtin_bit_cast(s16x4, __builtin_amdgcn_ds_read_tr16_b64_v4i16((LAS v4i16_t*)p)); }
__device__ __forceinline__ bf16x8 cat8(s16x4 lo, s16x4 hi) { return __builtin_shufflevector(lo, hi, 0, 1, 2, 3, 4, 5, 6, 7); }
__device__ __forceinline__ bf16x8 pack_step(const f32x16& x, int s) {
    u32x4 p; p.x = cvtpk(x[8 * s], x[8 * s + 1]); p.y = cvtpk(x[8 * s + 2], x[8 * s + 3]); p.z = cvtpk(x[8 * s + 4], x[8 * s + 5]); p.w = cvtpk(x[8 * s + 6], x[8 * s + 7]);
    return __builtin_bit_cast(bf16x8, p);
}
__device__ __forceinline__ bf16x8 row_frag(LAS const unsigned char* p) { const s16x4 lo = *(LAS const s16x4*)p, hi = *(LAS const s16x4*)(p + 16); return cat8(lo, hi); }

namespace swa {
constexpr int KOFF = 0, VOFF = 3 * 8192, LDS_NEED = 6 * 8192, NUNITS = BATCH * 2 * (SEQ / 64);
__device__ __forceinline__ void unit(int un, const bf16* QA, const bf16* KA, const bf16* VA, bf16* OA, const float* sinks, LAS unsigned char* lds, int tid) {
    const int lane = tid & 63, r32 = lane & 31, hi = lane >> 5, w = __builtin_amdgcn_readfirstlane(tid >> 6);
    const int i = un & 127, hk = (un >> 7) & 1, b = un >> 8;
    const size_t rowb = (size_t)b * SEQ;
#pragma unroll
    for (int jt = 0; jt < 3; ++jt) {
        const int ti = i - 2 + jt; u32x4 kv = {0u, 0u, 0u, 0u}, vv = {0u, 0u, 0u, 0u};
        if (ti >= 0) {
            kv = *(const u32x4*)(KA + (rowb + ti * 64 + (tid & 63)) * 128 + hk * 64 + (tid >> 6) * 8);
            vv = *(const u32x4*)(VA + (rowb + ti * 64 + 16 * (w & 3) + (lane >> 2)) * 128 + hk * 64 + (w >> 2) * 32 + (lane & 3) * 8);
        }
        *(LAS u32x4*)(lds + KOFF + jt * 8192 + (tid >> 6) * 1024 + (tid & 63) * 16) = kv;
        *(LAS u32x4*)(lds + VOFF + jt * 8192 + tid * 16) = vv;
    }
    const int hq = 4 * hk + (w >> 1), qh = w & 1;
    const bf16* qp = QA + (rowb + 64 * i + 32 * qh + r32) * 512 + hq * 64 + hi * 8;
    bf16x8 qr[4];
#pragma unroll
    for (int d0 = 0; d0 < 4; ++d0) qr[d0] = *(const bf16x8*)(qp + d0 * 16);
    const float sink2 = sinks[hq] * LOG2E;
    __syncthreads();
    f32x16 p[5];
    const int tq = 64 * i + 32 * qh + r32;
    float mx = -INFINITY;
#pragma unroll
    for (int j = 0; j < 5; ++j) {
        const int st = qh + j, jt = st >> 1, kh = st & 1;
        f32x16 a = {};
#pragma unroll
        for (int d0 = 0; d0 < 4; ++d0) { const bf16x8 kf = *(LAS const bf16x8*)(lds + KOFF + jt * 8192 + (2 * d0 + hi) * 1024 + (32 * kh + r32) * 16); a = MFMA32(kf, qr[d0], a); }
        const int tk0 = 64 * (i - 2) + 32 * st;
#pragma unroll
        for (int r = 0; r < 16; ++r) { const int tk = tk0 + crow(r, hi); const bool ok = (tk >= 0) && (tk <= tq) && (tq - tk < 128); a[r] = ok ? a[r] : -INFINITY; mx = fmaxf(mx, a[r]); }
        p[j] = a;
    }
    mx = fmaxf(mx, __shfl_xor(mx, 32));
    const float mm = fmaxf(mx, sink2);
    float sum = 0.f;
#pragma unroll
    for (int j = 0; j < 5; ++j)
#pragma unroll
        for (int r = 0; r < 16; ++r) { const float e = __builtin_amdgcn_exp2f(p[j][r] - mm); p[j][r] = e; sum += e; }
    sum += __shfl_xor(sum, 32);
    const float inv = 1.0f / (sum + __builtin_amdgcn_exp2f(sink2 - mm));
    f32x16 o[2] = {{}, {}};
    LAS const unsigned char* vb = lds + VOFF + ((lane >> 4) & 1) * 32 + (lane & 3) * 8 + (4 * hi + ((lane & 15) >> 2)) * 64;
#pragma unroll
    for (int j = 0; j < 5; ++j) {
        const int st = qh + j, jt = st >> 1, kh = st & 1;
#pragma unroll
        for (int s = 0; s < 2; ++s) { const bf16x8 pf = pack_step(p[j], s); const int ks = 2 * kh + s;
#pragma unroll
            for (int d0 = 0; d0 < 2; ++d0) { LAS const unsigned char* vp = vb + jt * 8192 + d0 * 4096 + ks * 1024; const bf16x8 vf = cat8(tr_rd(vp), tr_rd(vp + 512)); o[d0] = MFMA32(vf, pf, o[d0]); } }
    }
    bf16* op = OA + (rowb + 64 * i + 32 * qh + r32) * 512 + hq * 64 + 4 * hi;
#pragma unroll
    for (int d0 = 0; d0 < 2; ++d0)
#pragma unroll
        for (int g = 0; g < 4; ++g) { u32x2 wv; wv.x = cvtpk(o[d0][4 * g] * inv, o[d0][4 * g + 1] * inv); wv.y = cvtpk(o[d0][4 * g + 2] * inv, o[d0][4 * g + 3] * inv); *(u32x2*)(op + 32 * d0 + 8 * g) = wv; }
    __syncthreads();
}
}

#ifndef G3SEC
#define G3SEC 0
#endif
__device__ __noinline__ void probe_fn(int mode);
#define SEC_B(k) do { if (G3SEC == (k) && blockIdx.x == 0) probe_fn(0); } while (0)
#define SEC_E(k) do { if (G3SEC == (k) && blockIdx.x == 0) probe_fn(1); } while (0)
namespace gla {
constexpr int PQ = 264, PK3 = 320, PV = 576, PA = 136;
constexpr int O_Q1 = 0, O_Q2 = 16896, O_K2 = 33792, O_K3 = 50688, O_V = 71168, O_A = 108032, O_GLR = 116736, O_TOT = 120832, O_DV = 124928, O_PART = 125440, LDS_NEED = 127488;
constexpr int O_WG = 131072 + 2048;
constexpr int NSEG = 32, CPS = 4, NUNITS = 8 * NSEG, SELEMS = 128 * 256, SPAIRS = SELEMS / 2;
__device__ __forceinline__ unsigned short f2bf(float f) { unsigned u = __builtin_bit_cast(unsigned, f); return (unsigned short)((u + 0x7fffu + ((u >> 16) & 1u)) >> 16); }
__device__ __forceinline__ float bf2f(unsigned short h) { return __builtin_bit_cast(float, (unsigned)h << 16); }
__device__ __forceinline__ float logsig(float x) { return fminf(x, 0.f) - __logf(1.f + __expf(-fabsf(x))); }

struct KgRegs { u32x4 q[2], k[2]; f32x4 g; };
struct VRegs { u32x4 v[4]; };
template <bool FULL> __device__ __forceinline__ void fetch_kg(KgRegs& R, const bf16* QB, const bf16* KB, const float* GLR, size_t r0, int h, int tid) {
#pragma unroll
    for (int i = 0; i < 2; ++i) { const int p = tid + 512 * i, row = p >> 4, c = p & 15;
        R.k[i] = *(const u32x4*)(KB + (r0 + row) * 512 + h * 128 + c * 8);
        if (FULL) R.q[i] = *(const u32x4*)(QB + (r0 + row) * 512 + h * 128 + c * 8); }
    R.g = (f32x4){0.f, 0.f, 0.f, 0.f};
    if (tid < 256) R.g = *(const f32x4*)(GLR + r0 * 16 + tid * 4);
}
__device__ __forceinline__ void fetch_v(VRegs& R, const bf16* VB, size_t r0, int h, int tid) {
#pragma unroll
    for (int i = 0; i < 4; ++i) { const int p = tid + 512 * i, row = p >> 5, c = p & 31; R.v[i] = *(const u32x4*)(VB + (r0 + row) * 1024 + h * 256 + c * 8); }
}
template <bool FULL> __device__ __forceinline__ void put_kg(const KgRegs& R, LAS unsigned char* lds, int tid) {
#pragma unroll
    for (int i = 0; i < 2; ++i) { const int p = tid + 512 * i, row = p >> 4, c = p & 15;
        LAS u32x2* kd = (LAS u32x2*)(lds + O_K2 + row * PQ + c * 16); kd[0] = (u32x2){R.k[i].x, R.k[i].y}; kd[1] = (u32x2){R.k[i].z, R.k[i].w};
        if (FULL) { LAS u32x2* qd = (LAS u32x2*)(lds + O_Q1 + row * PQ + c * 16); qd[0] = (u32x2){R.q[i].x, R.q[i].y}; qd[1] = (u32x2){R.q[i].z, R.q[i].w}; } }
    if (tid < 256) *(LAS f32x4*)(lds + O_GLR + tid * 16) = R.g;
}
__device__ __forceinline__ void put_v(const VRegs& R, LAS unsigned char* lds, int tid) {
#pragma unroll
    for (int i = 0; i < 4; ++i) { const int p = tid + 512 * i, row = p >> 5, c = p & 31; *(LAS u32x4*)(lds + O_V + row * PV + c * 16) = R.v[i]; }
}
__device__ __forceinline__ void load_wg(const float* wgate, const float* gbias, int h, LAS unsigned char* lds, int tid) {
    LAS float* W = (LAS float*)(lds + O_WG);
#pragma unroll
    for (int i = 0; i < 4; ++i) { const int e = tid + 512 * i, j = e >> 7, c = e & 127; W[e] = wgate[j * 512 + h * 128 + c]; }
    if (tid < 128) W[2048 + tid] = gbias[h * 128 + tid];
}
template <bool FULL> __device__ __forceinline__ void prep(LAS unsigned char* lds, int tid, float& blast0, float& blast1) {
    const int cp = tid & 63, w = tid >> 6;
    __syncthreads();
    LAS const float* W = (LAS const float*)(lds + O_WG);
    float wa[16], wb[16];
#pragma unroll
    for (int j = 0; j < 16; ++j) { const f32x2_t t = *(LAS const f32x2_t*)(W + j * 128 + 2 * cp); wa[j] = t.x; wb[j] = t.y; }
    const f32x2_t bias = *(LAS const f32x2_t*)(W + 2048 + 2 * cp);
    float bl0[8], bl1[8]; float run0 = 0.f, run1 = 0.f;
#pragma unroll
    for (int i = 0; i < 8; ++i) { LAS const f32x4* g = (LAS const f32x4*)(lds + O_GLR + (8 * w + i) * 64); const f32x4 g0 = g[0], g1 = g[1], g2 = g[2], g3 = g[3];
        float x0 = bias.x, x1 = bias.y;
#pragma unroll
        for (int j = 0; j < 4; ++j) { x0 += g0[j] * wa[j]; x1 += g0[j] * wb[j]; }
#pragma unroll
        for (int j = 0; j < 4; ++j) { x0 += g1[j] * wa[4 + j]; x1 += g1[j] * wb[4 + j]; }
#pragma unroll
        for (int j = 0; j < 4; ++j) { x0 += g2[j] * wa[8 + j]; x1 += g2[j] * wb[8 + j]; }
#pragma unroll
        for (int j = 0; j < 4; ++j) { x0 += g3[j] * wa[12 + j]; x1 += g3[j] * wb[12 + j]; }
        run0 += logsig(x0) * 0.0625f; run1 += logsig(x1) * 0.0625f; bl0[i] = run0; bl1[i] = run1; }
    LAS f32x2_t* TOT = (LAS f32x2_t*)(lds + O_TOT);
    TOT[w * 64 + cp] = (f32x2_t){run0, run1};
    __syncthreads();
    float pre0 = 0.f, pre1 = 0.f, rr0 = 0.f, rr1 = 0.f, bt0 = 0.f, bt1 = 0.f;
#pragma unroll
    for (int g = 0; g < 8; ++g) { const f32x2_t t = TOT[g * 64 + cp]; if (g < w) { pre0 += t.x; pre1 += t.y; } if (g < 4) { rr0 += t.x; rr1 += t.y; } bt0 += t.x; bt1 += t.y; }
    const float c40 = __expf(bt0), c41 = __expf(bt1), c20 = __expf(-rr0), c21 = __expf(-rr1), c30 = __expf(rr0), c31 = __expf(rr1);
#pragma unroll
    for (int i = 0; i < 8; ++i) { const int t = 8 * w + i; const float e10 = __expf(pre0 + bl0[i]), e11 = __expf(pre1 + bl1[i]); const float i10 = __builtin_amdgcn_rcpf(e10), i11 = __builtin_amdgcn_rcpf(e11);
        const unsigned kk = *(LAS const unsigned*)(lds + O_K2 + t * PQ + cp * 4); const float k0 = __builtin_bit_cast(float, kk << 16), k1 = __builtin_bit_cast(float, kk & 0xffff0000u);
        *(LAS unsigned*)(lds + O_K3 + t * PK3 + cp * 4) = cvtpk(k0 * (i10 * c40), k1 * (i11 * c41));
        if (FULL) { const unsigned qq = *(LAS const unsigned*)(lds + O_Q1 + t * PQ + cp * 4); const float q0 = __builtin_bit_cast(float, qq << 16), q1 = __builtin_bit_cast(float, qq & 0xffff0000u);
            *(LAS unsigned*)(lds + O_Q1 + t * PQ + cp * 4) = cvtpk(q0 * e10, q1 * e11);
            *(LAS unsigned*)(lds + O_Q2 + t * PQ + cp * 4) = cvtpk(q0 * (e10 * c20), q1 * (e11 * c21));
            *(LAS unsigned*)(lds + O_K2 + t * PQ + cp * 4) = cvtpk(k0 * (i10 * c30), k1 * (i11 * c31)); } }
    if (w == 7) *(LAS f32x2_t*)(lds + O_DV + cp * 8) = (f32x2_t){c40, c41};
    blast0 = bt0; blast1 = bt1;
}
__device__ __forceinline__ void state_update(f32x16 (&S)[4], LAS unsigned char* lds, int w, int lane) {
    const int hi = lane >> 5, i16 = lane & 15, g16 = (lane >> 4) & 1;
    LAS const float* DVp = (LAS const float*)(lds + O_DV);
#pragma unroll
    for (int tile = 0; tile < 4; ++tile) {
#pragma unroll
        for (int r = 0; r < 16; ++r) S[tile][r] *= DVp[32 * tile + crow(r, hi)];
        asm volatile("" ::: "memory"); }
    LAS const unsigned char* vb = lds + O_V + (4 * hi + (i16 >> 2)) * PV + (32 * w + 16 * g16 + 4 * (i16 & 3)) * 2;
    LAS const unsigned char* kb = lds + O_K3 + (4 * hi + (i16 >> 2)) * PK3 + (16 * g16 + 4 * (i16 & 3)) * 2;
#pragma unroll
    for (int ks = 0; ks < 4; ++ks) { const bf16x8 vf = cat8(tr_rd(vb + ks * 16 * PV), tr_rd(vb + (ks * 16 + 8) * PV));
#pragma unroll
        for (int tile = 0; tile < 4; ++tile) { const bf16x8 kf = cat8(tr_rd(kb + ks * 16 * PK3 + tile * 64), tr_rd(kb + (ks * 16 + 8) * PK3 + tile * 64)); S[tile] = MFMA32(kf, vf, S[tile]); } }
}
struct Tensors { const bf16 *QB, *KB, *VB, *RB; bf16* OB; const float *GLR, *wgate, *gbias, *onorm; float *R, *SST, *DSEG; };

__device__ __forceinline__ void g1_unit(int un, const Tensors& T, LAS unsigned char* lds, int tid) {
    const int lane = tid & 63, w = __builtin_amdgcn_readfirstlane(tid >> 6);
    const int chain = un >> 5, seg = un & 31, b = chain >> 2, h = chain & 3;
    const size_t rb = (size_t)b * SEQ + (size_t)(seg * CPS) * 64;
    KgRegs KG; fetch_kg<false>(KG, T.QB, T.KB, T.GLR, rb, h, tid);
    load_wg(T.wgate, T.gbias, h, lds, tid);
    f32x16 S[4] = {{}, {}, {}, {}}; float bs0 = 0.f, bs1 = 0.f;
#pragma unroll 1
    for (int c = 0; c < CPS; ++c) {
        int tl = tid; asm volatile("" : "+v"(tl));
        put_kg<false>(KG, lds, tl);
        VRegs VR; fetch_v(VR, T.VB, rb + (size_t)c * 64, h, tl);
        float b0, b1; prep<false>(lds, tid, b0, b1); bs0 += b0; bs1 += b1;
        if (c + 1 < CPS) fetch_kg<false>(KG, T.QB, T.KB, T.GLR, rb + (size_t)(c + 1) * 64, h, tl);
        put_v(VR, lds, tl);
        __syncthreads();
        state_update(S, lds, w, lane);
        __syncthreads();
    }
    unsigned* Rp = (unsigned*)T.R + (size_t)un * SPAIRS + tid;
#pragma unroll
    for (int tile = 0; tile < 4; ++tile)
#pragma unroll
        for (int r = 0; r < 16; r += 2) Rp[(tile * 8 + (r >> 1)) * 512] = cvtpk(S[tile][r], S[tile][r + 1]);
    if (tid >= 448) *(f32x2_t*)(T.DSEG + un * 128 + 2 * (tid & 63)) = (f32x2_t){__expf(bs0), __expf(bs1)};
}
__device__ __forceinline__ void g2_scan(const Tensors& T, int gtid, int gthreads) {
    for (int e = gtid; e < 8 * SPAIRS; e += gthreads) {
        const int chain = e / SPAIRS, idx = e % SPAIRS, k = idx >> 9, ln = idx & 63, reg = 2 * k;
        const int dk = 32 * (reg >> 4) + crow(reg & 15, ln >> 5);
        const unsigned* Rp = (const unsigned*)T.R + (size_t)chain * NSEG * SPAIRS + idx; unsigned* Sp = (unsigned*)T.SST + (size_t)chain * NSEG * SPAIRS + idx; const float* Dp = T.DSEG + chain * NSEG * 128 + dk;
        float sa = 0.f, sb = 0.f;
#pragma unroll 1
        for (int s0 = 0; s0 < NSEG; s0 += 16) { unsigned r[16]; f32x2_t d[16];
#pragma unroll
            for (int j = 0; j < 16; ++j) { r[j] = __builtin_nontemporal_load(Rp + (size_t)(s0 + j) * SPAIRS); d[j] = *(const f32x2_t*)(Dp + (s0 + j) * 128); }
#pragma unroll
            for (int j = 0; j < 16; ++j) { Sp[(size_t)(s0 + j) * SPAIRS] = cvtpk(sa, sb);
                sa = sa * d[j].x + __builtin_bit_cast(float, r[j] << 16); sb = sb * d[j].y + __builtin_bit_cast(float, r[j] & 0xffff0000u); } }
    }
}
__device__ __forceinline__ void g3_unit(int un, const Tensors& T, LAS unsigned char* lds, int tid) {
    const int lane = tid & 63, r32 = lane & 31, hi = lane >> 5, w = __builtin_amdgcn_readfirstlane(tid >> 6), i16 = lane & 15, g16 = (lane >> 4) & 1;
    const int chain = un >> 5, seg = un & 31, b = chain >> 2, h = chain & 3;
    const size_t rb = (size_t)b * SEQ + (size_t)(seg * CPS) * 64;
    load_wg(T.wgate, T.gbias, h, lds, tid);
    f32x16 S[4];
    { const unsigned* Sp = (const unsigned*)T.SST + (size_t)un * SPAIRS + tid;
#pragma unroll
      for (int tile = 0; tile < 4; ++tile)
#pragma unroll
          for (int r = 0; r < 16; r += 2) { const unsigned w2 = Sp[(tile * 8 + (r >> 1)) * 512]; S[tile][r] = __builtin_bit_cast(float, w2 << 16); S[tile][r + 1] = __builtin_bit_cast(float, w2 & 0xffff0000u); } }
#pragma unroll 1
    for (int c = 0; c < CPS; ++c) {
        const size_t r0 = rb + (size_t)c * 64;
        int tl = tid; asm volatile("" : "+v"(tl));
        SEC_B(1);
        { KgRegs KG; VRegs VR; fetch_kg<true>(KG, T.QB, T.KB, T.GLR, r0, h, tl); fetch_v(VR, T.VB, r0, h, tl); put_kg<true>(KG, lds, tl);
          float b0, b1; prep<true>(lds, tid, b0, b1);
          put_v(VR, lds, tl); }
        __syncthreads(); SEC_E(1); SEC_B(2);
        if (w < 3) { const int tt = (w >= 1), st = (w == 2); f32x16 d = {};
            LAS const unsigned char* kp = lds + O_K2 + (32 * st + r32) * PQ + 8 * hi; LAS const unsigned char* qp = lds + O_Q2 + (32 * tt + r32) * PQ + 8 * hi;
#pragma unroll
            for (int kc = 0; kc < 8; ++kc) d = MFMA32(row_frag(kp + kc * 32), row_frag(qp + kc * 32), d);
            const int t = 32 * tt + r32;
#pragma unroll
            for (int g = 0; g < 4; ++g) { const int s0 = 32 * st + 8 * g + 4 * hi; float v[4];
#pragma unroll
                for (int e = 0; e < 4; ++e) v[e] = (s0 + e <= t) ? d[4 * g + e] : 0.f;
                *(LAS u32x2*)(lds + O_A + t * PA + s0 * 2) = (u32x2){cvtpk(v[0], v[1]), cvtpk(v[2], v[3])}; } }
        f32x16 o[2] = {{}, {}};
#pragma unroll
        for (int tile = 0; tile < 4; ++tile)
#pragma unroll
            for (int s = 0; s < 2; ++s) { const bf16x8 sf = pack_step(S[tile], s);
#pragma unroll
                for (int tt = 0; tt < 2; ++tt) o[tt] = MFMA32(sf, row_frag(lds + O_Q1 + (32 * tt + r32) * PQ + (32 * tile + 16 * s + 4 * hi) * 2), o[tt]); }
        __syncthreads();
        SEC_E(2); SEC_B(3);
        u32x2 rrv[2][4];
#pragma unroll
        for (int tt = 0; tt < 2; ++tt)
#pragma unroll
            for (int g = 0; g < 4; ++g) rrv[tt][g] = *(const u32x2*)(T.RB + (r0 + 32 * tt + r32) * 1024 + h * 256 + 32 * w + 4 * hi + 8 * g);
        LAS const unsigned char* vb = lds + O_V + (4 * hi + (i16 >> 2)) * PV + (32 * w + 16 * g16 + 4 * (i16 & 3)) * 2;
#pragma unroll
        for (int ks = 0; ks < 4; ++ks) { const bf16x8 vf = cat8(tr_rd(vb + ks * 16 * PV), tr_rd(vb + (ks * 16 + 8) * PV));
            if (ks < 2) o[0] = MFMA32(vf, row_frag(lds + O_A + r32 * PA + (16 * ks + 4 * hi) * 2), o[0]);
            o[1] = MFMA32(vf, row_frag(lds + O_A + (32 + r32) * PA + (16 * ks + 4 * hi) * 2), o[1]); }
        state_update(S, lds, w, lane);
        SEC_E(3); SEC_B(4);
        LAS float* PART = (LAS float*)(lds + O_PART);
        f32x4 gn4[4];
#pragma unroll
        for (int g = 0; g < 4; ++g) gn4[g] = *(const f32x4*)(T.onorm + h * 256 + 32 * w + 8 * g + 4 * hi);
#pragma unroll
        for (int tt = 0; tt < 2; ++tt) { float ss = 0.f;
#pragma unroll
            for (int r = 0; r < 16; ++r) ss += o[tt][r] * o[tt][r];
            ss += __shfl_xor(ss, 32); if (hi == 0) PART[w * 64 + 32 * tt + r32] = ss; }
        __syncthreads();
#pragma unroll
        for (int tt = 0; tt < 2; ++tt) { const int t = 32 * tt + r32; float tot = 0.f;
#pragma unroll
            for (int ww = 0; ww < 8; ++ww) tot += PART[ww * 64 + t];
            const float rstd = __builtin_amdgcn_rsqf(tot * (1.0f / 256.0f) + 1e-6f);
            const size_t base = (r0 + t) * 1024 + h * 256 + 32 * w + 4 * hi;
#pragma unroll
            for (int g = 0; g < 4; ++g) { const u32x2 rr = rrv[tt][g];
                const float v0 = o[tt][4 * g] * rstd * gn4[g][0] * __builtin_bit_cast(float, rr.x << 16), v1 = o[tt][4 * g + 1] * rstd * gn4[g][1] * __builtin_bit_cast(float, rr.x & 0xffff0000u);
                const float v2 = o[tt][4 * g + 2] * rstd * gn4[g][2] * __builtin_bit_cast(float, rr.y << 16), v3 = o[tt][4 * g + 3] * rstd * gn4[g][3] * __builtin_bit_cast(float, rr.y & 0xffff0000u);
                *(u32x2*)(T.OB + base + 8 * g) = (u32x2){cvtpk(v0, v1), cvtpk(v2, v3)}; } }
        __syncthreads();
        SEC_E(4);
    }
}
}
#define CAS __attribute__((address_space(4)))

constexpr size_t MiB = 1u << 20;
constexpr size_t WS_CTL = 0, CTL_ZERO_BYTES = 1 * MiB;
constexpr size_t WS_ROPEC = 1 * MiB, WS_ROPES = 2 * MiB;
constexpr size_t WS_STATS = 3 * MiB;
constexpr size_t WS_GLR = 4 * MiB;
constexpr size_t WS_DSEG = 5 * MiB;
constexpr size_t WS_W = 6 * MiB;
constexpr size_t WS_XB = 108 * MiB;
constexpr size_t WS_ZH = 140 * MiB;
constexpr size_t Z_QA = WS_ZH, Z_KA = WS_ZH + 16 * MiB, Z_VA = WS_ZH + 20 * MiB, Z_QB = WS_ZH + 24 * MiB, Z_KB = WS_ZH + 40 * MiB, Z_VB = WS_ZH + 56 * MiB, Z_RB = WS_ZH + 88 * MiB, Z_GA = WS_ZH + 120 * MiB, Z_GB = WS_ZH + 152 * MiB;
constexpr size_t WS_R = 324 * MiB, WS_SST = 356 * MiB, WS_END = 388 * MiB;
constexpr size_t WS_DBG = 388 * MiB;
constexpr int CW_BAR = 4096, CW_DBG = 16384;
constexpr int RING_BYTES = 131072, MISC_OFF = RING_BYTES + 320, RSTD_OFF = RING_BYTES + 1024, LDS_BYTES = 147456;
static_assert(pg8::EPI_ROPEC == WS_ROPEC && pg8::EPI_ROPES == WS_ROPES && pg8::EPI_STATS == WS_STATS && pg8::EPI_GLR == WS_GLR && pg8::EPI_QA == Z_QA && pg8::EPI_KA == Z_KA && pg8::EPI_VA == Z_VA && pg8::EPI_QB == Z_QB && pg8::EPI_KB == Z_KB && pg8::EPI_VB == Z_VB && pg8::EPI_RB == Z_RB && pg8::EPI_GA == Z_GA && pg8::EPI_GB == Z_GB, "w_in epilogue offsets match the workspace map");
static_assert(gla::O_WG >= RSTD_OFF + 1024 && gla::O_WG + 8704 <= LDS_BYTES, "gate-weight table above the ring");
static_assert(swa::LDS_NEED <= RING_BYTES && gla::LDS_NEED <= RING_BYTES, "phase scratch fits the ring region");

__device__ __forceinline__ void conv_item64(const float* W, int ldw, int c0a, int nva, int c0b, int nvb, const float* gain, int k0, bf16* WT, int drow0, int K, LAS unsigned char* scr, int lane) {
    const int r = lane >> 4, c = lane & 15;
    const int col = (c < 8) ? c0a + 4 * c : c0b + 4 * (c - 8); const bool ok = (c < 8) ? (4 * c < nva) : (4 * (c - 8) < nvb);
    f32x4 v[16];
#pragma unroll
    for (int i = 0; i < 16; ++i) v[i] = ok ? __builtin_nontemporal_load((const f32x4*)(W + (size_t)(k0 + 4 * i + r) * ldw + col)) : (f32x4){0.f, 0.f, 0.f, 0.f};
    if (gain) {
#pragma unroll
        for (int i = 0; i < 16; ++i) v[i] = v[i] * gain[k0 + 4 * i + r]; }
#pragma unroll
    for (int i = 0; i < 16; ++i) *(LAS u32x2*)(scr + (4 * i + r) * 160 + c * 8) = (u32x2){cvtpk(v[i].x, v[i].y), cvtpk(v[i].z, v[i].w)};
    const int i16 = lane & 15, q = i16 >> 2, pp = i16 & 3;
#pragma unroll
    for (int nb = 0; nb < 4; ++nb)
#pragma unroll
        for (int kb = 0; kb < 4; ++kb) { const s16x4 t = tr_rd(scr + (16 * kb + 4 * r + q) * 160 + (16 * nb + 4 * pp) * 2);
            *(s16x4*)(WT + (size_t)(drow0 + 16 * nb + i16) * K + k0 + 16 * kb + 4 * r) = t; }
}
constexpr size_t W_GU1 = 0, W_D1 = 11 * MiB, W_IN = 17 * MiB, W_PA = 29 * MiB, W_PB = 30 * MiB, W_OUT = 32 * MiB, W_GU2 = 34 * MiB, W_D2 = 45 * MiB, W_SET = 51 * MiB;
constexpr int CI_GU = 16 * 88, CI_D = 44 * 16, CI_IN = 16 * 96, CI_PA = 8 * 16, CI_PB = 16 * 16, CI_OUT = 16 * 16, CI_ALL = 2 * CI_GU + 2 * CI_D + CI_IN + CI_PA + CI_PB + CI_OUT;
__device__ __forceinline__ void conv_run(const float* const CAS* in, int l, unsigned char* wset, int it_lo, int it_hi, int widx, int nworkers, LAS unsigned char* scr, int lane) {
    for (int it = it_lo + widx; it < it_hi; it += nworkers) {
        int r = it;
        if (r < 2 * CI_GU) { const int second = r >= CI_GU; r -= second * CI_GU; const int kb = r / 88, dg = 2 * (r % 88), tile = dg >> 3, bj = (dg >> 2) & 1, wc = dg & 3;
            const float* src = in[(second ? 17 : 2) + bj] + (size_t)l * DM * FF; const int c0 = 128 * tile + 32 * wc;
            conv_item64(src, FF, c0, 32, c0 + 32, 32, in[second ? 16 : 1] + (size_t)l * DM, 64 * kb, (bf16*)(wset + (second ? W_GU2 : W_GU1)), 32 * dg, DM, scr, lane); continue; }
        r -= 2 * CI_GU;
        if (r < 2 * CI_D) { const int second = r >= CI_D; r -= second * CI_D; const int kb = r / 16, pr = r % 16;
            conv_item64(in[second ? 19 : 4] + (size_t)l * FF * DM, DM, 64 * pr, 32, 64 * pr + 32, 32, nullptr, 64 * kb, (bf16*)(wset + (second ? W_D2 : W_D1)), 64 * pr, FF, scr, lane); continue; }
        r -= 2 * CI_D;
        if (r < CI_IN) { const int kb = r / 96, dg = 2 * (r % 96), tile = dg >> 3, bj = (dg >> 2) & 1, wc = dg & 3; int ca, cb, na = 32, nb = 32;
            if (tile < 2) { ca = 64 * (4 * tile + wc) + 32 * bj; cb = ca + 64; }
            else if (tile == 2) { ca = (wc < 2 ? 512 : 640) + 32 * bj; cb = ca + 64; }
            else if (tile < 15) { ca = 32 * dg; cb = ca + 32; }
            else if (tile < 23) { ca = 32 * dg + 16; cb = ca + 32; }
            else { ca = 3840; cb = 3840; na = (dg == 184) ? 16 : 0; nb = 0; }
            conv_item64(in[6] + (size_t)l * DM * IN_COLS, IN_COLS, ca, na, cb, nb, in[5] + (size_t)l * DM, 64 * kb, (bf16*)(wset + W_IN), 32 * dg, DM, scr, lane); continue; }
        r -= CI_IN;
        if (r < CI_PA) { const int kb = r / 16, pr = r % 16; conv_item64(in[13] + (size_t)l * QAW * DM, DM, 64 * pr, 32, 64 * pr + 32, 32, nullptr, 64 * kb, (bf16*)(wset + W_PA), 64 * pr, QAW, scr, lane); continue; }
        r -= CI_PA;
        if (r < CI_PB) { const int kb = r / 16, pr = r % 16; conv_item64(in[14] + (size_t)l * GVW * DM, DM, 64 * pr, 32, 64 * pr + 32, 32, nullptr, 64 * kb, (bf16*)(wset + W_PB), 64 * pr, GVW, scr, lane); continue; }
        r -= CI_PB;
        { const int kb = r / 16, pr = r % 16; conv_item64(in[15] + (size_t)l * DM * DM, DM, 64 * pr, 32, 64 * pr + 32, 32, nullptr, 64 * kb, (bf16*)(wset + W_OUT), 64 * pr, DM, scr, lane); }
    }
}
__device__ __forceinline__ float wave_sum(float v) {
#pragma unroll
    for (int o = 1; o < 64; o <<= 1) v += __shfl_xor(v, o);
    return v;
}
__device__ __forceinline__ void prologue_phase(const float* x, bf16* XB, float* stats, float* ropec, float* ropes, const float CAS* invf, int gw, int ngw, int lane, int gtid, int gthreads) {
    for (int m0 = gw * 2; m0 < M; m0 += ngw * 2) {
        f32x4 v[2][4];
#pragma unroll
        for (int rr = 0; rr < 2; ++rr) { const f32x4* xr = (const f32x4*)(x + (size_t)(m0 + rr) * DM) + lane;
#pragma unroll
            for (int j = 0; j < 4; ++j) v[rr][j] = __builtin_nontemporal_load(xr + 64 * j); }
        asm volatile("" ::: "memory");
#pragma unroll
        for (int rr = 0; rr < 2; ++rr) { const int m = m0 + rr; unsigned long long* o8 = (unsigned long long*)(XB + (size_t)m * DM) + lane; float s = 0.f;
#pragma unroll
            for (int j = 0; j < 4; ++j) { const f32x4 w = v[rr][j]; s += (w.x * w.x + w.y * w.y) + (w.z * w.z + w.w * w.w);
                o8[64 * j] = (unsigned long long)pk2(w.x, w.y) | ((unsigned long long)pk2(w.z, w.w) << 32); }
            s = wave_sum(s);
            if (lane < 16) stats[(size_t)m * 16 + lane] = (lane == 0) ? s : 0.f; }
    }
    for (int e = gtid; e < SEQ * 32; e += gthreads) { const int t = e >> 5, i = e & 31;
        const float ang = (float)t * invf[i];
        const double a = (double)ang, q = __builtin_rint(a * 0.63661977236758134308), r = __builtin_fma(-q, 6.123233995736766036e-17, __builtin_fma(-q, 1.57079632679489655800, a)), r2 = r * r;
        const double sn = r * (1.0 - r2 / 6.0 * (1.0 - r2 / 20.0 * (1.0 - r2 / 42.0 * (1.0 - r2 / 72.0 * (1.0 - r2 / 110.0 * (1.0 - r2 / 156.0 * (1.0 - r2 / 210.0 * (1.0 - r2 / 272.0))))))));
        const double cs = 1.0 - r2 / 2.0 * (1.0 - r2 / 12.0 * (1.0 - r2 / 30.0 * (1.0 - r2 / 56.0 * (1.0 - r2 / 90.0 * (1.0 - r2 / 132.0 * (1.0 - r2 / 182.0 * (1.0 - r2 / 240.0)))))));
        const int qi = (int)q & 3;
        const double c = (qi == 0) ? cs : (qi == 1) ? -sn : (qi == 2) ? -cs : sn, s_ = (qi == 0) ? sn : (qi == 1) ? cs : (qi == 2) ? -sn : -cs;
        ropec[e] = (float)c; ropes[e] = (float)s_; }
}

__device__ __forceinline__ void panel_rstd(const float* stats, int pm, LAS float* tab, int tid) {
    if (tid < 256) { const f32x4* p = (const f32x4*)(stats + (size_t)(pm * 256 + tid) * 16); const f32x4 t = (p[0] + p[1]) + (p[2] + p[3]);
        tab[tid] = __builtin_amdgcn_rsqf(((t[0] + t[1]) + (t[2] + t[3])) * (1.0f / 1024.0f) + 1e-6f); }
    __syncthreads();
}
struct Args { const float* in[20]; float* out; unsigned char* ws; float invf[32]; int s_lo, s_hi, ph_lo, ph_hi, do_pro, pad; };
enum { PH_CONV = 0, PH_GU = 1, PH_DN = 2, PH_IN = 3, PH_X1 = 4, PH_SCAN = 5, PH_G3 = 6, PH_PROJ = 7, PH_OUT = 8, N_PH = 9 };
#ifndef PHMASK
#define PHMASK 0x3ff
#endif
#define P_WSET(layer) (ws + WS_W + (size_t)((layer) & 1) * W_SET)
#define P_X     (ap->out)
#define P_XB    ((bf16*)(ws + WS_XB))
#define P_STATS ((float*)(ws + WS_STATS))
#define P_HID   ((bf16*)(ws + WS_ZH))
#define P_QA    ((bf16*)(ws + Z_QA))
#define P_KA    ((bf16*)(ws + Z_KA))
#define P_VA    ((bf16*)(ws + Z_VA))
#define P_QB    ((bf16*)(ws + Z_QB))
#define P_KB    ((bf16*)(ws + Z_KB))
#define P_VB    ((bf16*)(ws + Z_VB))
#define P_RB    ((bf16*)(ws + Z_RB))
#define P_GA    ((bf16*)(ws + Z_GA))
#define P_GB    ((bf16*)(ws + Z_GB))
#define P_GLR   ((float*)(ws + WS_GLR))
#define P_ROPEC ((float*)(ws + WS_ROPEC))
#define P_ROPES ((float*)(ws + WS_ROPES))
#define PHASE_WS() const CAS Args* ap = (const CAS Args*)__builtin_amdgcn_kernarg_segment_ptr(); asm volatile("" : "+s"(ap)); unsigned char* ws = ap->ws; (void)ws; int bxl = bx, Gl = G; asm volatile("" : "+s"(bxl), "+s"(Gl)); (void)bxl; (void)Gl
#define PHASE_IDS() PHASE_WS(); int tid = tid0; asm volatile("" : "+v"(tid)); const int lane = tid & 63, wave = __builtin_amdgcn_readfirstlane(tid >> 6); const int gw = vcu * 8 + wave, gtid = vcu * 512 + tid; (void)lane; (void)gw; (void)gtid
#define GLA_TENSORS() gla::Tensors GT{P_QB, P_KB, P_VB, P_RB, P_VB, P_GLR, ap->in[10] + (size_t)l * 16 * GKW, ap->in[11] + (size_t)l * GKW, ap->in[12] + (size_t)l * GVW, (float*)(ws + WS_R), (float*)(ws + WS_SST), (float*)(ws + WS_DSEG)}
#ifndef PROBE_MASK
#define PROBE_MASK 0
#endif
#define PB(k) do { if (PROBE_MASK && ((PROBE_MASK >> (k)) & 1) && bx == 0) probe_fn(0); } while (0)
#define PE(k) do { if (PROBE_MASK && ((PROBE_MASK >> (k)) & 1) && bx == 0) probe_fn(1); } while (0)
#ifndef PROBE_AMP
#define PROBE_AMP 4
#endif
__device__ __noinline__ void probe_fn(int mode) {
    volatile LAS unsigned* Mw = (volatile LAS unsigned*)(uintptr_t)(MISC_OFF);
    if (threadIdx.x != 0) return;
    const unsigned long long now = __builtin_amdgcn_s_memrealtime();
    if (mode == 0) { Mw[16] = (unsigned)now; Mw[17] = (unsigned)(now >> 32); }
    else if (mode == 1) { const unsigned long long a_ = (((unsigned long long)Mw[19] << 32) | Mw[18]) + (now - (((unsigned long long)Mw[17] << 32) | Mw[16])); Mw[18] = (unsigned)a_; Mw[19] = (unsigned)(a_ >> 32); }
    else { const unsigned long long end_ = now + (unsigned long long)PROBE_AMP * (((unsigned long long)Mw[19] << 32) | Mw[18]); while (__builtin_amdgcn_s_memrealtime() < end_) __builtin_amdgcn_s_sleep(16); }
}
__global__ void __launch_bounds__(512, 2) mega_fwd(Args args) {
    extern __shared__ __attribute__((aligned(16))) unsigned char lds_raw[];
    LAS unsigned char* lds = (LAS unsigned char*)lds_raw;
    volatile LAS unsigned* MISC = (volatile LAS unsigned*)(lds + MISC_OFF);
    const int tid0 = threadIdx.x;
    const int G = gridDim.x, bx = blockIdx.x, vcu = (G % 8 == 0) ? (bx % 8) * (G / 8) + bx / 8 : bx;
    const int ngw = G * 8, gthreads = G * 512;
    for (int u = tid0; u < (LDS_BYTES - RING_BYTES) / 4; u += 512) ((LAS unsigned*)(lds + RING_BYTES))[u] = 0u;
    __syncthreads();
#if !MULTI
    XcdBarrier bar = xcd_barrier_post((unsigned*)(args.ws + WS_CTL) + CW_BAR, MISC + 8);
#define GRID_BAR() do { SEC_B(7); xcd_barrier(bar); SEC_E(7); } while (0)
#else
    (void)MISC;
#define GRID_BAR() do { } while (0)
#endif
    if (((PHMASK >> 9) & 1) && (!MULTI || args.do_pro)) {
        PB(9); PHASE_IDS(); prologue_phase(ap->in[0], P_XB, P_STATS, P_ROPEC, P_ROPES, ap->invf, gw, ngw, lane, gtid, gthreads);
        conv_run(ap->in, 0, P_WSET(0), 0, CI_ALL, gw, ngw, lds + wave * 16384, lane);
        GRID_BAR(); PE(9);
    }
#if MULTI
    const int lo = args.ph_lo, hi = args.ph_hi, s_lo = args.s_lo, s_hi = args.s_hi;
#define IN(k) (((PHMASK >> (k)) & 1) && lo <= (k) && (k) < hi)
#else
    constexpr int s_lo = 0, s_hi = 2 * DEPTH;
#define IN(k) ((PHMASK >> (k)) & 1)
#endif
    for (int st = s_lo; st < s_hi; ++st) {
        const int l = st >> 1, odd = st & 1;
        if (IN(PH_GU)) { PB(PH_GU); PHASE_WS();
            pg8::Gemm g{P_XB, (const bf16*)(P_WSET(l) + (odd ? W_GU2 : W_GU1)), M, NGU, DM}; pg8::StaticOrder S; S.init(M, NGU, Gl, bxl);
            { pg8::Unit u0; S.next(0, u0); panel_rstd(P_STATS, u0.pm, (LAS float*)(lds + RSTD_OFF), tid0); }
            pg8::EpiGU E{P_HID, (const LAS float*)(lds + RSTD_OFF)};
            pg8::gemm_phase<pg8::EpiGU, pg8::StaticOrder, true, true>(lds, g, S, E);
            if (((PHMASK >> PH_CONV) & 1) && l + 1 < DEPTH) {
                constexpr int NU = (M / 256) * (NGU / 256); const int rounds = (NU + Gl - 1) / Gl, nshort = rounds * Gl - NU, first = nshort ? Gl - nshort : 0, nw = nshort ? nshort : Gl;
                if (bxl >= first) { int tid = tid0; asm volatile("" : "+v"(tid)); const int lane = tid & 63, wave = __builtin_amdgcn_readfirstlane(tid >> 6); __syncthreads(); conv_run(ap->in, l + 1, P_WSET(l + 1), odd ? CI_ALL / 2 : 0, odd ? CI_ALL : CI_ALL / 2, (bxl - first) * 8 + wave, nw * 8, lds + wave * 16384, lane); }
            }
            GRID_BAR(); PE(PH_GU);
        }
        if (IN(PH_DN)) { PB(PH_DN); PHASE_WS();
            pg8::Gemm g{P_HID, (const bf16*)(P_WSET(l) + (odd ? W_D2 : W_D1)), M, DM, FF}; pg8::StaticOrder S; S.init(M, DM, Gl, bxl);
            pg8::EpiRes E{st == 0 ? ap->in[0] : (const float*)P_X, P_X, P_XB, P_STATS, 0.5f};
            pg8::gemm_phase<pg8::EpiRes, pg8::StaticOrder, false, true>(lds, g, S, E);
            if (MULTI || st + 1 < s_hi) GRID_BAR();
            PE(PH_DN);
        }
        if (!odd) {
            if (IN(PH_IN)) { PB(PH_IN); PHASE_WS();
                pg8::Gemm g{P_XB, (const bf16*)(P_WSET(l) + W_IN), M, NIN, DM}; pg8::StaticOrder S; S.init(M, NIN, Gl, bxl);
                { pg8::Unit u0; S.next(0, u0); panel_rstd(P_STATS, u0.pm, (LAS float*)(lds + RSTD_OFF), tid0); }
                pg8::EpiIn E{ws, ap->in[7] + l * 64, ap->in[8] + l * 64, (const LAS float*)(lds + RSTD_OFF)};
                pg8::gemm_phase<pg8::EpiIn, pg8::StaticOrder, true, true>(lds, g, S, E);
                GRID_BAR(); PE(PH_IN);
            }
            if (IN(PH_X1)) { PB(PH_X1);
                SEC_B(5); { PHASE_IDS(); GLA_TENSORS(); for (int un = vcu; un < gla::NUNITS; un += G) gla::g1_unit(un, GT, lds, tid); } SEC_E(5);
                GRID_BAR(); PE(PH_X1);
            }
            if (IN(PH_SCAN)) { PB(PH_SCAN);
                { PHASE_IDS(); GLA_TENSORS(); gla::g2_scan(GT, gtid, gthreads); }
                SEC_B(6); { PHASE_IDS(); for (int un = vcu; un < swa::NUNITS; un += G) swa::unit(un, P_QA, P_KA, P_VA, P_QA, ap->in[9] + l * 8, lds, tid); } SEC_E(6);
                GRID_BAR(); PE(PH_SCAN);
            }
            if (IN(PH_G3)) { PB(PH_G3); PHASE_IDS(); GLA_TENSORS(); for (int un = vcu; un < gla::NUNITS; un += G) gla::g3_unit(un, GT, lds, tid); GRID_BAR(); PE(PH_G3); }
            if (IN(PH_PROJ)) { PB(PH_PROJ); PHASE_WS();
                { pg8::Gemm g{P_QA, (const bf16*)(P_WSET(l) + W_PA), M, DM, QAW}; pg8::StaticOrder S; S.init(M, DM, Gl, bxl); pg8::EpiPA E{P_GA};
                  pg8::gemm_phase<pg8::EpiPA, pg8::StaticOrder, false, true>(lds, g, S, E); }
                __syncthreads();
                { pg8::Gemm g{P_VB, (const bf16*)(P_WSET(l) + W_PB), M, DM, GVW}; pg8::StaticOrder S; S.init(M, DM, Gl, bxl); pg8::EpiPB E{P_GA, P_GB};
                  pg8::gemm_phase<pg8::EpiPB, pg8::StaticOrder, false, true>(lds, g, S, E); }
                GRID_BAR(); PE(PH_PROJ);
            }
            if (IN(PH_OUT)) { PB(PH_OUT); PHASE_WS();
                pg8::Gemm g{P_GA, (const bf16*)(P_WSET(l) + W_OUT), M, DM, DM}; pg8::StaticOrder S; S.init(M, DM, Gl, bxl);
                pg8::EpiRes E{P_X, P_X, P_XB, P_STATS, 1.0f};
                pg8::gemm_phase<pg8::EpiRes, pg8::StaticOrder, false, true>(lds, g, S, E);
                GRID_BAR(); PE(PH_OUT);
            }
        }
    }
#ifdef EXTRA_BARS
    for (int i_ = 0; i_ < EXTRA_BARS; ++i_) xcd_barrier(bar);
#endif
    if (PROBE_MASK && bx == 0) probe_fn(2);
#undef IN
}
constexpr size_t WS_DBG_END = WS_END;
constexpr size_t WS_NEED = (DBG ? WS_DBG_END : WS_END);

extern "C" void kernel_launch(void* const* d_in, const int* in_sizes, int n_in, void* d_out, int out_size, void* d_ws, size_t ws_size, hipStream_t stream) {
    static int grid = 0;
    if (grid == 0) {
        if (n_in != 20 || in_sizes[0] != M * DM || out_size != M * DM || ws_size < WS_NEED) {
            fprintf(stderr, "kernel_launch: built for 20 inputs, x/out of %d floats, >= %zu bytes of workspace; got n_in %d, in0 %d, out %d, ws %zu; nothing launched\n", M * DM, (size_t)WS_NEED, n_in, n_in > 0 ? in_sizes[0] : -1, out_size, ws_size); grid = -1; return; }
        int dev = 0, cus = 0, per_cu = 0;
        if (hipGetDevice(&dev) != hipSuccess || hipDeviceGetAttribute(&cus, hipDeviceAttributeMultiprocessorCount, dev) != hipSuccess) { fprintf(stderr, "kernel_launch: device query failed\n"); grid = -1; return; }
        if (hipFuncSetAttribute((const void*)mega_fwd, hipFuncAttributeMaxDynamicSharedMemorySize, LDS_BYTES) != hipSuccess) { fprintf(stderr, "kernel_launch: hipFuncSetAttribute failed\n"); grid = -1; return; }
        if (hipOccupancyMaxActiveBlocksPerMultiprocessor(&per_cu, (const void*)mega_fwd, 512, LDS_BYTES) != hipSuccess || per_cu < 1)
            fprintf(stderr, "kernel_launch: note: occupancy query reports %d workgroups per CU\n", per_cu);
        (void)hipGetLastError();
        grid = cus;
        if (grid != 256) { fprintf(stderr, "kernel_launch: built for a 256-CU device (one workgroup per CU, one row panel per workgroup in the GEMM phases); found %d CUs; nothing launched\n", cus); grid = -1; return; }
    }
    if (grid < 0) return;
    if (hipMemsetAsync((char*)d_ws + WS_CTL, 0, CTL_ZERO_BYTES, stream) != hipSuccess) { fprintf(stderr, "kernel_launch: memset failed\n"); return; }
    Args a{};
    for (int i = 0; i < 20; ++i) a.in[i] = (const float*)d_in[i];
    a.out = (float*)d_out; a.ws = (unsigned char*)d_ws;
    for (int i = 0; i < 32; ++i) a.invf[i] = (float)pow(10000.0, -(double)(2 * i) / 64.0);
#if !MULTI
    a.s_lo = 0; a.s_hi = 2 * DEPTH; a.ph_lo = 0; a.ph_hi = N_PH; a.do_pro = 1;
    hipLaunchKernelGGL(mega_fwd, dim3(grid), dim3(512), LDS_BYTES, stream, a);
#else
    a.s_lo = 0; a.s_hi = 0; a.ph_lo = 0; a.ph_hi = 0; a.do_pro = 1;
    hipLaunchKernelGGL(mega_fwd, dim3(grid), dim3(512), LDS_BYTES, stream, a);
    a.do_pro = 0;
    for (int st = 0; st < 2 * DEPTH; ++st)
        for (int ph = 0; ph < N_PH; ++ph) {
            if (ph == PH_CONV || ((st & 1) && ph >= PH_IN)) continue;
            a.s_lo = st; a.s_hi = st + 1; a.ph_lo = ph; a.ph_hi = ph + 1;
#if DBG
            dbg_before(a, st, ph, stream);
#endif
            hipLaunchKernelGGL(mega_fwd, dim3(grid), dim3(512), LDS_BYTES, stream, a);
#if DBG
            dbg_after(a, st, ph, stream);
#endif
        }
#if DBG
    hipLaunchKernelGGL(dbg_report, dim3(1024), dim3(256), 0, stream, (const float*)((unsigned char*)d_ws + WS_CTL) + CW_DBG, (float*)d_out);
#endif
#endif
    const hipError_t le = hipPeekAtLastError();
    if (le != hipSuccess) fprintf(stderr, "kernel_launch: launch failed: %s (grid %d)\n", hipGetErrorName(le), grid);
}
```

```cpp
#include <hip/hip_runtime.h>
#include <hip/hip_bf16.h>
#include <cstdio>
#include <cstdint>
#include <cmath>

#ifndef DBG
#define DBG 0
#endif
#ifndef MULTI
#define MULTI 0
#endif

constexpr int BATCH = 2, SEQ = 8192, DM = 1024, DEPTH = 4, M = BATCH * SEQ;
constexpr int FF = 2816, NGU = 2 * FF;
constexpr int IN_COLS = 5904, NIN = 6144;
constexpr int QAW = 512, KVW = 128, GKW = 512, GVW = 1024;
constexpr float EPS = 1e-6f;
constexpr float LOG2E = 1.4426950408889634f;
namespace pg8 {
#define PG8_LAS __attribute__((address_space(3)))
typedef unsigned short bf16_t;
typedef short bf16x8 __attribute__((ext_vector_type(8)));
typedef float f32x4 __attribute__((ext_vector_type(4)));
typedef unsigned u32x4 __attribute__((ext_vector_type(4)));
constexpr int BM = 256, BK = 64, HALF = 128, HTB = HALF * BK * 2  , STAGE_BYTES = 8 * HTB, NXCD = 8, WGM = 8;

__host__ __device__ __forceinline__ int lds_byte(int r, int c) { const int st = (r >> 4) * 2 + (c >> 5), rr = r & 15, cc = c & 31, ob = rr * 64 + cc * 2; return st * 1024 + (ob ^ (((ob >> 9) & 1) << 5)); }
__host__ __device__ __forceinline__ void stage_rc(int b, int& R, int& C) { const int st = b / 1024, sb = b % 1024, swz = sb ^ (((sb >> 9) & 1) << 5); R = (st >> 1) * 16 + swz / 64; C = (st & 1) * 32 + (swz % 64) / 2; }
__host__ __device__ __forceinline__ int perm32(int rho) { const int n = rho >> 4, i = rho & 15; return 8 * (i >> 2) + 4 * n + (i & 3); }

struct Unit { int pm, pn; };
struct Gemm { const bf16_t* A; const bf16_t* Bt; int M, N, K; };

struct StaticOrder {
    int nM, nN, nwg, G, c;
    __host__ __device__ void init(int M, int N, int G_, int c_) { nM = M / BM; nN = N / BM; nwg = nM * nN; G = G_; c = c_; }
    __host__ __device__ bool next(int i, Unit& u) const {
        const long L = (long)i * G + c; if (L >= nwg) return false;
        int wgid = (int)L; { const int q = nwg / NXCD, r = nwg % NXCD, xcd = wgid % NXCD, off = wgid / NXCD; wgid = (xcd < r ? xcd * (q + 1) : r * (q + 1) + (xcd - r) * q) + off; }
        const int nig = WGM * nN, gid = wgid / nig, fm = gid * WGM, gsz = (nM - fm) < WGM ? (nM - fm) : WGM;
        u.pm = fm + ((wgid % nig) % gsz); u.pn = (wgid % nig) / gsz; return true;
    }
    __device__ __forceinline__ void a_ready(const Unit&) const {}
    __device__ __forceinline__ void done(const Unit&) const {}
};

typedef float f32x2 __attribute__((ext_vector_type(2)));
typedef __bf16 bf16x2v __attribute__((ext_vector_type(2)));
__device__ __forceinline__ unsigned cvt_pk_bf16(float lo, float hi) { f32x2 v = {lo, hi}; bf16x2v b = __builtin_convertvector(v, bf16x2v); return __builtin_bit_cast(unsigned, b); }
__device__ __forceinline__ float silu_f(float g) { return g * __builtin_amdgcn_rcpf(1.f + __builtin_amdgcn_exp2f(-1.4426950408889634f * g)); }
__device__ __forceinline__ float sigm_f(float g) { return __builtin_amdgcn_rcpf(1.f + __builtin_amdgcn_exp2f(-1.4426950408889634f * g)); }
__device__ __forceinline__ float bf_lo(unsigned w) { return __builtin_bit_cast(float, w << 16); }
__device__ __forceinline__ float bf_hi(unsigned w) { return __builtin_bit_cast(float, w & 0xffff0000u); }
__device__ __forceinline__ float row_rstd(const float* stats, int row) {
    const f32x4* p = (const f32x4*)(stats + (size_t)row * 16);
    const f32x4 a = p[0], b = p[1], c = p[2], d = p[3]; const f32x4 s = (a + b) + (c + d);
    return __builtin_amdgcn_rsqf(((s[0] + s[1]) + (s[2] + s[3])) * (1.0f / 1024.0f) + 1e-6f);
}
__device__ __forceinline__ u32x4 pack8(const f32x4 v0, const f32x4 v1) { u32x4 w; w.x = cvt_pk_bf16(v0[0], v0[1]); w.y = cvt_pk_bf16(v0[2], v0[3]); w.z = cvt_pk_bf16(v1[0], v1[1]); w.w = cvt_pk_bf16(v1[2], v1[3]); return w; }

__device__ __forceinline__ void rows_rstd(float (&rs)[8], const PG8_LAS float* tab, int rl0) {
#pragma unroll
    for (int i = 0; i < 8; ++i) rs[i] = tab[rl0 + (i >> 2) * HALF + (i & 3) * 16];
}
struct EpiGU {
    static constexpr bool PERM = true, AFTER_DRAIN = false; static constexpr int MID_T = 0;
    bf16_t* H; const PG8_LAS float* rtab;
    __device__ __forceinline__ void operator()(const f32x4 (&acc)[2][2][4][2], const Unit& u, int wr, int wc, int fr, int fq) const {
        int row0 = u.pm * BM + wr * 64 + fr; asm volatile("" : "+v"(row0)); const int col0 = u.pn * 128 + wc * 32 + 8 * fq;
        float rs[8]; rows_rstd(rs, rtab, wr * 64 + fr);
#pragma unroll
        for (int ai = 0; ai < 2; ++ai)
#pragma unroll
            for (int m = 0; m < 4; ++m) { const int row = row0 + ai * HALF + m * 16; const float r = rs[ai * 4 + m];
                f32x4 o[2];
#pragma unroll
                for (int n = 0; n < 2; ++n) { const f32x4 g = acc[ai][0][m][n] * r, up = acc[ai][1][m][n] * r;
#pragma unroll
                    for (int e = 0; e < 4; ++e) o[n][e] = silu_f(g[e]) * up[e]; }
                *(u32x4*)(H + (size_t)row * 2816 + col0) = pack8(o[0], o[1]); }
    }
};
struct EpiRes {
    static constexpr bool PERM = true, AFTER_DRAIN = false; static constexpr int MID_T = 0;
    const float* Xin; float* X; bf16_t* XB; float* stats; float scale;
    __device__ __forceinline__ void operator()(const f32x4 (&acc)[2][2][4][2], const Unit& u, int wr, int wc, int fr, int fq) const {
        int row0 = u.pm * BM + wr * 64 + fr; asm volatile("" : "+v"(row0)); const int col0 = u.pn * BM + wc * 32 + 8 * fq;
        f32x4 xa[2][2][2];
#define EPI_LDX(buf, it) do { const float* xp_ = Xin + (size_t)(row0 + ((it) >> 2) * HALF + ((it) & 3) * 16) * 1024 + col0; \
            xa[buf][0][0] = *(const f32x4*)xp_; xa[buf][0][1] = *(const f32x4*)(xp_ + 4); xa[buf][1][0] = *(const f32x4*)(xp_ + HALF); xa[buf][1][1] = *(const f32x4*)(xp_ + HALF + 4); } while (0)
        EPI_LDX(0, 0);
#pragma unroll
        for (int it = 0; it < 8; ++it) { const int ai = it >> 2, m = it & 3, row = row0 + ai * HALF + m * 16, cb = it & 1;
            if (it < 7) EPI_LDX(cb ^ 1, it + 1);
            asm volatile("" ::: "memory");
            float ss = 0.f;
#pragma unroll
            for (int bj = 0; bj < 2; ++bj) { float* xp = X + (size_t)row * 1024 + col0 + bj * HALF;
                const f32x4 v0 = xa[cb][bj][0] + acc[ai][bj][m][0] * scale, v1 = xa[cb][bj][1] + acc[ai][bj][m][1] * scale;
                *(f32x4*)xp = v0; *(f32x4*)(xp + 4) = v1;
                *(u32x4*)(XB + (size_t)row * 1024 + col0 + bj * HALF) = pack8(v0, v1);
                ss += ((v0[0] * v0[0] + v0[1] * v0[1]) + (v0[2] * v0[2] + v0[3] * v0[3])) + ((v1[0] * v1[0] + v1[1] * v1[1]) + (v1[2] * v1[2] + v1[3] * v1[3])); }
            ss += __shfl_xor(ss, 16); ss += __shfl_xor(ss, 32);
            if (fq == 0) stats[(size_t)row * 16 + u.pn * 4 + wc] = ss; }
#undef EPI_LDX
    }
};
constexpr size_t EPI_MiB = 1u << 20, EPI_ROPEC = 1 * EPI_MiB, EPI_ROPES = 2 * EPI_MiB, EPI_STATS = 3 * EPI_MiB, EPI_GLR = 4 * EPI_MiB, EPI_ZH = 140 * EPI_MiB;
constexpr size_t EPI_QA = EPI_ZH, EPI_KA = EPI_ZH + 16 * EPI_MiB, EPI_VA = EPI_ZH + 20 * EPI_MiB, EPI_QB = EPI_ZH + 24 * EPI_MiB, EPI_KB = EPI_ZH + 40 * EPI_MiB, EPI_VB = EPI_ZH + 56 * EPI_MiB, EPI_RB = EPI_ZH + 88 * EPI_MiB, EPI_GA = EPI_ZH + 120 * EPI_MiB, EPI_GB = EPI_ZH + 152 * EPI_MiB;
struct EpiIn {
    static constexpr bool PERM = true, AFTER_DRAIN = false; static constexpr int MID_T = 0;
    unsigned char* ws; const float* qgain; const float* kgain; const PG8_LAS float* rtab;
    template <int ACT> __device__ __forceinline__ void plain(const f32x4 (&acc)[2][2][4][2], const Unit& u, int wr, int wc, int fr, int fq, bf16_t* dst, int pitch, int colt, float sc) const {
        int row0 = u.pm * BM + wr * 64 + fr; asm volatile("" : "+v"(row0)); const int col0 = colt + wc * 32 + 8 * fq;
        float rs[8]; rows_rstd(rs, rtab, wr * 64 + fr);
#pragma unroll
        for (int ai = 0; ai < 2; ++ai)
#pragma unroll
            for (int m = 0; m < 4; ++m) { const int row = row0 + ai * HALF + m * 16; const float r = rs[ai * 4 + m] * sc;
#pragma unroll
                for (int bj = 0; bj < 2; ++bj) { f32x4 v0 = acc[ai][bj][m][0] * r, v1 = acc[ai][bj][m][1] * r;
                    if (ACT == 1) {
#pragma unroll
                        for (int e = 0; e < 4; ++e) { v0[e] = silu_f(v0[e]); v1[e] = silu_f(v1[e]); } }
                    if (ACT == 2) {
#pragma unroll
                        for (int e = 0; e < 4; ++e) { v0[e] = sigm_f(v0[e]); v1[e] = sigm_f(v1[e]); } }
                    *(u32x4*)(dst + (size_t)row * pitch + col0 + bj * HALF) = pack8(v0, v1); } }
    }
    __device__ __forceinline__ void normrope(const f32x4 (&acc)[2][2][4][2], const Unit& u, int wr, int fr, int fq, bf16_t* dst, int pitch, int colh, const float* gain, float osc) const {
        int row0 = u.pm * BM + wr * 64 + fr; asm volatile("" : "+v"(row0));
        const float* ropec = (const float*)(ws + EPI_ROPEC); const float* ropes = (const float*)(ws + EPI_ROPES);
        float rs[8]; rows_rstd(rs, rtab, wr * 64 + fr);
        f32x4 cs[2][2][2];
#define EPI_LDR(buf, it) do { const size_t t_ = (size_t)((row0 + ((it) >> 2) * HALF + ((it) & 3) * 16) & (SEQ - 1)) * 32 + 8 * fq; \
            cs[buf][0][0] = *(const f32x4*)(ropec + t_); cs[buf][0][1] = *(const f32x4*)(ropes + t_); cs[buf][1][0] = *(const f32x4*)(ropec + t_ + 4); cs[buf][1][1] = *(const f32x4*)(ropes + t_ + 4); } while (0)
#pragma unroll
        for (int it = 0; it < 8; ++it) { const int ai = it >> 2, m = it & 3, row = row0 + ai * HALF + m * 16, cb = it & 1;
            EPI_LDR(cb, it);
            const float r = rs[it]; float ss = 0.f;
            f32x4 g1[2], g2[2];
#pragma unroll
            for (int n = 0; n < 2; ++n) { g1[n] = *(const f32x4*)(gain + 8 * fq + 4 * n); g2[n] = *(const f32x4*)(gain + 32 + 8 * fq + 4 * n); }
#pragma unroll
            for (int bj = 0; bj < 2; ++bj)
#pragma unroll
                for (int n = 0; n < 2; ++n) { const f32x4 q = acc[ai][bj][m][n]; ss += (q[0] * q[0] + q[1] * q[1]) + (q[2] * q[2] + q[3] * q[3]); }
            ss += __shfl_xor(ss, 16); ss += __shfl_xor(ss, 32);
            const float sc2 = osc * r * __builtin_amdgcn_rsqf(ss * (r * r) * (1.0f / 64.0f) + 1e-6f);
            f32x4 o1[2], o2[2];
#pragma unroll
            for (int n = 0; n < 2; ++n) { const f32x4 c = cs[cb][n][0], sn = cs[cb][n][1];
                const f32x4 x1 = acc[ai][0][m][n] * sc2 * g1[n], x2 = acc[ai][1][m][n] * sc2 * g2[n];
                o1[n] = x1 * c - x2 * sn; o2[n] = x2 * c + x1 * sn; }
            bf16_t* p = dst + (size_t)row * pitch + colh + 8 * fq;
            *(u32x4*)p = pack8(o1[0], o1[1]); *(u32x4*)(p + 32) = pack8(o2[0], o2[1]); }
#undef EPI_LDR
    }
    __device__ __forceinline__ void operator()(const f32x4 (&acc)[2][2][4][2], const Unit& u, int wr, int wc, int fr, int fq) const {
        const int pn = u.pn;
        if (pn < 2) { normrope(acc, u, wr, fr, fq, (bf16_t*)(ws + EPI_QA), 512, (4 * pn + wc) * 64, qgain, 0.125f * 1.4426950408889634f); }
        else if (pn == 2) {
            if (wc < 2) normrope(acc, u, wr, fr, fq, (bf16_t*)(ws + EPI_KA), 128, wc * 64, kgain, 1.0f);
            else {
                int row0 = u.pm * BM + wr * 64 + fr; asm volatile("" : "+v"(row0));
                float rs[8]; rows_rstd(rs, rtab, wr * 64 + fr);
#pragma unroll
                for (int ai = 0; ai < 2; ++ai)
#pragma unroll
                    for (int m = 0; m < 4; ++m) { const int row = row0 + ai * HALF + m * 16; const float r = rs[ai * 4 + m];
#pragma unroll
                        for (int bj = 0; bj < 2; ++bj) *(u32x4*)((bf16_t*)(ws + EPI_VA) + (size_t)row * 128 + (wc - 2) * 64 + bj * 32 + 8 * fq) = pack8(acc[ai][bj][m][0] * r, acc[ai][bj][m][1] * r); } }
        }
        else if (pn < 5)  plain<0>(acc, u, wr, wc, fr, fq, (bf16_t*)(ws + EPI_QB), 512, (pn - 3) * 256, 0.08838834764831845f);
        else if (pn < 7)  plain<0>(acc, u, wr, wc, fr, fq, (bf16_t*)(ws + EPI_KB), 512, (pn - 5) * 256, 1.0f);
        else if (pn < 11) plain<0>(acc, u, wr, wc, fr, fq, (bf16_t*)(ws + EPI_VB), 1024, (pn - 7) * 256, 1.0f);
        else if (pn < 15) plain<1>(acc, u, wr, wc, fr, fq, (bf16_t*)(ws + EPI_RB), 1024, (pn - 11) * 256, 1.0f);
        else if (pn < 19) plain<2>(acc, u, wr, wc, fr, fq, (bf16_t*)(ws + EPI_GA), 1024, (pn - 15) * 256, 1.0f);
        else if (pn < 23) plain<2>(acc, u, wr, wc, fr, fq, (bf16_t*)(ws + EPI_GB), 1024, (pn - 19) * 256, 1.0f);
        else { if (wc == 0 && fq < 2) { int row0 = u.pm * BM + wr * 64 + fr; asm volatile("" : "+v"(row0)); float rs[8]; rows_rstd(rs, rtab, wr * 64 + fr);
#pragma unroll
                for (int ai = 0; ai < 2; ++ai)
#pragma unroll
                    for (int m = 0; m < 4; ++m) { const int row = row0 + ai * HALF + m * 16; const float r = rs[ai * 4 + m];
                        float* p = (float*)(ws + EPI_GLR) + (size_t)row * 16 + 8 * fq; *(f32x4*)p = acc[ai][0][m][0] * r; *(f32x4*)(p + 4) = acc[ai][0][m][1] * r; } } }
    }
};
struct EpiPF {
    static constexpr bool PERM = true, AFTER_DRAIN = false; static constexpr int MID_T = 8;
    bf16_t* MG; const bf16_t* GB;
    __device__ __forceinline__ void mid(f32x4 (&acc)[2][2][4][2], const Unit& u, int wr, int wc, int fr, int fq) const {
        int row0 = u.pm * BM + wr * 64 + fr; asm volatile("" : "+v"(row0)); const int col0 = u.pn * BM + wc * 32 + 8 * fq;
        u32x4 ab[2][2], gb[2][2];
#define EPI_LDG(buf, it) do { const size_t o_ = (size_t)(row0 + ((it) >> 2) * HALF + ((it) & 3) * 16) * 1024 + col0; ab[buf][0] = *(const u32x4*)(MG + o_); ab[buf][1] = *(const u32x4*)(MG + o_ + HALF); \
            gb[buf][0] = *(const u32x4*)(GB + o_); gb[buf][1] = *(const u32x4*)(GB + o_ + HALF); } while (0)
        EPI_LDG(0, 0);
#pragma unroll
        for (int it = 0; it < 8; ++it) { const int ai = it >> 2, m = it & 3, cb = it & 1;
            if (it < 7) EPI_LDG(cb ^ 1, it + 1);
            asm volatile("" ::: "memory");
#pragma unroll
            for (int bj = 0; bj < 2; ++bj) { const u32x4 a = ab[cb][bj], g = gb[cb][bj];
                const f32x4 a0 = {bf_lo(a.x), bf_hi(a.x), bf_lo(a.y), bf_hi(a.y)}, a1 = {bf_lo(a.z), bf_hi(a.z), bf_lo(a.w), bf_hi(a.w)};
                f32x4 g0 = {bf_lo(g.x), bf_hi(g.x), bf_lo(g.y), bf_hi(g.y)}, g1 = {bf_lo(g.z), bf_hi(g.z), bf_lo(g.w), bf_hi(g.w)};
#pragma unroll
                for (int e = 0; e < 4; ++e) { g0[e] = __builtin_amdgcn_rcpf(g0[e]); g1[e] = __builtin_amdgcn_rcpf(g1[e]); }
                acc[ai][bj][m][0] = acc[ai][bj][m][0] * (a0 * g0); acc[ai][bj][m][1] = acc[ai][bj][m][1] * (a1 * g1); } }
#undef EPI_LDG
    }
    __device__ __forceinline__ void operator()(const f32x4 (&acc)[2][2][4][2], const Unit& u, int wr, int wc, int fr, int fq) const {
        int row0 = u.pm * BM + wr * 64 + fr; asm volatile("" : "+v"(row0)); const int col0 = u.pn * BM + wc * 32 + 8 * fq;
        u32x4 gb[2][2];
#define EPI_LDG(buf, it) do { const bf16_t* p_ = GB + (size_t)(row0 + ((it) >> 2) * HALF + ((it) & 3) * 16) * 1024 + col0; gb[buf][0] = *(const u32x4*)p_; gb[buf][1] = *(const u32x4*)(p_ + HALF); } while (0)
        EPI_LDG(0, 0);
#pragma unroll
        for (int it = 0; it < 8; ++it) { const int ai = it >> 2, m = it & 3, row = row0 + ai * HALF + m * 16, cb = it & 1;
            if (it < 7) EPI_LDG(cb ^ 1, it + 1);
            asm volatile("" ::: "memory");
#pragma unroll
            for (int bj = 0; bj < 2; ++bj) { const u32x4 g = gb[cb][bj];
                const f32x4 g0 = {bf_lo(g.x), bf_hi(g.x), bf_lo(g.y), bf_hi(g.y)}, g1 = {bf_lo(g.z), bf_hi(g.z), bf_lo(g.w), bf_hi(g.w)};
                *(u32x4*)(MG + (size_t)row * 1024 + col0 + bj * HALF) = pack8(acc[ai][bj][m][0] * g0, acc[ai][bj][m][1] * g1); } }
#undef EPI_LDG
    }
};

template <class Epi, class Sched, bool ALIGN_EPI = false, bool SP2 = false>
__device__ __forceinline__ void gemm_phase(PG8_LAS unsigned char* lds, const Gemm g, const Sched& S, const Epi& E) {
    int tid_l = threadIdx.x; asm volatile("" : "+v"(tid_l));
    const int tid = tid_l, wid = __builtin_amdgcn_readfirstlane(tid >> 6), lane = tid & 63, wr = wid >> 2, wc = wid & 3, fr = lane & 15, fq = lane >> 4;
    const int K = g.K, nt = K / BK;
    unsigned voffA[2], voffB[2];
#pragma unroll
    for (int i = 0; i < 2; ++i) { int R, C; stage_rc(tid * 16 + i * 8192, R, C); const int Rb = Epi::PERM ? ((R & ~31) + perm32(R & 31)) : R;
        voffA[i] = (unsigned)(R * K + C) * 2u; voffB[i] = (unsigned)(Rb * K + C) * 2u; }
    const size_t kstep = (size_t)(BK * 2);
    const size_t hstep = (size_t)HALF * K * 2;
    const size_t tstep = 2 * hstep;
    const unsigned ldsw = (unsigned)wid * 1024u;
    const int aoff = lds_byte(wr * 64 + fr, fq * 8), boff = lds_byte(wc * 32 + fr, fq * 8);
#define PG8_SA(b, h) (((b) * 2 + (h)) * HTB)
#define PG8_SB(b, h) ((4 + (b) * 2 + (h)) * HTB)
#define PG8_STAGE(bufoff, gbase, voff) do { _Pragma("unroll") for (int _i = 0; _i < 2; ++_i) \
        __builtin_amdgcn_global_load_lds((const unsigned*)((const char*)(gbase) + (voff)[_i]), (PG8_LAS unsigned*)(lds + (bufoff) + ldsw + _i * 8192), 16, 0, 0); } while (0)
#define PG8_LDA(dst, b, h) do { _Pragma("unroll") for (int m = 0; m < 4; ++m) _Pragma("unroll") for (int k = 0; k < 2; ++k) dst[m][k] = *(const PG8_LAS bf16x8*)(lds + PG8_SA(b, h) + aoff + m * 2048 + k * 1024); } while (0)
#define PG8_LDB(dst, b, h) do { _Pragma("unroll") for (int n = 0; n < 2; ++n) _Pragma("unroll") for (int k = 0; k < 2; ++k) dst[n][k] = *(const PG8_LAS bf16x8*)(lds + PG8_SB(b, h) + boff + n * 2048 + k * 1024); } while (0)
#define PG8_MMA(ai, bj, At, Bt) do { __builtin_amdgcn_s_setprio(1); _Pragma("unroll") for (int m = 0; m < 4; ++m) _Pragma("unroll") for (int n = 0; n < 2; ++n) _Pragma("unroll") for (int k = 0; k < 2; ++k) \
        acc[ai][bj][m][n] = __builtin_amdgcn_mfma_f32_16x16x32_bf16(Bt[n][k], At[m][k], acc[ai][bj][m][n], 0, 0, 0); __builtin_amdgcn_s_setprio(0); } while (0)
#define PG8_WAIT_V(n) asm volatile("s_waitcnt vmcnt(" #n ")" ::: "memory")
#define PG8_WAIT_L(n) asm volatile("s_waitcnt lgkmcnt(" #n ")" ::: "memory")
#define PG8_BAR __builtin_amdgcn_s_barrier()
#define PG8_SCHED __builtin_amdgcn_sched_barrier(0)
    Unit cur, nxt; int ui = 0;
    if (!S.next(0, cur)) return;
    f32x4 acc[2][2][4][2];
#pragma unroll
    for (int a = 0; a < 2; ++a)
#pragma unroll
        for (int b = 0; b < 2; ++b)
#pragma unroll
            for (int m = 0; m < 4; ++m)
#pragma unroll
                for (int n = 0; n < 2; ++n) acc[a][b][m][n] = (f32x4){0.f, 0.f, 0.f, 0.f};
    bf16x8 At[4][2], B0[2][2], B1[2][2];
    const char* cA = (const char*)g.A + (size_t)cur.pm * tstep; const char* cB = (const char*)g.Bt + (size_t)cur.pn * tstep;
    S.a_ready(cur);
    if constexpr (SP2) {
        PG8_STAGE(PG8_SB(0, 0), cB, voffB); PG8_STAGE(PG8_SB(0, 1), cB + hstep, voffB); PG8_STAGE(PG8_SA(0, 0), cA, voffA); PG8_STAGE(PG8_SA(0, 1), cA + hstep, voffA);
        if (wr == 1) PG8_BAR;
        PG8_WAIT_V(2); PG8_BAR;
        PG8_STAGE(PG8_SB(1, 0), cB + kstep, voffB); PG8_STAGE(PG8_SA(1, 0), cA + kstep, voffA); PG8_STAGE(PG8_SB(1, 1), cB + hstep + kstep, voffB);
        PG8_WAIT_V(6); PG8_BAR;
    } else {
        PG8_STAGE(PG8_SB(0, 0), cB, voffB); PG8_STAGE(PG8_SA(0, 0), cA, voffA); PG8_STAGE(PG8_SB(0, 1), cB + hstep, voffB); PG8_STAGE(PG8_SA(0, 1), cA + hstep, voffA);
        if (wr == 1) PG8_BAR;
        PG8_WAIT_V(4); PG8_BAR;
        PG8_STAGE(PG8_SB(1, 0), cB + kstep, voffB); PG8_STAGE(PG8_SA(1, 0), cA + kstep, voffA); PG8_STAGE(PG8_SB(1, 1), cB + hstep + kstep, voffB);
        PG8_WAIT_V(6); PG8_BAR;
    }
    for (;;) {
        const bool has_next = S.next(ui + 1, nxt);
        const char* nA = has_next ? (const char*)g.A + (size_t)nxt.pm * tstep : cA; const char* nB = has_next ? (const char*)g.Bt + (size_t)nxt.pn * tstep : cB;
        int t = 0;
        for (int kseg = 0; kseg < (Epi::MID_T > 0 ? 2 : 1); ++kseg) {
        const int t_end = (Epi::MID_T > 0 && kseg == 0) ? Epi::MID_T : nt;
        for (; t < t_end; t += 2) {
            const bool last = (t == nt - 2);
            const char* a1 = cA + (size_t)(t + 1) * kstep;
            const char* a2 = last ? nA : cA + (size_t)(t + 2) * kstep; const char* b2 = last ? nB : cB + (size_t)(t + 2) * kstep;
            const char* a3 = a2 + kstep; const char* b3 = b2 + kstep;
            if (last && has_next) S.a_ready(nxt);
            if constexpr (SP2) {
            PG8_LDB(B0, 0, 0); PG8_LDB(B1, 0, 1); PG8_SCHED; PG8_LDA(At, 0, 0); PG8_STAGE(PG8_SA(1, 1), a1 + hstep, voffA);
            PG8_WAIT_V(8); PG8_WAIT_L(0); PG8_BAR; PG8_MMA(0, 0, At, B0); PG8_MMA(0, 1, At, B1); PG8_BAR; PG8_SCHED;
            PG8_LDA(At, 0, 1); PG8_STAGE(PG8_SB(0, 0), b2, voffB); PG8_STAGE(PG8_SB(0, 1), b2 + hstep, voffB); PG8_STAGE(PG8_SA(0, 0), a2, voffA);
            PG8_WAIT_V(8); PG8_WAIT_L(0); PG8_BAR; PG8_MMA(1, 0, At, B0); PG8_MMA(1, 1, At, B1); PG8_BAR; PG8_SCHED;
            PG8_LDB(B0, 1, 0); PG8_LDB(B1, 1, 1); PG8_SCHED; PG8_LDA(At, 1, 0); PG8_STAGE(PG8_SA(0, 1), a2 + hstep, voffA);
            PG8_WAIT_V(8); PG8_WAIT_L(0); PG8_BAR; PG8_MMA(0, 0, At, B0); PG8_MMA(0, 1, At, B1); PG8_BAR; PG8_SCHED;
            PG8_LDA(At, 1, 1); PG8_STAGE(PG8_SB(1, 0), b3, voffB); PG8_STAGE(PG8_SB(1, 1), b3 + hstep, voffB); PG8_STAGE(PG8_SA(1, 0), a3, voffA);
            PG8_WAIT_V(8); PG8_WAIT_L(0); PG8_BAR; PG8_MMA(1, 0, At, B0); PG8_MMA(1, 1, At, B1); PG8_BAR; PG8_SCHED;
            } else {
            PG8_LDB(B0, 0, 0); PG8_SCHED; PG8_LDA(At, 0, 0); PG8_STAGE(PG8_SA(1, 1), a1 + hstep, voffA);
            PG8_WAIT_L(8); PG8_BAR; PG8_WAIT_L(0); PG8_MMA(0, 0, At, B0); PG8_BAR; PG8_SCHED;
            PG8_LDB(B1, 0, 1); PG8_STAGE(PG8_SB(0, 0), b2, voffB);
            PG8_BAR; PG8_WAIT_L(0); PG8_MMA(0, 1, At, B1); PG8_BAR;
            PG8_LDA(At, 0, 1); PG8_STAGE(PG8_SA(0, 0), a2, voffA);
            PG8_BAR; PG8_WAIT_L(0); PG8_MMA(1, 0, At, B0); PG8_BAR; PG8_SCHED;
            PG8_STAGE(PG8_SB(0, 1), b2 + hstep, voffB);
            PG8_WAIT_V(6); PG8_BAR; PG8_MMA(1, 1, At, B1); PG8_BAR;
            PG8_LDB(B0, 1, 0); PG8_SCHED; PG8_LDA(At, 1, 0); PG8_STAGE(PG8_SA(0, 1), a2 + hstep, voffA);
            PG8_WAIT_L(8); PG8_BAR; PG8_WAIT_L(0); PG8_MMA(0, 0, At, B0); PG8_BAR; PG8_SCHED;
            PG8_LDB(B1, 1, 1); PG8_STAGE(PG8_SB(1, 0), b3, voffB);
            PG8_BAR; PG8_WAIT_L(0); PG8_MMA(0, 1, At, B1); PG8_BAR;
            PG8_LDA(At, 1, 1); PG8_STAGE(PG8_SA(1, 0), a3, voffA);
            PG8_BAR; PG8_WAIT_L(0); PG8_MMA(1, 0, At, B0); PG8_BAR; PG8_SCHED;
            PG8_STAGE(PG8_SB(1, 1), b3 + hstep, voffB);
            PG8_WAIT_V(6); PG8_BAR; PG8_MMA(1, 1, At, B1); PG8_BAR;
            }
        }
        if constexpr (Epi::MID_T > 0) { if (kseg == 0) E.mid(acc, cur, wr, wc, fr, fq); }
        }
        if constexpr (ALIGN_EPI) { if (wr == 0) PG8_BAR; }
        if constexpr (!Epi::AFTER_DRAIN) { E(acc, cur, wr, wc, fr, fq); S.done(cur); }
        if (!has_next) break;
#pragma unroll
        for (int a = 0; a < 2; ++a)
#pragma unroll
            for (int b = 0; b < 2; ++b)
#pragma unroll
                for (int m = 0; m < 4; ++m)
#pragma unroll
                    for (int n = 0; n < 2; ++n) acc[a][b][m][n] = (f32x4){0.f, 0.f, 0.f, 0.f};
        cur = nxt; cA = nA; cB = nB; ++ui;
        if constexpr (ALIGN_EPI) { if (wr == 1) PG8_BAR; }
    }
    PG8_WAIT_V(0);
    if constexpr (!ALIGN_EPI) { if (wr == 0) PG8_BAR; }
    PG8_BAR;
    if constexpr (Epi::AFTER_DRAIN) { E.fused(acc, cur, wr, wc, fr, fq, lds, wid, lane); S.done(cur); }
#undef PG8_SA
#undef PG8_SB
#undef PG8_STAGE
#undef PG8_LDA
#undef PG8_LDB
#undef PG8_MMA
#undef PG8_WAIT_V
#undef PG8_WAIT_L
#undef PG8_BAR
#undef PG8_SCHED
}
}
#define GAS __attribute__((address_space(1)))
#define LAS __attribute__((address_space(3)))
typedef unsigned short bf16;
typedef unsigned v4u __attribute__((ext_vector_type(4)));
typedef float f32x4 __attribute__((ext_vector_type(4)));
typedef short bf16x8 __attribute__((ext_vector_type(8)));
typedef GAS unsigned gu32;
typedef GAS unsigned long long gu64;
#define RLX_AGENT __ATOMIC_RELAXED, __HIP_MEMORY_SCOPE_AGENT
#define LDS_WAIT() asm volatile("s_waitcnt lgkmcnt(0)" ::: "memory")
#define VM_WAIT() asm volatile("s_waitcnt vmcnt(0)" ::: "memory")
__device__ __forceinline__ unsigned long long rt() { return __builtin_amdgcn_s_memrealtime(); }
__device__ __forceinline__ unsigned f2bf(float f) { unsigned u = __builtin_bit_cast(unsigned, f); return (u + 0x7fffu + ((u >> 16) & 1u)) >> 16; }
__device__ __forceinline__ unsigned pk2(float lo, float hi) { return f2bf(lo) | (f2bf(hi) << 16); }

#define XB_TMO      128
#define XB_XCNT(j)  (256  + 64 * (j))
#define XB_XSUB(j)  (1280 + 64 * (j))
#define XB_XGEN(j)  (2304 + 64 * (j))
#define XB_TOP      3328
#define XB_TOPGEN   3392
#define XCD_BAR_WORDS 3456
#define XB_SPIN_CAP (1u << 18)

__device__ __forceinline__ unsigned xb_ld(unsigned* p)              { return __hip_atomic_load(p, __ATOMIC_RELAXED, __HIP_MEMORY_SCOPE_AGENT); }
__device__ __forceinline__ unsigned xb_add(unsigned* p, unsigned v) { return __hip_atomic_fetch_add(p, v, __ATOMIC_RELAXED, __HIP_MEMORY_SCOPE_AGENT); }
__device__ __forceinline__ unsigned xb_xcc_id() { return (unsigned)__builtin_amdgcn_s_getreg((3 << 11) | 20) & 0xFu; }
#define XB_SPIN(cond, bar) do { unsigned _sp = 0; while (cond) { __builtin_amdgcn_s_sleep(1); \
    if ((++_sp & 255u) == 0u) { if (xb_ld(&(bar)[XB_TMO])) break; if (_sp > XB_SPIN_CAP) { atomicAdd(&(bar)[XB_TMO], 1u); break; } } } } while (0)

struct XcdBarrier {
    unsigned* bar; unsigned x;
    volatile LAS unsigned* st;
};

__device__ __forceinline__ XcdBarrier xcd_barrier_post(unsigned* bar, volatile LAS unsigned* st) {
    XcdBarrier b; b.bar = bar; b.x = xb_xcc_id(); b.st = st;
    if (threadIdx.x == 0) (void)xb_add(&bar[XB_XCNT(b.x)], 1u);
    return b;
}
__device__ __forceinline__ void xcd_barrier_complete(unsigned* bar, unsigned x, unsigned& nloc, unsigned& nx) {
    const unsigned G = gridDim.x * gridDim.y * gridDim.z;
    unsigned sum, cnt, mine, sp = 0u;
    for (;;) {
        sum = 0u; cnt = 0u; mine = 0u;
#pragma unroll
        for (unsigned j = 0; j < 16; ++j) { const unsigned c = xb_ld(&bar[XB_XCNT(j)]); sum += c; cnt += (c > 0u) ? 1u : 0u; mine = (j == x) ? c : mine; }
        if (sum == G) break;
        __builtin_amdgcn_s_sleep(1);
        if ((++sp & 255u) == 0u) { if (xb_ld(&bar[XB_TMO])) break; if (sp > XB_SPIN_CAP) { atomicAdd(&bar[XB_TMO], 1u); break; } }
    }
    nloc = mine > 0u ? mine : 1u; nx = cnt > 0u ? cnt : 1u;
}

__device__ __noinline__ void xcd_barrier_fn(unsigned* bbar, unsigned bx_, volatile LAS unsigned* bst) {
    XcdBarrier b; b.bar = bbar; b.x = bx_; b.st = bst;
    asm volatile("s_waitcnt vmcnt(0)" ::: "memory");
    __syncthreads();
    if (threadIdx.x == 0) {
        unsigned* bar = b.bar;
        __builtin_amdgcn_s_waitcnt(0);
        unsigned nloc = b.st[0], nx = b.st[1];
        if (nloc == 0u) { xcd_barrier_complete(bar, b.x, nloc, nx); b.st[0] = nloc; b.st[1] = nx; }
        const unsigned old = xb_add(&bar[XB_XSUB(b.x)], 1u);
        const unsigned gen = old / nloc;
        if (old + 1u == (gen + 1u) * nloc) {
            __builtin_amdgcn_fence(__ATOMIC_RELEASE, "agent");
            asm volatile("s_waitcnt vmcnt(0)" ::: "memory");
            const unsigned og = xb_add(&bar[XB_TOP], 1u);
            const unsigned tg = og / nx;
            if (og + 1u == (tg + 1u) * nx) xb_add(&bar[XB_TOPGEN], 1u);
            else XB_SPIN(xb_ld(&bar[XB_TOPGEN]) == tg, bar);
            __builtin_amdgcn_fence(__ATOMIC_ACQUIRE, "agent");
            xb_add(&bar[XB_XGEN(b.x)], 1u);
            asm volatile("s_waitcnt vmcnt(0)" ::: "memory");
        } else {
            XB_SPIN(xb_ld(&bar[XB_XGEN(b.x)]) == gen, bar);
            __builtin_amdgcn_fence(__ATOMIC_ACQUIRE, "agent");
            asm volatile("s_waitcnt vmcnt(0)" ::: "memory");
        }
    }
    __syncthreads();
}

__device__ __forceinline__ void xcd_barrier(const XcdBarrier& b) { xcd_barrier_fn(b.bar, b.x, b.st); }
typedef unsigned u32x4 __attribute__((ext_vector_type(4)));

typedef short s16x4 __attribute__((ext_vector_type(4)));
typedef float f32x16 __attribute__((ext_vector_type(16)));
typedef float f32x2_t __attribute__((ext_vector_type(2)));
typedef __bf16 bf16x2_t __attribute__((ext_vector_type(2)));
typedef short v4i16_t __attribute__((ext_vector_type(4)));
typedef unsigned u32x2 __attribute__((ext_vector_type(2)));
#define MFMA32(a, b, c) __builtin_amdgcn_mfma_f32_32x32x16_bf16((a), (b), (c), 0, 0, 0)
__device__ __forceinline__ int crow(int r, int hi) { return (r & 3) + 8 * (r >> 2) + 4 * hi; }
__device__ __forceinline__ unsigned cvtpk(float lo, float hi) { f32x2_t v = {lo, hi}; bf16x2_t b = __builtin_convertvector(v, bf16x2_t); return __builtin_bit_cast(unsigned, b); }
__device__ __forceinline__ s16x4 tr_rd(LAS const unsigned char* p) { return __builtin_bit_cast(s16x4, __builtin_amdgcn_ds_read_tr16_b64_v4i16((LAS v4i16_t*)p)); }
__device__ __forceinline__ bf16x8 cat8(s16x4 lo, s16x4 hi) { return __builtin_shufflevector(lo, hi, 0, 1, 2, 3, 4, 5, 6, 7); }
__device__ __forceinline__ bf16x8 pack_step(const f32x16& x, int s) {
    u32x4 p; p.x = cvtpk(x[8 * s], x[8 * s + 1]); p.y = cvtpk(x[8 * s + 2], x[8 * s + 3]); p.z = cvtpk(x[8 * s + 4], x[8 * s + 5]); p.w = cvtpk(x[8 * s + 6], x[8 * s + 7]);
    return __builtin_bit_cast(bf16x8, p);
}
__device__ __forceinline__ bf16x8 row_frag(LAS const unsigned char* p) { const s16x4 lo = *(LAS const s16x4*)p, hi = *(LAS const s16x4*)(p + 16); return cat8(lo, hi); }

namespace swa {
constexpr int KOFF = 0, VOFF = 3 * 8192, LDS_NEED = 6 * 8192, NUNITS = BATCH * 2 * (SEQ / 64);
__device__ __forceinline__ void unit(int un, const bf16* QA, const bf16* KA, const bf16* VA, bf16* OC  , const float* sinks, LAS unsigned char* lds, int tid) {
    const int lane = tid & 63, r32 = lane & 31, hi = lane >> 5, w = __builtin_amdgcn_readfirstlane(tid >> 6);
    const int i = un & 127, hk = (un >> 7) & 1, b = un >> 8;
    const size_t rowb = (size_t)b * SEQ;
#pragma unroll
    for (int jt = 0; jt < 3; ++jt) {
        const int ti = i - 2 + jt; u32x4 kv = {0u, 0u, 0u, 0u}, vv = {0u, 0u, 0u, 0u};
        if (ti >= 0) {
            kv = *(const u32x4*)(KA + (rowb + ti * 64 + (tid & 63)) * 128 + hk * 64 + (tid >> 6) * 8);
            vv = *(const u32x4*)(VA + (rowb + ti * 64 + 16 * (w & 3) + (lane >> 2)) * 128 + hk * 64 + (w >> 2) * 32 + (lane & 3) * 8);
        }
        *(LAS u32x4*)(lds + KOFF + jt * 8192 + (tid >> 6) * 1024 + (tid & 63) * 16) = kv;
        *(LAS u32x4*)(lds + VOFF + jt * 8192 + tid * 16) = vv;
    }
    const int hq = 4 * hk + (w >> 1), qh = w & 1;
    const bf16* qp = QA + (rowb + 64 * i + 32 * qh + r32) * 512 + hq * 64 + hi * 8;
    bf16x8 qr[4];
#pragma unroll
    for (int d0 = 0; d0 < 4; ++d0) qr[d0] = *(const bf16x8*)(qp + d0 * 16);
    const float sink2 = sinks[hq] * LOG2E;
    __syncthreads();
    f32x16 p[5];
    const int tq = 64 * i + 32 * qh + r32;
    float mx = -INFINITY;
#pragma unroll
    for (int j = 0; j < 5; ++j) {
        const int st = qh + j, jt = st >> 1, kh = st & 1;
        f32x16 a = {};
#pragma unroll
        for (int d0 = 0; d0 < 4; ++d0) { const bf16x8 kf = *(LAS const bf16x8*)(lds + KOFF + jt * 8192 + (2 * d0 + hi) * 1024 + (32 * kh + r32) * 16); a = MFMA32(kf, qr[d0], a); }
        const int tk0 = 64 * (i - 2) + 32 * st;
#pragma unroll
        for (int r = 0; r < 16; ++r) { const int tk = tk0 + crow(r, hi); const bool ok = (tk >= 0) && (tk <= tq) && (tq - tk < 128); a[r] = ok ? a[r] : -INFINITY; mx = fmaxf(mx, a[r]); }
        p[j] = a;
    }
    mx = fmaxf(mx, __shfl_xor(mx, 32));
    const float mm = fmaxf(mx, sink2);
    float sum = 0.f;
#pragma unroll
    for (int j = 0; j < 5; ++j)
#pragma unroll
        for (int r = 0; r < 16; ++r) { const float e = __builtin_amdgcn_exp2f(p[j][r] - mm); p[j][r] = e; sum += e; }
    sum += __shfl_xor(sum, 32);
    const float inv = 1.0f / (sum + __builtin_amdgcn_exp2f(sink2 - mm));
    f32x16 o[2] = {{}, {}};
    LAS const unsigned char* vb = lds + VOFF + ((lane >> 4) & 1) * 32 + (lane & 3) * 8 + (4 * hi + ((lane & 15) >> 2)) * 64;
#pragma unroll
    for (int j = 0; j < 5; ++j) {
        const int st = qh + j, jt = st >> 1, kh = st & 1;
#pragma unroll
        for (int s = 0; s < 2; ++s) { const bf16x8 pf = pack_step(p[j], s); const int ks = 2 * kh + s;
#pragma unroll
            for (int d0 = 0; d0 < 2; ++d0) { LAS const unsigned char* vp = vb + jt * 8192 + d0 * 4096 + ks * 1024; const bf16x8 vf = cat8(tr_rd(vp), tr_rd(vp + 512)); o[d0] = MFMA32(vf, pf, o[d0]); } }
    }
    bf16* op = OC + (rowb + 64 * i + 32 * qh + r32) * 1536 + hq * 64 + 4 * hi;
#pragma unroll
    for (int d0 = 0; d0 < 2; ++d0)
#pragma unroll
        for (int g = 0; g < 4; ++g) { u32x2 wv; wv.x = cvtpk(o[d0][4 * g] * inv, o[d0][4 * g + 1] * inv); wv.y = cvtpk(o[d0][4 * g + 2] * inv, o[d0][4 * g + 3] * inv); *(u32x2*)(op + 32 * d0 + 8 * g) = wv; }
    __syncthreads();
}
}

#ifndef G3SEC
#define G3SEC 0
#endif
__device__ __noinline__ void probe_fn(int mode);
#define SEC_B(k) do { if (G3SEC == (k) && blockIdx.x == 0) probe_fn(0); } while (0)
#define SEC_E(k) do { if (G3SEC == (k) && blockIdx.x == 0) probe_fn(1); } while (0)
namespace gla {
constexpr int PQ = 264, PK3 = 320, PV = 576, PA = 136;
constexpr int O_Q1 = 0, O_Q2 = 16896, O_K2 = 33792, O_K3 = 50688, O_V = 71168, O_A = 108032, O_GLR = 116736, O_TOT = 120832, O_DV = 124928, O_PART = 125440, LDS_NEED = 127488;
constexpr int O_WG = 131072 + 2048;
constexpr int NSEG = 32, CPS = 4, NUNITS = 8 * NSEG, SELEMS = 128 * 256, SPAIRS = SELEMS / 2;
__device__ __forceinline__ unsigned short f2bf(float f) { unsigned u = __builtin_bit_cast(unsigned, f); return (unsigned short)((u + 0x7fffu + ((u >> 16) & 1u)) >> 16); }
__device__ __forceinline__ float bf2f(unsigned short h) { return __builtin_bit_cast(float, (unsigned)h << 16); }
__device__ __forceinline__ float logsig(float x) { return fminf(x, 0.f) - __logf(1.f + __expf(-fabsf(x))); }

struct KgRegs { u32x4 q[2], k[2]; f32x4 g; };
struct VRegs { u32x4 v[4]; };
template <bool FULL> __device__ __forceinline__ void fetch_kg(KgRegs& R, const bf16* QB, const bf16* KB, const float* GLR, size_t r0, int h, int tid) {
#pragma unroll
    for (int i = 0; i < 2; ++i) { const int p = tid + 512 * i, row = p >> 4, c = p & 15;
        R.k[i] = *(const u32x4*)(KB + (r0 + row) * 512 + h * 128 + c * 8);
        if (FULL) R.q[i] = *(const u32x4*)(QB + (r0 + row) * 512 + h * 128 + c * 8); }
    R.g = (f32x4){0.f, 0.f, 0.f, 0.f};
    if (tid < 256) R.g = *(const f32x4*)(GLR + r0 * 16 + tid * 4);
}
__device__ __forceinline__ void fetch_v(VRegs& R, const bf16* VB, size_t r0, int h, int tid) {
#pragma unroll
    for (int i = 0; i < 4; ++i) { const int p = tid + 512 * i, row = p >> 5, c = p & 31; R.v[i] = *(const u32x4*)(VB + (r0 + row) * 1024 + h * 256 + c * 8); }
}
template <bool FULL> __device__ __forceinline__ void put_kg(const KgRegs& R, LAS unsigned char* lds, int tid) {
#pragma unroll
    for (int i = 0; i < 2; ++i) { const int p = tid + 512 * i, row = p >> 4, c = p & 15;
        LAS u32x2* kd = (LAS u32x2*)(lds + O_K2 + row * PQ + c * 16); kd[0] = (u32x2){R.k[i].x, R.k[i].y}; kd[1] = (u32x2){R.k[i].z, R.k[i].w};
        if (FULL) { LAS u32x2* qd = (LAS u32x2*)(lds + O_Q1 + row * PQ + c * 16); qd[0] = (u32x2){R.q[i].x, R.q[i].y}; qd[1] = (u32x2){R.q[i].z, R.q[i].w}; } }
    if (tid < 256) *(LAS f32x4*)(lds + O_GLR + tid * 16) = R.g;
}
__device__ __forceinline__ void put_v(const VRegs& R, LAS unsigned char* lds, int tid) {
#pragma unroll
    for (int i = 0; i < 4; ++i) { const int p = tid + 512 * i, row = p >> 5, c = p & 31; *(LAS u32x4*)(lds + O_V + row * PV + c * 16) = R.v[i]; }
}
__device__ __forceinline__ void load_wg(const float* wgate, const float* gbias, int h, LAS unsigned char* lds, int tid) {
    LAS float* W = (LAS float*)(lds + O_WG);
#pragma unroll
    for (int i = 0; i < 4; ++i) { const int e = tid + 512 * i, j = e >> 7, c = e & 127; W[e] = wgate[j * 512 + h * 128 + c]; }
    if (tid < 128) W[2048 + tid] = gbias[h * 128 + tid];
}
template <bool FULL> __device__ __forceinline__ void prep(LAS unsigned char* lds, int tid, float& blast0, float& blast1) {
    const int cp = tid & 63, w = tid >> 6;
    __syncthreads();
    LAS const float* W = (LAS const float*)(lds + O_WG);
    float wa[16], wb[16];
#pragma unroll
    for (int j = 0; j < 16; ++j) { const f32x2_t t = *(LAS const f32x2_t*)(W + j * 128 + 2 * cp); wa[j] = t.x; wb[j] = t.y; }
    const f32x2_t bias = *(LAS const f32x2_t*)(W + 2048 + 2 * cp);
    float bl0[8], bl1[8]; float run0 = 0.f, run1 = 0.f;
#pragma unroll
    for (int i = 0; i < 8; ++i) { LAS const f32x4* g = (LAS const f32x4*)(lds + O_GLR + (8 * w + i) * 64); const f32x4 g0 = g[0], g1 = g[1], g2 = g[2], g3 = g[3];
        float x0 = bias.x, x1 = bias.y;
#pragma unroll
        for (int j = 0; j < 4; ++j) { x0 += g0[j] * wa[j]; x1 += g0[j] * wb[j]; }
#pragma unroll
        for (int j = 0; j < 4; ++j) { x0 += g1[j] * wa[4 + j]; x1 += g1[j] * wb[4 + j]; }
#pragma unroll
        for (int j = 0; j < 4; ++j) { x0 += g2[j] * wa[8 + j]; x1 += g2[j] * wb[8 + j]; }
#pragma unroll
        for (int j = 0; j < 4; ++j) { x0 += g3[j] * wa[12 + j]; x1 += g3[j] * wb[12 + j]; }
        run0 += logsig(x0) * 0.0625f; run1 += logsig(x1) * 0.0625f; bl0[i] = run0; bl1[i] = run1; }
    LAS f32x2_t* TOT = (LAS f32x2_t*)(lds + O_TOT);
    TOT[w * 64 + cp] = (f32x2_t){run0, run1};
    __syncthreads();
    float pre0 = 0.f, pre1 = 0.f, rr0 = 0.f, rr1 = 0.f, bt0 = 0.f, bt1 = 0.f;
#pragma unroll
    for (int g = 0; g < 8; ++g) { const f32x2_t t = TOT[g * 64 + cp]; if (g < w) { pre0 += t.x; pre1 += t.y; } if (g < 4) { rr0 += t.x; rr1 += t.y; } bt0 += t.x; bt1 += t.y; }
    const float c40 = __expf(bt0), c41 = __expf(bt1), c20 = __expf(-rr0), c21 = __expf(-rr1), c30 = __expf(rr0), c31 = __expf(rr1);
#pragma unroll
    for (int i = 0; i < 8; ++i) { const int t = 8 * w + i; const float e10 = __expf(pre0 + bl0[i]), e11 = __expf(pre1 + bl1[i]); const float i10 = __builtin_amdgcn_rcpf(e10), i11 = __builtin_amdgcn_rcpf(e11);
        const unsigned kk = *(LAS const unsigned*)(lds + O_K2 + t * PQ + cp * 4); const float k0 = __builtin_bit_cast(float, kk << 16), k1 = __builtin_bit_cast(float, kk & 0xffff0000u);
        *(LAS unsigned*)(lds + O_K3 + t * PK3 + cp * 4) = cvtpk(k0 * (i10 * c40), k1 * (i11 * c41));
        if (FULL) { const unsigned qq = *(LAS const unsigned*)(lds + O_Q1 + t * PQ + cp * 4); const float q0 = __builtin_bit_cast(float, qq << 16), q1 = __builtin_bit_cast(float, qq & 0xffff0000u);
            *(LAS unsigned*)(lds + O_Q1 + t * PQ + cp * 4) = cvtpk(q0 * e10, q1 * e11);
            *(LAS unsigned*)(lds + O_Q2 + t * PQ + cp * 4) = cvtpk(q0 * (e10 * c20), q1 * (e11 * c21));
            *(LAS unsigned*)(lds + O_K2 + t * PQ + cp * 4) = cvtpk(k0 * (i10 * c30), k1 * (i11 * c31)); } }
    if (w == 7) *(LAS f32x2_t*)(lds + O_DV + cp * 8) = (f32x2_t){c40, c41};
    blast0 = bt0; blast1 = bt1;
}
__device__ __forceinline__ void state_update(f32x16 (&S)[4], LAS unsigned char* lds, int w, int lane) {
    const int hi = lane >> 5, i16 = lane & 15, g16 = (lane >> 4) & 1;
    LAS const float* DVp = (LAS const float*)(lds + O_DV);
#pragma unroll
    for (int tile = 0; tile < 4; ++tile) {
#pragma unroll
        for (int r = 0; r < 16; ++r) S[tile][r] *= DVp[32 * tile + crow(r, hi)];
        asm volatile("" ::: "memory"); }
    LAS const unsigned char* vb = lds + O_V + (4 * hi + (i16 >> 2)) * PV + (32 * w + 16 * g16 + 4 * (i16 & 3)) * 2;
    LAS const unsigned char* kb = lds + O_K3 + (4 * hi + (i16 >> 2)) * PK3 + (16 * g16 + 4 * (i16 & 3)) * 2;
#pragma unroll
    for (int ks = 0; ks < 4; ++ks) { const bf16x8 vf = cat8(tr_rd(vb + ks * 16 * PV), tr_rd(vb + (ks * 16 + 8) * PV));
#pragma unroll
        for (int tile = 0; tile < 4; ++tile) { const bf16x8 kf = cat8(tr_rd(kb + ks * 16 * PK3 + tile * 64), tr_rd(kb + (ks * 16 + 8) * PK3 + tile * 64)); S[tile] = MFMA32(kf, vf, S[tile]); } }
}
struct Tensors { const bf16 *QB, *KB, *VB, *RB; bf16* OB; const float *GLR, *wgate, *gbias, *onorm; float *R, *SST, *DSEG; };

__device__ __forceinline__ void g1_unit(int un, const Tensors& T, LAS unsigned char* lds, int tid) {
    const int lane = tid & 63, w = __builtin_amdgcn_readfirstlane(tid >> 6);
    const int chain = un >> 5, seg = un & 31, b = chain >> 2, h = chain & 3;
    const size_t rb = (size_t)b * SEQ + (size_t)(seg * CPS) * 64;
    KgRegs KG; fetch_kg<false>(KG, T.QB, T.KB, T.GLR, rb, h, tid);
    load_wg(T.wgate, T.gbias, h, lds, tid);
    f32x16 S[4] = {{}, {}, {}, {}}; float bs0 = 0.f, bs1 = 0.f;
#pragma unroll 1
    for (int c = 0; c < CPS; ++c) {
        int tl = tid; asm volatile("" : "+v"(tl));
        put_kg<false>(KG, lds, tl);
        VRegs VR; fetch_v(VR, T.VB, rb + (size_t)c * 64, h, tl);
        float b0, b1; prep<false>(lds, tid, b0, b1); bs0 += b0; bs1 += b1;
        if (c + 1 < CPS) fetch_kg<false>(KG, T.QB, T.KB, T.GLR, rb + (size_t)(c + 1) * 64, h, tl);
        put_v(VR, lds, tl);
        __syncthreads();
        state_update(S, lds, w, lane);
        __syncthreads();
    }
    unsigned* Rp = (unsigned*)T.R + (size_t)un * SPAIRS + tid;
#pragma unroll
    for (int tile = 0; tile < 4; ++tile)
#pragma unroll
        for (int r = 0; r < 16; r += 2) Rp[(tile * 8 + (r >> 1)) * 512] = cvtpk(S[tile][r], S[tile][r + 1]);
    if (tid >= 448) *(f32x2_t*)(T.DSEG + un * 128 + 2 * (tid & 63)) = (f32x2_t){__expf(bs0), __expf(bs1)};
}
__device__ __forceinline__ void g2_scan(const Tensors& T, int gtid, int gthreads) {
    for (int e = gtid; e < 8 * SPAIRS; e += gthreads) {
        const int chain = e / SPAIRS, idx = e % SPAIRS, k = idx >> 9, ln = idx & 63, reg = 2 * k;
        const int dk = 32 * (reg >> 4) + crow(reg & 15, ln >> 5);
        const unsigned* Rp = (const unsigned*)T.R + (size_t)chain * NSEG * SPAIRS + idx; unsigned* Sp = (unsigned*)T.SST + (size_t)chain * NSEG * SPAIRS + idx; const float* Dp = T.DSEG + chain * NSEG * 128 + dk;
        float sa = 0.f, sb = 0.f;
#pragma unroll 1
        for (int s0 = 0; s0 < NSEG; s0 += 16) { unsigned r[16]; f32x2_t d[16];
#pragma unroll
            for (int j = 0; j < 16; ++j) { r[j] = __builtin_nontemporal_load(Rp + (size_t)(s0 + j) * SPAIRS); d[j] = *(const f32x2_t*)(Dp + (s0 + j) * 128); }
#pragma unroll
            for (int j = 0; j < 16; ++j) { Sp[(size_t)(s0 + j) * SPAIRS] = cvtpk(sa, sb);
                sa = sa * d[j].x + __builtin_bit_cast(float, r[j] << 16); sb = sb * d[j].y + __builtin_bit_cast(float, r[j] & 0xffff0000u); } }
    }
}
__device__ __forceinline__ void g3_unit(int un, const Tensors& T, LAS unsigned char* lds, int tid) {
    const int lane = tid & 63, r32 = lane & 31, hi = lane >> 5, w = __builtin_amdgcn_readfirstlane(tid >> 6), i16 = lane & 15, g16 = (lane >> 4) & 1;
    const int chain = un >> 5, seg = un & 31, b = chain >> 2, h = chain & 3;
    const size_t rb = (size_t)b * SEQ + (size_t)(seg * CPS) * 64;
    load_wg(T.wgate, T.gbias, h, lds, tid);
    f32x16 S[4];
    { const unsigned* Sp = (const unsigned*)T.SST + (size_t)un * SPAIRS + tid;
#pragma unroll
      for (int tile = 0; tile < 4; ++tile)
#pragma unroll
          for (int r = 0; r < 16; r += 2) { const unsigned w2 = Sp[(tile * 8 + (r >> 1)) * 512]; S[tile][r] = __builtin_bit_cast(float, w2 << 16); S[tile][r + 1] = __builtin_bit_cast(float, w2 & 0xffff0000u); } }
#pragma unroll 1
    for (int c = 0; c < CPS; ++c) {
        const size_t r0 = rb + (size_t)c * 64;
        int tl = tid; asm volatile("" : "+v"(tl));
        SEC_B(1);
        { KgRegs KG; VRegs VR; fetch_kg<true>(KG, T.QB, T.KB, T.GLR, r0, h, tl); fetch_v(VR, T.VB, r0, h, tl); put_kg<true>(KG, lds, tl);
          float b0, b1; prep<true>(lds, tid, b0, b1);
          put_v(VR, lds, tl); }
        __syncthreads(); SEC_E(1); SEC_B(2);
        if (w < 3) { const int tt = (w >= 1), st = (w == 2); f32x16 d = {};
            LAS const unsigned char* kp = lds + O_K2 + (32 * st + r32) * PQ + 8 * hi; LAS const unsigned char* qp = lds + O_Q2 + (32 * tt + r32) * PQ + 8 * hi;
#pragma unroll
            for (int kc = 0; kc < 8; ++kc) d = MFMA32(row_frag(kp + kc * 32), row_frag(qp + kc * 32), d);
            const int t = 32 * tt + r32;
#pragma unroll
            for (int g = 0; g < 4; ++g) { const int s0 = 32 * st + 8 * g + 4 * hi; float v[4];
#pragma unroll
                for (int e = 0; e < 4; ++e) v[e] = (s0 + e <= t) ? d[4 * g + e] : 0.f;
                *(LAS u32x2*)(lds + O_A + t * PA + s0 * 2) = (u32x2){cvtpk(v[0], v[1]), cvtpk(v[2], v[3])}; } }
        f32x16 o[2] = {{}, {}};
#pragma unroll
        for (int tile = 0; tile < 4; ++tile)
#pragma unroll
            for (int s = 0; s < 2; ++s) { const bf16x8 sf = pack_step(S[tile], s);
#pragma unroll
                for (int tt = 0; tt < 2; ++tt) o[tt] = MFMA32(sf, row_frag(lds + O_Q1 + (32 * tt + r32) * PQ + (32 * tile + 16 * s + 4 * hi) * 2), o[tt]); }
        __syncthreads();
        SEC_E(2); SEC_B(3);
        u32x2 rrv[2][4];
#pragma unroll
        for (int tt = 0; tt < 2; ++tt)
#pragma unroll
            for (int g = 0; g < 4; ++g) rrv[tt][g] = *(const u32x2*)(T.RB + (r0 + 32 * tt + r32) * 1024 + h * 256 + 32 * w + 4 * hi + 8 * g);
        LAS const unsigned char* vb = lds + O_V + (4 * hi + (i16 >> 2)) * PV + (32 * w + 16 * g16 + 4 * (i16 & 3)) * 2;
#pragma unroll
        for (int ks = 0; ks < 4; ++ks) { const bf16x8 vf = cat8(tr_rd(vb + ks * 16 * PV), tr_rd(vb + (ks * 16 + 8) * PV));
            if (ks < 2) o[0] = MFMA32(vf, row_frag(lds + O_A + r32 * PA + (16 * ks + 4 * hi) * 2), o[0]);
            o[1] = MFMA32(vf, row_frag(lds + O_A + (32 + r32) * PA + (16 * ks + 4 * hi) * 2), o[1]); }
        state_update(S, lds, w, lane);
        SEC_E(3); SEC_B(4);
        LAS float* PART = (LAS float*)(lds + O_PART);
        f32x4 gn4[4];
#pragma unroll
        for (int g = 0; g < 4; ++g) gn4[g] = *(const f32x4*)(T.onorm + h * 256 + 32 * w + 8 * g + 4 * hi);
#pragma unroll
        for (int tt = 0; tt < 2; ++tt) { float ss = 0.f;
#pragma unroll
            for (int r = 0; r < 16; ++r) ss += o[tt][r] * o[tt][r];
            ss += __shfl_xor(ss, 32); if (hi == 0) PART[w * 64 + 32 * tt + r32] = ss; }
        __syncthreads();
#pragma unroll
        for (int tt = 0; tt < 2; ++tt) { const int t = 32 * tt + r32; float tot = 0.f;
#pragma unroll
            for (int ww = 0; ww < 8; ++ww) tot += PART[ww * 64 + t];
            const float rstd = __builtin_amdgcn_rsqf(tot * (1.0f / 256.0f) + 1e-6f);
            const size_t obase = (r0 + t) * 1536 + 512 + h * 256 + 32 * w + 4 * hi;
#pragma unroll
            for (int g = 0; g < 4; ++g) { const u32x2 rr = rrv[tt][g];
                const float v0 = o[tt][4 * g] * rstd * gn4[g][0] * __builtin_bit_cast(float, rr.x << 16), v1 = o[tt][4 * g + 1] * rstd * gn4[g][1] * __builtin_bit_cast(float, rr.x & 0xffff0000u);
                const float v2 = o[tt][4 * g + 2] * rstd * gn4[g][2] * __builtin_bit_cast(float, rr.y << 16), v3 = o[tt][4 * g + 3] * rstd * gn4[g][3] * __builtin_bit_cast(float, rr.y & 0xffff0000u);
                *(u32x2*)(T.OB + obase + 8 * g) = (u32x2){cvtpk(v0, v1), cvtpk(v2, v3)}; } }
        __syncthreads();
        SEC_E(4);
    }
}
}
#define CAS __attribute__((address_space(4)))

constexpr size_t MiB = 1u << 20;
constexpr size_t WS_CTL = 0, CTL_ZERO_BYTES = 1 * MiB;
constexpr size_t WS_ROPEC = 1 * MiB, WS_ROPES = 2 * MiB;
constexpr size_t WS_STATS = 3 * MiB;
constexpr size_t WS_GLR = 4 * MiB;
constexpr size_t WS_DSEG = 5 * MiB;
constexpr size_t WS_W = 6 * MiB;
constexpr size_t WS_XB = 108 * MiB;
constexpr size_t WS_ZH = 140 * MiB;
constexpr size_t Z_QA = WS_ZH, Z_KA = WS_ZH + 16 * MiB, Z_VA = WS_ZH + 20 * MiB, Z_QB = WS_ZH + 24 * MiB, Z_KB = WS_ZH + 40 * MiB, Z_VB = WS_ZH + 56 * MiB, Z_RB = WS_ZH + 88 * MiB, Z_GA = WS_ZH + 120 * MiB, Z_GB = WS_ZH + 152 * MiB;
constexpr size_t WS_R = 324 * MiB, WS_SST = 356 * MiB;
constexpr size_t WS_OC = 388 * MiB, WS_END = 436 * MiB;
constexpr size_t WS_DBG = 436 * MiB;
constexpr int CW_BAR = 4096, CW_DBG = 16384;
constexpr int RING_BYTES = 131072, MISC_OFF = RING_BYTES + 320, RSTD_OFF = RING_BYTES + 1024, LDS_BYTES = 147456;
static_assert(pg8::EPI_ROPEC == WS_ROPEC && pg8::EPI_ROPES == WS_ROPES && pg8::EPI_STATS == WS_STATS && pg8::EPI_GLR == WS_GLR && pg8::EPI_QA == Z_QA && pg8::EPI_KA == Z_KA && pg8::EPI_VA == Z_VA && pg8::EPI_QB == Z_QB && pg8::EPI_KB == Z_KB && pg8::EPI_VB == Z_VB && pg8::EPI_RB == Z_RB && pg8::EPI_GA == Z_GA && pg8::EPI_GB == Z_GB, "w_in epilogue offsets match the workspace map");
static_assert(gla::O_WG >= RSTD_OFF + 1024 && gla::O_WG + 8704 <= LDS_BYTES, "gate-weight table above the ring");
static_assert(swa::LDS_NEED <= RING_BYTES && gla::LDS_NEED <= RING_BYTES, "phase scratch fits the ring region");

__device__ __forceinline__ void conv_item64(const float* W, int ldw, int c0a, int nva, int c0b, int nvb, const float* gain, int k0, bf16* WT, int drow0, int K, int kdst, LAS unsigned char* scr, int lane) {
    const int r = lane >> 4, c = lane & 15;
    const int col = (c < 8) ? c0a + 4 * c : c0b + 4 * (c - 8); const bool ok = (c < 8) ? (4 * c < nva) : (4 * (c - 8) < nvb);
    f32x4 v[16];
#pragma unroll
    for (int i = 0; i < 16; ++i) v[i] = ok ? __builtin_nontemporal_load((const f32x4*)(W + (size_t)(k0 + 4 * i + r) * ldw + col)) : (f32x4){0.f, 0.f, 0.f, 0.f};
    if (gain) {
#pragma unroll
        for (int i = 0; i < 16; ++i) v[i] = v[i] * gain[k0 + 4 * i + r]; }
#pragma unroll
    for (int i = 0; i < 16; ++i) *(LAS u32x2*)(scr + (4 * i + r) * 160 + c * 8) = (u32x2){cvtpk(v[i].x, v[i].y), cvtpk(v[i].z, v[i].w)};
    const int i16 = lane & 15, q = i16 >> 2, pp = i16 & 3;
#pragma unroll
    for (int nb = 0; nb < 4; ++nb)
#pragma unroll
        for (int kb = 0; kb < 4; ++kb) { const s16x4 t = tr_rd(scr + (16 * kb + 4 * r + q) * 160 + (16 * nb + 4 * pp) * 2);
            *(s16x4*)(WT + (size_t)(drow0 + 16 * nb + i16) * K + kdst + 16 * kb + 4 * r) = t; }
}
constexpr size_t W_GU1 = 0, W_D1 = 11 * MiB, W_IN = 17 * MiB, W_PA = 29 * MiB, W_PB = 30 * MiB, W_OUT = 32 * MiB, W_GU2 = 34 * MiB, W_D2 = 45 * MiB, W_SET = 51 * MiB;
constexpr int CI_GU = 16 * 88, CI_D = 44 * 16, CI_IN = 16 * 96, CI_PA = 8 * 16, CI_PB = 16 * 16, CI_OUT = 16 * 16, CI_ALL = 2 * CI_GU + 2 * CI_D + CI_IN + CI_PA + CI_PB + CI_OUT;
__device__ __forceinline__ void conv_run(const float* const CAS* in, int l, unsigned char* wset, int it_lo, int it_hi, int widx, int nworkers, LAS unsigned char* scr, int lane) {
    for (int it = it_lo + widx; it < it_hi; it += nworkers) {
        int r = it;
        if (r < 2 * CI_GU) { const int second = r >= CI_GU; r -= second * CI_GU; const int kb = r / 88, dg = 2 * (r % 88), tile = dg >> 3, bj = (dg >> 2) & 1, wc = dg & 3;
            const float* src = in[(second ? 17 : 2) + bj] + (size_t)l * DM * FF; const int c0 = 128 * tile + 32 * wc;
            conv_item64(src, FF, c0, 32, c0 + 32, 32, in[second ? 16 : 1] + (size_t)l * DM, 64 * kb, (bf16*)(wset + (second ? W_GU2 : W_GU1)), 32 * dg, DM, 64 * kb, scr, lane); continue; }
        r -= 2 * CI_GU;
        if (r < 2 * CI_D) { const int second = r >= CI_D; r -= second * CI_D; const int kb = r / 16, pr = r % 16;
            conv_item64(in[second ? 19 : 4] + (size_t)l * FF * DM, DM, 64 * pr, 32, 64 * pr + 32, 32, nullptr, 64 * kb, (bf16*)(wset + (second ? W_D2 : W_D1)), 64 * pr, FF, 64 * kb, scr, lane); continue; }
        r -= 2 * CI_D;
        if (r < CI_IN) { const int kb = r / 96, dg = 2 * (r % 96), tile = dg >> 3, bj = (dg >> 2) & 1, wc = dg & 3; int ca, cb, na = 32, nb = 32;
            if (tile < 2) { ca = 64 * (4 * tile + wc) + 32 * bj; cb = ca + 64; }
            else if (tile == 2) { ca = (wc < 2 ? 512 : 640) + 32 * bj; cb = ca + 64; }
            else if (tile < 15) { ca = 32 * dg; cb = ca + 32; }
            else if (tile < 23) { ca = 32 * dg + 16; cb = ca + 32; }
            else { ca = 3840; cb = 3840; na = (dg == 184) ? 16 : 0; nb = 0; }
            conv_item64(in[6] + (size_t)l * DM * IN_COLS, IN_COLS, ca, na, cb, nb, in[5] + (size_t)l * DM, 64 * kb, (bf16*)(wset + W_IN), 32 * dg, DM, 64 * kb, scr, lane); continue; }
        r -= CI_IN;
        if (r < CI_PA) { const int kb = r / 16, pr = r % 16; conv_item64(in[13] + (size_t)l * QAW * DM, DM, 64 * pr, 32, 64 * pr + 32, 32, nullptr, 64 * kb, (bf16*)(wset + W_PA), 64 * pr, QAW + GVW, 64 * kb, scr, lane); continue; }
        r -= CI_PA;
        if (r < CI_PB) { const int kb = r / 16, pr = r % 16; conv_item64(in[14] + (size_t)l * GVW * DM, DM, 64 * pr, 32, 64 * pr + 32, 32, nullptr, 64 * kb, (bf16*)(wset + W_PA), 64 * pr, QAW + GVW, QAW + 64 * kb, scr, lane); continue; }
        r -= CI_PB;
        { const int kb = r / 16, pr = r % 16; conv_item64(in[15] + (size_t)l * DM * DM, DM, 64 * pr, 32, 64 * pr + 32, 32, nullptr, 64 * kb, (bf16*)(wset + W_OUT), 64 * pr, DM, 64 * kb, scr, lane); }
    }
}
__device__ __forceinline__ float wave_sum(float v) {
#pragma unroll
    for (int o = 1; o < 64; o <<= 1) v += __shfl_xor(v, o);
    return v;
}
__device__ __forceinline__ void prologue_phase(const float* x, bf16* XB, float* stats, float* ropec, float* ropes, const float CAS* invf, int gw, int ngw, int lane, int gtid, int gthreads) {
    for (int m0 = gw * 2; m0 < M; m0 += ngw * 2) {
        f32x4 v[2][4];
#pragma unroll
        for (int rr = 0; rr < 2; ++rr) { const f32x4* xr = (const f32x4*)(x + (size_t)(m0 + rr) * DM) + lane;
#pragma unroll
            for (int j = 0; j < 4; ++j) v[rr][j] = __builtin_nontemporal_load(xr + 64 * j); }
        asm volatile("" ::: "memory");
#pragma unroll
        for (int rr = 0; rr < 2; ++rr) { const int m = m0 + rr; unsigned long long* o8 = (unsigned long long*)(XB + (size_t)m * DM) + lane; float s = 0.f;
#pragma unroll
            for (int j = 0; j < 4; ++j) { const f32x4 w = v[rr][j]; s += (w.x * w.x + w.y * w.y) + (w.z * w.z + w.w * w.w);
                o8[64 * j] = (unsigned long long)pk2(w.x, w.y) | ((unsigned long long)pk2(w.z, w.w) << 32); }
            s = wave_sum(s);
            if (lane < 16) stats[(size_t)m * 16 + lane] = (lane == 0) ? s : 0.f; }
    }
    for (int e = gtid; e < SEQ * 32; e += gthreads) { const int t = e >> 5, i = e & 31;
        const float ang = (float)t * invf[i];
        const double a = (double)ang, q = __builtin_rint(a * 0.63661977236758134308), r = __builtin_fma(-q, 6.123233995736766036e-17, __builtin_fma(-q, 1.57079632679489655800, a)), r2 = r * r;
        const double sn = r * (1.0 - r2 / 6.0 * (1.0 - r2 / 20.0 * (1.0 - r2 / 42.0 * (1.0 - r2 / 72.0 * (1.0 - r2 / 110.0 * (1.0 - r2 / 156.0 * (1.0 - r2 / 210.0 * (1.0 - r2 / 272.0))))))));
        const double cs = 1.0 - r2 / 2.0 * (1.0 - r2 / 12.0 * (1.0 - r2 / 30.0 * (1.0 - r2 / 56.0 * (1.0 - r2 / 90.0 * (1.0 - r2 / 132.0 * (1.0 - r2 / 182.0 * (1.0 - r2 / 240.0)))))));
        const int qi = (int)q & 3;
        const double c = (qi == 0) ? cs : (qi == 1) ? -sn : (qi == 2) ? -cs : sn, s_ = (qi == 0) ? sn : (qi == 1) ? cs : (qi == 2) ? -sn : -cs;
        ropec[e] = (float)c; ropes[e] = (float)s_; }
}

__device__ __forceinline__ void panel_rstd(const float* stats, int pm, LAS float* tab, int tid) {
    if (tid < 256) { const f32x4* p = (const f32x4*)(stats + (size_t)(pm * 256 + tid) * 16); const f32x4 t = (p[0] + p[1]) + (p[2] + p[3]);
        tab[tid] = __builtin_amdgcn_rsqf(((t[0] + t[1]) + (t[2] + t[3])) * (1.0f / 1024.0f) + 1e-6f); }
    __syncthreads();
}
struct Args { const float* in[20]; float* out; unsigned char* ws; float invf[32]; int s_lo, s_hi, ph_lo, ph_hi, do_pro, pad; };
enum { PH_CONV = 0, PH_GU = 1, PH_DN = 2, PH_IN = 3, PH_X1 = 4, PH_SCAN = 5, PH_G3 = 6, PH_PROJ = 7, PH_OUT = 8, N_PH = 9 };
#ifndef PHMASK
#define PHMASK 0x3ff
#endif
#define P_WSET(layer) (ws + WS_W + (size_t)((layer) & 1) * W_SET)
#define P_X     (ap->out)
#define P_XB    ((bf16*)(ws + WS_XB))
#define P_STATS ((float*)(ws + WS_STATS))
#define P_HID   ((bf16*)(ws + WS_ZH))
#define P_QA    ((bf16*)(ws + Z_QA))
#define P_KA    ((bf16*)(ws + Z_KA))
#define P_VA    ((bf16*)(ws + Z_VA))
#define P_QB    ((bf16*)(ws + Z_QB))
#define P_KB    ((bf16*)(ws + Z_KB))
#define P_VB    ((bf16*)(ws + Z_VB))
#define P_RB    ((bf16*)(ws + Z_RB))
#define P_GA    ((bf16*)(ws + Z_GA))
#define P_GB    ((bf16*)(ws + Z_GB))
#define P_GLR   ((float*)(ws + WS_GLR))
#define P_OC    ((bf16*)(ws + WS_OC))
#define P_ROPEC ((float*)(ws + WS_ROPEC))
#define P_ROPES ((float*)(ws + WS_ROPES))
#define PHASE_WS() const CAS Args* ap = (const CAS Args*)__builtin_amdgcn_kernarg_segment_ptr(); asm volatile("" : "+s"(ap)); unsigned char* ws = ap->ws; (void)ws; int bxl = bx, Gl = G; asm volatile("" : "+s"(bxl), "+s"(Gl)); (void)bxl; (void)Gl
#define PHASE_IDS() PHASE_WS(); int tid = tid0; asm volatile("" : "+v"(tid)); const int lane = tid & 63, wave = __builtin_amdgcn_readfirstlane(tid >> 6); const int gw = vcu * 8 + wave, gtid = vcu * 512 + tid; (void)lane; (void)gw; (void)gtid
#define GLA_TENSORS() gla::Tensors GT{P_QB, P_KB, P_VB, P_RB, P_OC, P_GLR, ap->in[10] + (size_t)l * 16 * GKW, ap->in[11] + (size_t)l * GKW, ap->in[12] + (size_t)l * GVW, (float*)(ws + WS_R), (float*)(ws + WS_SST), (float*)(ws + WS_DSEG)}
#ifndef PROBE_MASK
#define PROBE_MASK 0
#endif
#define PB(k) do { if (PROBE_MASK && ((PROBE_MASK >> (k)) & 1) && bx == 0) probe_fn(0); } while (0)
#define PE(k) do { if (PROBE_MASK && ((PROBE_MASK >> (k)) & 1) && bx == 0) probe_fn(1); } while (0)
#ifndef PROBE_AMP
#define PROBE_AMP 4
#endif
__device__ __noinline__ void probe_fn(int mode) {
    volatile LAS unsigned* Mw = (volatile LAS unsigned*)(uintptr_t)(MISC_OFF);
    if (threadIdx.x != 0) return;
    const unsigned long long now = __builtin_amdgcn_s_memrealtime();
    if (mode == 0) { Mw[16] = (unsigned)now; Mw[17] = (unsigned)(now >> 32); }
    else if (mode == 1) { const unsigned long long a_ = (((unsigned long long)Mw[19] << 32) | Mw[18]) + (now - (((unsigned long long)Mw[17] << 32) | Mw[16])); Mw[18] = (unsigned)a_; Mw[19] = (unsigned)(a_ >> 32); }
    else { const unsigned long long end_ = now + (unsigned long long)PROBE_AMP * (((unsigned long long)Mw[19] << 32) | Mw[18]); while (__builtin_amdgcn_s_memrealtime() < end_) __builtin_amdgcn_s_sleep(16); }
}
__global__ void __launch_bounds__(512, 2) mega_fwd(Args args) {
    extern __shared__ __attribute__((aligned(16))) unsigned char lds_raw[];
    LAS unsigned char* lds = (LAS unsigned char*)lds_raw;
    volatile LAS unsigned* MISC = (volatile LAS unsigned*)(lds + MISC_OFF);
    const int tid0 = threadIdx.x;
    const int G = gridDim.x, bx = blockIdx.x, vcu = (G % 8 == 0) ? (bx % 8) * (G / 8) + bx / 8 : bx;
    const int ngw = G * 8, gthreads = G * 512;
    for (int u = tid0; u < (LDS_BYTES - RING_BYTES) / 4; u += 512) ((LAS unsigned*)(lds + RING_BYTES))[u] = 0u;
    __syncthreads();
#if !MULTI
    XcdBarrier bar = xcd_barrier_post((unsigned*)(args.ws + WS_CTL) + CW_BAR, MISC + 8);
#define GRID_BAR() do { SEC_B(7); xcd_barrier(bar); SEC_E(7); } while (0)
#else
    (void)MISC;
#define GRID_BAR() do { } while (0)
#endif
    if (((PHMASK >> 9) & 1) && (!MULTI || args.do_pro)) {
        PB(9); PHASE_IDS(); prologue_phase(ap->in[0], P_XB, P_STATS, P_ROPEC, P_ROPES, ap->invf, gw, ngw, lane, gtid, gthreads);
        conv_run(ap->in, 0, P_WSET(0), 0, CI_ALL, gw, ngw, lds + wave * 16384, lane);
        GRID_BAR(); PE(9);
    }
#if MULTI
    const int lo = args.ph_lo, hi = args.ph_hi, s_lo = args.s_lo, s_hi = args.s_hi;
#define IN(k) (((PHMASK >> (k)) & 1) && lo <= (k) && (k) < hi)
#else
    constexpr int s_lo = 0, s_hi = 2 * DEPTH;
#define IN(k) ((PHMASK >> (k)) & 1)
#endif
    for (int st = s_lo; st < s_hi; ++st) {
        const int l = st >> 1, odd = st & 1;
        if (IN(PH_GU)) { PB(PH_GU); PHASE_WS();
            pg8::Gemm g{P_XB, (const bf16*)(P_WSET(l) + (odd ? W_GU2 : W_GU1)), M, NGU, DM}; pg8::StaticOrder S; S.init(M, NGU, Gl, bxl);
            { pg8::Unit u0; S.next(0, u0); panel_rstd(P_STATS, u0.pm, (LAS float*)(lds + RSTD_OFF), tid0); }
            pg8::EpiGU E{P_HID, (const LAS float*)(lds + RSTD_OFF)};
            pg8::gemm_phase<pg8::EpiGU, pg8::StaticOrder, true, true>(lds, g, S, E);
            if (((PHMASK >> PH_CONV) & 1) && l + 1 < DEPTH) {
                constexpr int NU = (M / 256) * (NGU / 256); const int rounds = (NU + Gl - 1) / Gl, nshort = rounds * Gl - NU, first = nshort ? Gl - nshort : 0, nw = nshort ? nshort : Gl;
                if (bxl >= first) { int tid = tid0; asm volatile("" : "+v"(tid)); const int lane = tid & 63, wave = __builtin_amdgcn_readfirstlane(tid >> 6); __syncthreads(); conv_run(ap->in, l + 1, P_WSET(l + 1), odd ? CI_ALL / 2 : 0, odd ? CI_ALL : CI_ALL / 2, (bxl - first) * 8 + wave, nw * 8, lds + wave * 16384, lane); }
            }
            GRID_BAR(); PE(PH_GU);
        }
        if (IN(PH_DN)) { PB(PH_DN); PHASE_WS();
            pg8::Gemm g{P_HID, (const bf16*)(P_WSET(l) + (odd ? W_D2 : W_D1)), M, DM, FF}; pg8::StaticOrder S; S.init(M, DM, Gl, bxl);
            pg8::EpiRes E{st == 0 ? ap->in[0] : (const float*)P_X, P_X, P_XB, P_STATS, 0.5f};
            pg8::gemm_phase<pg8::EpiRes, pg8::StaticOrder, false, true>(lds, g, S, E);
            if (MULTI || st + 1 < s_hi) GRID_BAR();
            PE(PH_DN);
        }
        if (!odd) {
            if (IN(PH_IN)) { PB(PH_IN); PHASE_WS();
                pg8::Gemm g{P_XB, (const bf16*)(P_WSET(l) + W_IN), M, NIN, DM}; pg8::StaticOrder S; S.init(M, NIN, Gl, bxl);
                { pg8::Unit u0; S.next(0, u0); panel_rstd(P_STATS, u0.pm, (LAS float*)(lds + RSTD_OFF), tid0); }
                pg8::EpiIn E{ws, ap->in[7] + l * 64, ap->in[8] + l * 64, (const LAS float*)(lds + RSTD_OFF)};
                pg8::gemm_phase<pg8::EpiIn, pg8::StaticOrder, true, true>(lds, g, S, E);
                GRID_BAR(); PE(PH_IN);
            }
            if (IN(PH_X1)) { PB(PH_X1);
                SEC_B(5); { PHASE_IDS(); GLA_TENSORS(); for (int un = vcu; un < gla::NUNITS; un += G) gla::g1_unit(un, GT, lds, tid); } SEC_E(5);
                GRID_BAR(); PE(PH_X1);
            }
            if (IN(PH_SCAN)) { PB(PH_SCAN);
                { PHASE_IDS(); GLA_TENSORS(); gla::g2_scan(GT, gtid, gthreads); }
                SEC_B(6); { PHASE_IDS(); for (int un = vcu; un < swa::NUNITS; un += G) swa::unit(un, P_QA, P_KA, P_VA, P_OC, ap->in[9] + l * 8, lds, tid); } SEC_E(6);
                GRID_BAR(); PE(PH_SCAN);
            }
            if (IN(PH_G3)) { PB(PH_G3); PHASE_IDS(); GLA_TENSORS(); for (int un = vcu; un < gla::NUNITS; un += G) gla::g3_unit(un, GT, lds, tid); GRID_BAR(); PE(PH_G3); }
            if (IN(PH_PROJ)) { PB(PH_PROJ); PHASE_WS();
                pg8::Gemm g{P_OC, (const bf16*)(P_WSET(l) + W_PA), M, DM, QAW + GVW}; pg8::StaticOrder S; S.init(M, DM, Gl, bxl); pg8::EpiPF E{P_GA, P_GB};
                pg8::gemm_phase<pg8::EpiPF, pg8::StaticOrder, false, true>(lds, g, S, E);
                GRID_BAR(); PE(PH_PROJ);
            }
            if (IN(PH_OUT)) { PB(PH_OUT); PHASE_WS();
                pg8::Gemm g{P_GA, (const bf16*)(P_WSET(l) + W_OUT), M, DM, DM}; pg8::StaticOrder S; S.init(M, DM, Gl, bxl);
                pg8::EpiRes E{P_X, P_X, P_XB, P_STATS, 1.0f};
                pg8::gemm_phase<pg8::EpiRes, pg8::StaticOrder, false, true>(lds, g, S, E);
                GRID_BAR(); PE(PH_OUT);
            }
        }
    }
#ifdef EXTRA_BARS
    for (int i_ = 0; i_ < EXTRA_BARS; ++i_) xcd_barrier(bar);
#endif
    if (PROBE_MASK && bx == 0) probe_fn(2);
#undef IN
}
constexpr size_t WS_DBG_END = WS_END;
constexpr size_t WS_NEED = (DBG ? WS_DBG_END : WS_END);

extern "C" void kernel_launch(void* const* d_in, const int* in_sizes, int n_in, void* d_out, int out_size, void* d_ws, size_t ws_size, hipStream_t stream) {
    static int grid = 0;
    if (grid == 0) {
        if (n_in != 20 || in_sizes[0] != M * DM || out_size != M * DM || ws_size < WS_NEED) {
            fprintf(stderr, "kernel_launch: built for 20 inputs, x/out of %d floats, >= %zu bytes of workspace; got n_in %d, in0 %d, out %d, ws %zu; nothing launched\n", M * DM, (size_t)WS_NEED, n_in, n_in > 0 ? in_sizes[0] : -1, out_size, ws_size); grid = -1; return; }
        int dev = 0, cus = 0, per_cu = 0;
        if (hipGetDevice(&dev) != hipSuccess || hipDeviceGetAttribute(&cus, hipDeviceAttributeMultiprocessorCount, dev) != hipSuccess) { fprintf(stderr, "kernel_launch: device query failed\n"); grid = -1; return; }
        if (hipFuncSetAttribute((const void*)mega_fwd, hipFuncAttributeMaxDynamicSharedMemorySize, LDS_BYTES) != hipSuccess) { fprintf(stderr, "kernel_launch: hipFuncSetAttribute failed\n"); grid = -1; return; }
        if (hipOccupancyMaxActiveBlocksPerMultiprocessor(&per_cu, (const void*)mega_fwd, 512, LDS_BYTES) != hipSuccess || per_cu < 1)
            fprintf(stderr, "kernel_launch: note: occupancy query reports %d workgroups per CU\n", per_cu);
        (void)hipGetLastError();
        grid = cus;
        if (grid != 256) { fprintf(stderr, "kernel_launch: built for a 256-CU device (one workgroup per CU, one row panel per workgroup in the GEMM phases); found %d CUs; nothing launched\n", cus); grid = -1; return; }
    }
    if (grid < 0) return;
    if (hipMemsetAsync((char*)d_ws + WS_CTL, 0, CTL_ZERO_BYTES, stream) != hipSuccess) { fprintf(stderr, "kernel_launch: memset failed\n"); return; }
    Args a{};
    for (int i = 0; i < 20; ++i) a.in[i] = (const float*)d_in[i];
    a.out = (float*)d_out; a.ws = (unsigned char*)d_ws;
    for (int i = 0; i < 32; ++i) a.invf[i] = (float)pow(10000.0, -(double)(2 * i) / 64.0);
#if !MULTI
    a.s_lo = 0; a.s_hi = 2 * DEPTH; a.ph_lo = 0; a.ph_hi = N_PH; a.do_pro = 1;
    hipLaunchKernelGGL(mega_fwd, dim3(grid), dim3(512), LDS_BYTES, stream, a);
#else
    a.s_lo = 0; a.s_hi = 0; a.ph_lo = 0; a.ph_hi = 0; a.do_pro = 1;
    hipLaunchKernelGGL(mega_fwd, dim3(grid), dim3(512), LDS_BYTES, stream, a);
    a.do_pro = 0;
    for (int st = 0; st < 2 * DEPTH; ++st)
        for (int ph = 0; ph < N_PH; ++ph) {
            if (ph == PH_CONV || ((st & 1) && ph >= PH_IN)) continue;
            a.s_lo = st; a.s_hi = st + 1; a.ph_lo = ph; a.ph_hi = ph + 1;
#if DBG
            dbg_before(a, st, ph, stream);
#endif
            hipLaunchKernelGGL(mega_fwd, dim3(grid), dim3(512), LDS_BYTES, stream, a);
#if DBG
            dbg_after(a, st, ph, stream);
#endif
        }
#if DBG
    hipLaunchKernelGGL(dbg_report, dim3(1024), dim3(256), 0, stream, (const float*)((unsigned char*)d_ws + WS_CTL) + CW_DBG, (float*)d_out);
#endif
#endif
    const hipError_t le = hipPeekAtLastError();
    if (le != hipSuccess) fprintf(stderr, "kernel_launch: launch failed: %s (grid %d)\n", hipGetErrorName(le), grid);
}
```

```cpp
#include <hip/hip_runtime.h>
#include <hip/hip_bf16.h>
#include <cstdio>
#include <cstdint>
#include <cmath>

#ifndef DBG
#define DBG 0
#endif
#ifndef MULTI
#define MULTI 0
#endif

constexpr int BATCH = 2, SEQ = 8192, DM = 1024, DEPTH = 4, M = BATCH * SEQ;
constexpr int FF = 2816, NGU = 2 * FF;
constexpr int IN_COLS = 5904, NIN = 6144;
constexpr int QAW = 512, KVW = 128, GKW = 512, GVW = 1024;
constexpr float EPS = 1e-6f;
constexpr float LOG2E = 1.4426950408889634f;
#ifndef G3SEC
#define G3SEC 0
#endif
__device__ __noinline__ void probe_fn(int mode);
#define PG8_SEC_B(k) do { if (G3SEC != 0 && G3SEC == (k) && blockIdx.x == 0) probe_fn(0); } while (0)
#define PG8_SEC_E(k) do { if (G3SEC != 0 && G3SEC == (k) && blockIdx.x == 0) probe_fn(1); } while (0)
namespace pg8 {
#define PG8_LAS __attribute__((address_space(3)))
typedef unsigned short bf16_t;
typedef short bf16x8 __attribute__((ext_vector_type(8)));
typedef float f32x4 __attribute__((ext_vector_type(4)));
typedef unsigned u32x4 __attribute__((ext_vector_type(4)));
constexpr int BM = 256, BK = 64, HALF = 128, HTB = HALF * BK * 2  , STAGE_BYTES = 8 * HTB, NXCD = 8, WGM = 8;

#ifndef PG8_SWZ
#define PG8_SWZ(x) ((x) ^ ((((x) >> 9) & 1) << 5))
#endif
__host__ __device__ __forceinline__ int lds_byte(int r, int c) { const int st = (r >> 4) * 2 + (c >> 5), rr = r & 15, cc = c & 31, ob = rr * 64 + cc * 2; return st * 1024 + PG8_SWZ(ob); }
__host__ __device__ __forceinline__ void stage_rc(int b, int& R, int& C) { const int st = b / 1024, sb = b % 1024, swz = PG8_SWZ(sb); R = (st >> 1) * 16 + swz / 64; C = (st & 1) * 32 + (swz % 64) / 2; }
__host__ __device__ __forceinline__ int perm32(int rho) { const int n = rho >> 4, i = rho & 15; return 8 * (i >> 2) + 4 * n + (i & 3); }

struct Unit { int pm, pn; };
struct Gemm { const bf16_t* A; const bf16_t* Bt; int M, N, K; };

struct StaticOrder {
    int nM, nN, nwg, G, c;
    __host__ __device__ void init(int M, int N, int G_, int c_) { nM = M / BM; nN = N / BM; nwg = nM * nN; G = G_; c = c_; }
    __host__ __device__ bool next(int i, Unit& u) const {
        const long L = (long)i * G + c; if (L >= nwg) return false;
        int wgid = (int)L; { const int q = nwg / NXCD, r = nwg % NXCD, xcd = wgid % NXCD, off = wgid / NXCD; wgid = (xcd < r ? xcd * (q + 1) : r * (q + 1) + (xcd - r) * q) + off; }
        const int nig = WGM * nN, gid = wgid / nig, fm = gid * WGM, gsz = (nM - fm) < WGM ? (nM - fm) : WGM;
        u.pm = fm + ((wgid % nig) % gsz); u.pn = (wgid % nig) / gsz; return true;
    }
    __device__ __forceinline__ void a_ready(const Unit&) const {}
    __device__ __forceinline__ void done(const Unit&) const {}
};

typedef float f32x2 __attribute__((ext_vector_type(2)));
typedef __bf16 bf16x2v __attribute__((ext_vector_type(2)));
__device__ __forceinline__ unsigned cvt_pk_bf16(float lo, float hi) { f32x2 v = {lo, hi}; bf16x2v b = __builtin_convertvector(v, bf16x2v); return __builtin_bit_cast(unsigned, b); }
__device__ __forceinline__ float silu_f(float g) { return g * __builtin_amdgcn_rcpf(1.f + __builtin_amdgcn_exp2f(-1.4426950408889634f * g)); }
__device__ __forceinline__ float sigm_f(float g) { return __builtin_amdgcn_rcpf(1.f + __builtin_amdgcn_exp2f(-1.4426950408889634f * g)); }
__device__ __forceinline__ float bf_lo(unsigned w) { return __builtin_bit_cast(float, w << 16); }
__device__ __forceinline__ float bf_hi(unsigned w) { return __builtin_bit_cast(float, w & 0xffff0000u); }
__device__ __forceinline__ float row_rstd(const float* stats, int row) {
    const f32x4* p = (const f32x4*)(stats + (size_t)row * 16);
    const f32x4 a = p[0], b = p[1], c = p[2], d = p[3]; const f32x4 s = (a + b) + (c + d);
    return __builtin_amdgcn_rsqf(((s[0] + s[1]) + (s[2] + s[3])) * (1.0f / 1024.0f) + 1e-6f);
}
__device__ __forceinline__ u32x4 pack8(const f32x4 v0, const f32x4 v1) { u32x4 w; w.x = cvt_pk_bf16(v0[0], v0[1]); w.y = cvt_pk_bf16(v0[2], v0[3]); w.z = cvt_pk_bf16(v1[0], v1[1]); w.w = cvt_pk_bf16(v1[2], v1[3]); return w; }

__device__ __forceinline__ void rows_rstd(float (&rs)[8], const PG8_LAS float* tab, int rl0) {
#pragma unroll
    for (int i = 0; i < 8; ++i) rs[i] = tab[rl0 + (i >> 2) * HALF + (i & 3) * 16];
}
struct EpiGU {
    static constexpr bool PERM = true, AFTER_DRAIN = false; static constexpr int MID_T = 0, SEC_ID = 8;
    bf16_t* H; const PG8_LAS float* rtab;
    __device__ __forceinline__ void operator()(const f32x4 (&acc)[2][2][4][2], const Unit& u, int wr, int wc, int fr, int fq) const {
        int row0 = u.pm * BM + wr * 64 + fr; asm volatile("" : "+v"(row0)); const int col0 = u.pn * 128 + wc * 32 + 8 * fq;
        float rs[8]; rows_rstd(rs, rtab, wr * 64 + fr);
#pragma unroll
        for (int ai = 0; ai < 2; ++ai)
#pragma unroll
            for (int m = 0; m < 4; ++m) { const int row = row0 + ai * HALF + m * 16; const float r = rs[ai * 4 + m];
                f32x4 o[2];
#pragma unroll
                for (int n = 0; n < 2; ++n) { const f32x4 g = acc[ai][0][m][n] * r, up = acc[ai][1][m][n] * r;
#pragma unroll
                    for (int e = 0; e < 4; ++e) o[n][e] = silu_f(g[e]) * up[e]; }
                *(u32x4*)(H + (size_t)row * 2816 + col0) = pack8(o[0], o[1]); }
    }
};
struct EpiRes {
    static constexpr bool PERM = true, AFTER_DRAIN = false; static constexpr int MID_T = 0, SEC_ID = 10;
    const float* Xin; float* X; bf16_t* XB; float* stats; float scale;
    __device__ __forceinline__ void operator()(const f32x4 (&acc)[2][2][4][2], const Unit& u, int wr, int wc, int fr, int fq) const {
        int row0 = u.pm * BM + wr * 64 + fr; asm volatile("" : "+v"(row0)); const int col0 = u.pn * BM + wc * 32 + 8 * fq;
        f32x4 xa[2][2][2];
#define EPI_LDX(buf, it) do { const float* xp_ = Xin + (size_t)(row0 + ((it) >> 2) * HALF + ((it) & 3) * 16) * 1024 + col0; \
            xa[buf][0][0] = *(const f32x4*)xp_; xa[buf][0][1] = *(const f32x4*)(xp_ + 4); xa[buf][1][0] = *(const f32x4*)(xp_ + HALF); xa[buf][1][1] = *(const f32x4*)(xp_ + HALF + 4); } while (0)
        EPI_LDX(0, 0);
#pragma unroll
        for (int it = 0; it < 8; ++it) { const int ai = it >> 2, m = it & 3, row = row0 + ai * HALF + m * 16, cb = it & 1;
            if (it < 7) EPI_LDX(cb ^ 1, it + 1);
            asm volatile("" ::: "memory");
            float ss = 0.f;
#pragma unroll
            for (int bj = 0; bj < 2; ++bj) { float* xp = X + (size_t)row * 1024 + col0 + bj * HALF;
                const f32x4 v0 = xa[cb][bj][0] + acc[ai][bj][m][0] * scale, v1 = xa[cb][bj][1] + acc[ai][bj][m][1] * scale;
                *(f32x4*)xp = v0; *(f32x4*)(xp + 4) = v1;
                *(u32x4*)(XB + (size_t)row * 1024 + col0 + bj * HALF) = pack8(v0, v1);
                ss += ((v0[0] * v0[0] + v0[1] * v0[1]) + (v0[2] * v0[2] + v0[3] * v0[3])) + ((v1[0] * v1[0] + v1[1] * v1[1]) + (v1[2] * v1[2] + v1[3] * v1[3])); }
            ss += __shfl_xor(ss, 16); ss += __shfl_xor(ss, 32);
            if (fq == 0) stats[(size_t)row * 16 + u.pn * 4 + wc] = ss; }
#undef EPI_LDX
    }
};
constexpr size_t EPI_MiB = 1u << 20, EPI_ROPEC = 1 * EPI_MiB, EPI_ROPES = 2 * EPI_MiB, EPI_STATS = 3 * EPI_MiB, EPI_GLR = 4 * EPI_MiB, EPI_ZH = 140 * EPI_MiB;
constexpr size_t EPI_QA = EPI_ZH, EPI_KA = EPI_ZH + 16 * EPI_MiB, EPI_VA = EPI_ZH + 20 * EPI_MiB, EPI_QB = EPI_ZH + 24 * EPI_MiB, EPI_KB = EPI_ZH + 40 * EPI_MiB, EPI_VB = EPI_ZH + 56 * EPI_MiB, EPI_RB = EPI_ZH + 88 * EPI_MiB, EPI_GA = EPI_ZH + 120 * EPI_MiB, EPI_GB = EPI_ZH + 152 * EPI_MiB;
struct EpiIn {
    static constexpr bool PERM = true, AFTER_DRAIN = false; static constexpr int MID_T = 0, SEC_ID = 9;
    unsigned char* ws; const float* qgain; const float* kgain; const PG8_LAS float* rtab;
    template <int ACT> __device__ __forceinline__ void plain(const f32x4 (&acc)[2][2][4][2], const Unit& u, int wr, int wc, int fr, int fq, bf16_t* dst, int pitch, int colt, float sc) const {
        int row0 = u.pm * BM + wr * 64 + fr; asm volatile("" : "+v"(row0)); const int col0 = colt + wc * 32 + 8 * fq;
        float rs[8]; rows_rstd(rs, rtab, wr * 64 + fr);
#pragma unroll
        for (int ai = 0; ai < 2; ++ai)
#pragma unroll
            for (int m = 0; m < 4; ++m) { const int row = row0 + ai * HALF + m * 16; const float r = rs[ai * 4 + m] * sc;
#pragma unroll
                for (int bj = 0; bj < 2; ++bj) { f32x4 v0 = acc[ai][bj][m][0] * r, v1 = acc[ai][bj][m][1] * r;
                    if (ACT == 1) {
#pragma unroll
                        for (int e = 0; e < 4; ++e) { v0[e] = silu_f(v0[e]); v1[e] = silu_f(v1[e]); } }
                    if (ACT == 2) {
#pragma unroll
                        for (int e = 0; e < 4; ++e) { v0[e] = sigm_f(v0[e]); v1[e] = sigm_f(v1[e]); } }
                    *(u32x4*)(dst + (size_t)row * pitch + col0 + bj * HALF) = pack8(v0, v1); } }
    }
    __device__ __forceinline__ void normrope(const f32x4 (&acc)[2][2][4][2], const Unit& u, int wr, int fr, int fq, bf16_t* dst, int pitch, int colh, const float* gain, float osc) const {
        int row0 = u.pm * BM + wr * 64 + fr; asm volatile("" : "+v"(row0));
        const float* ropec = (const float*)(ws + EPI_ROPEC); const float* ropes = (const float*)(ws + EPI_ROPES);
        float rs[8]; rows_rstd(rs, rtab, wr * 64 + fr);
        f32x4 cs[2][2][2];
#define EPI_LDR(buf, it) do { const size_t t_ = (size_t)((row0 + ((it) >> 2) * HALF + ((it) & 3) * 16) & (SEQ - 1)) * 32 + 8 * fq; \
            cs[buf][0][0] = *(const f32x4*)(ropec + t_); cs[buf][0][1] = *(const f32x4*)(ropes + t_); cs[buf][1][0] = *(const f32x4*)(ropec + t_ + 4); cs[buf][1][1] = *(const f32x4*)(ropes + t_ + 4); } while (0)
#pragma unroll
        for (int it = 0; it < 8; ++it) { const int ai = it >> 2, m = it & 3, row = row0 + ai * HALF + m * 16, cb = it & 1;
            EPI_LDR(cb, it);
            const float r = rs[it]; float ss = 0.f;
            f32x4 g1[2], g2[2];
#pragma unroll
            for (int n = 0; n < 2; ++n) { g1[n] = *(const f32x4*)(gain + 8 * fq + 4 * n); g2[n] = *(const f32x4*)(gain + 32 + 8 * fq + 4 * n); }
#pragma unroll
            for (int bj = 0; bj < 2; ++bj)
#pragma unroll
                for (int n = 0; n < 2; ++n) { const f32x4 q = acc[ai][bj][m][n]; ss += (q[0] * q[0] + q[1] * q[1]) + (q[2] * q[2] + q[3] * q[3]); }
            ss += __shfl_xor(ss, 16); ss += __shfl_xor(ss, 32);
            const float sc2 = osc * r * __builtin_amdgcn_rsqf(ss * (r * r) * (1.0f / 64.0f) + 1e-6f);
            f32x4 o1[2], o2[2];
#pragma unroll
            for (int n = 0; n < 2; ++n) { const f32x4 c = cs[cb][n][0], sn = cs[cb][n][1];
                const f32x4 x1 = acc[ai][0][m][n] * sc2 * g1[n], x2 = acc[ai][1][m][n] * sc2 * g2[n];
                o1[n] = x1 * c - x2 * sn; o2[n] = x2 * c + x1 * sn; }
            bf16_t* p = dst + (size_t)row * pitch + colh + 8 * fq;
            *(u32x4*)p = pack8(o1[0], o1[1]); *(u32x4*)(p + 32) = pack8(o2[0], o2[1]); }
#undef EPI_LDR
    }
    __device__ __forceinline__ void operator()(const f32x4 (&acc)[2][2][4][2], const Unit& u, int wr, int wc, int fr, int fq) const {
        const int pn = u.pn;
        if (pn < 2) { normrope(acc, u, wr, fr, fq, (bf16_t*)(ws + EPI_QA), 512, (4 * pn + wc) * 64, qgain, 0.125f * 1.4426950408889634f); }
        else if (pn == 2) {
            if (wc < 2) normrope(acc, u, wr, fr, fq, (bf16_t*)(ws + EPI_KA), 128, wc * 64, kgain, 1.0f);
            else {
                int row0 = u.pm * BM + wr * 64 + fr; asm volatile("" : "+v"(row0));
                float rs[8]; rows_rstd(rs, rtab, wr * 64 + fr);
#pragma unroll
                for (int ai = 0; ai < 2; ++ai)
#pragma unroll
                    for (int m = 0; m < 4; ++m) { const int row = row0 + ai * HALF + m * 16; const float r = rs[ai * 4 + m];
#pragma unroll
                        for (int bj = 0; bj < 2; ++bj) *(u32x4*)((bf16_t*)(ws + EPI_VA) + (size_t)row * 128 + (wc - 2) * 64 + bj * 32 + 8 * fq) = pack8(acc[ai][bj][m][0] * r, acc[ai][bj][m][1] * r); } }
        }
        else if (pn < 5)  plain<0>(acc, u, wr, wc, fr, fq, (bf16_t*)(ws + EPI_QB), 512, (pn - 3) * 256, 0.08838834764831845f);
        else if (pn < 7)  plain<0>(acc, u, wr, wc, fr, fq, (bf16_t*)(ws + EPI_KB), 512, (pn - 5) * 256, 1.0f);
        else if (pn < 11) plain<0>(acc, u, wr, wc, fr, fq, (bf16_t*)(ws + EPI_VB), 1024, (pn - 7) * 256, 1.0f);
        else if (pn < 15) plain<1>(acc, u, wr, wc, fr, fq, (bf16_t*)(ws + EPI_RB), 1024, (pn - 11) * 256, 1.0f);
        else if (pn < 19) plain<2>(acc, u, wr, wc, fr, fq, (bf16_t*)(ws + EPI_GA), 1024, (pn - 15) * 256, 1.0f);
        else if (pn < 23) plain<2>(acc, u, wr, wc, fr, fq, (bf16_t*)(ws + EPI_GB), 1024, (pn - 19) * 256, 1.0f);
        else { if (wc == 0 && fq < 2) { int row0 = u.pm * BM + wr * 64 + fr; asm volatile("" : "+v"(row0)); float rs[8]; rows_rstd(rs, rtab, wr * 64 + fr);
#pragma unroll
                for (int ai = 0; ai < 2; ++ai)
#pragma unroll
                    for (int m = 0; m < 4; ++m) { const int row = row0 + ai * HALF + m * 16; const float r = rs[ai * 4 + m];
                        float* p = (float*)(ws + EPI_GLR) + (size_t)row * 16 + 8 * fq; *(f32x4*)p = acc[ai][0][m][0] * r; *(f32x4*)(p + 4) = acc[ai][0][m][1] * r; } } }
    }
};
struct EpiPF {
    static constexpr bool PERM = true, AFTER_DRAIN = false; static constexpr int MID_T = 8, SEC_ID = 0;
    bf16_t* MG; const bf16_t* GB;
    __device__ __forceinline__ void mid(f32x4 (&acc)[2][2][4][2], const Unit& u, int wr, int wc, int fr, int fq) const {
        int row0 = u.pm * BM + wr * 64 + fr; asm volatile("" : "+v"(row0)); const int col0 = u.pn * BM + wc * 32 + 8 * fq;
        u32x4 ab[2][2], gb[2][2];
#define EPI_LDG(buf, it) do { const size_t o_ = (size_t)(row0 + ((it) >> 2) * HALF + ((it) & 3) * 16) * 1024 + col0; ab[buf][0] = *(const u32x4*)(MG + o_); ab[buf][1] = *(const u32x4*)(MG + o_ + HALF); \
            gb[buf][0] = *(const u32x4*)(GB + o_); gb[buf][1] = *(const u32x4*)(GB + o_ + HALF); } while (0)
        EPI_LDG(0, 0);
#pragma unroll
        for (int it = 0; it < 8; ++it) { const int ai = it >> 2, m = it & 3, cb = it & 1;
            if (it < 7) EPI_LDG(cb ^ 1, it + 1);
            asm volatile("" ::: "memory");
#pragma unroll
            for (int bj = 0; bj < 2; ++bj) { const u32x4 a = ab[cb][bj], g = gb[cb][bj];
                const f32x4 a0 = {bf_lo(a.x), bf_hi(a.x), bf_lo(a.y), bf_hi(a.y)}, a1 = {bf_lo(a.z), bf_hi(a.z), bf_lo(a.w), bf_hi(a.w)};
                f32x4 g0 = {bf_lo(g.x), bf_hi(g.x), bf_lo(g.y), bf_hi(g.y)}, g1 = {bf_lo(g.z), bf_hi(g.z), bf_lo(g.w), bf_hi(g.w)};
#pragma unroll
                for (int e = 0; e < 4; ++e) { g0[e] = __builtin_amdgcn_rcpf(g0[e]); g1[e] = __builtin_amdgcn_rcpf(g1[e]); }
                acc[ai][bj][m][0] = acc[ai][bj][m][0] * (a0 * g0); acc[ai][bj][m][1] = acc[ai][bj][m][1] * (a1 * g1); } }
#undef EPI_LDG
    }
    __device__ __forceinline__ void operator()(const f32x4 (&acc)[2][2][4][2], const Unit& u, int wr, int wc, int fr, int fq) const {
        int row0 = u.pm * BM + wr * 64 + fr; asm volatile("" : "+v"(row0)); const int col0 = u.pn * BM + wc * 32 + 8 * fq;
        u32x4 gb[2][2];
#define EPI_LDG(buf, it) do { const bf16_t* p_ = GB + (size_t)(row0 + ((it) >> 2) * HALF + ((it) & 3) * 16) * 1024 + col0; gb[buf][0] = *(const u32x4*)p_; gb[buf][1] = *(const u32x4*)(p_ + HALF); } while (0)
        EPI_LDG(0, 0);
#pragma unroll
        for (int it = 0; it < 8; ++it) { const int ai = it >> 2, m = it & 3, row = row0 + ai * HALF + m * 16, cb = it & 1;
            if (it < 7) EPI_LDG(cb ^ 1, it + 1);
            asm volatile("" ::: "memory");
#pragma unroll
            for (int bj = 0; bj < 2; ++bj) { const u32x4 g = gb[cb][bj];
                const f32x4 g0 = {bf_lo(g.x), bf_hi(g.x), bf_lo(g.y), bf_hi(g.y)}, g1 = {bf_lo(g.z), bf_hi(g.z), bf_lo(g.w), bf_hi(g.w)};
                *(u32x4*)(MG + (size_t)row * 1024 + col0 + bj * HALF) = pack8(acc[ai][bj][m][0] * g0, acc[ai][bj][m][1] * g1); } }
#undef EPI_LDG
    }
};

template <class Epi, class Sched, bool ALIGN_EPI = false, bool SP2 = false>
__device__ __forceinline__ void gemm_phase(PG8_LAS unsigned char* lds, const Gemm g, const Sched& S, const Epi& E) {
    int tid_l = threadIdx.x; asm volatile("" : "+v"(tid_l));
    const int tid = tid_l, wid = __builtin_amdgcn_readfirstlane(tid >> 6), lane = tid & 63, wr = wid >> 2, wc = wid & 3, fr = lane & 15, fq = lane >> 4;
    const int K = g.K, nt = K / BK;
    unsigned voffA[2], voffB[2];
#pragma unroll
    for (int i = 0; i < 2; ++i) { int R, C; stage_rc(tid * 16 + i * 8192, R, C); const int Rb = Epi::PERM ? ((R & ~31) + perm32(R & 31)) : R;
        voffA[i] = (unsigned)(R * K + C) * 2u; voffB[i] = (unsigned)(Rb * K + C) * 2u; }
    const size_t kstep = (size_t)(BK * 2);
    const size_t hstep = (size_t)HALF * K * 2;
    const size_t tstep = 2 * hstep;
    const unsigned ldsw = (unsigned)wid * 1024u;
    const int aoff = lds_byte(wr * 64 + fr, fq * 8), boff = lds_byte(wc * 32 + fr, fq * 8);
#define PG8_SA(b, h) (((b) * 2 + (h)) * HTB)
#define PG8_SB(b, h) ((4 + (b) * 2 + (h)) * HTB)
#define PG8_STAGE(bufoff, gbase, voff) do { _Pragma("unroll") for (int _i = 0; _i < 2; ++_i) \
        __builtin_amdgcn_global_load_lds((const unsigned*)((const char*)(gbase) + (voff)[_i]), (PG8_LAS unsigned*)(lds + (bufoff) + ldsw + _i * 8192), 16, 0, 0); } while (0)
#define PG8_LDA(dst, b, h) do { _Pragma("unroll") for (int m = 0; m < 4; ++m) _Pragma("unroll") for (int k = 0; k < 2; ++k) dst[m][k] = *(const PG8_LAS bf16x8*)(lds + PG8_SA(b, h) + aoff + m * 2048 + k * 1024); } while (0)
#define PG8_LDB(dst, b, h) do { _Pragma("unroll") for (int n = 0; n < 2; ++n) _Pragma("unroll") for (int k = 0; k < 2; ++k) dst[n][k] = *(const PG8_LAS bf16x8*)(lds + PG8_SB(b, h) + boff + n * 2048 + k * 1024); } while (0)
#define PG8_MMA(ai, bj, At, Bt) do { __builtin_amdgcn_s_setprio(1); _Pragma("unroll") for (int m = 0; m < 4; ++m) _Pragma("unroll") for (int n = 0; n < 2; ++n) _Pragma("unroll") for (int k = 0; k < 2; ++k) \
        acc[ai][bj][m][n] = __builtin_amdgcn_mfma_f32_16x16x32_bf16(Bt[n][k], At[m][k], acc[ai][bj][m][n], 0, 0, 0); __builtin_amdgcn_s_setprio(0); } while (0)
#define PG8_WAIT_V(n) asm volatile("s_waitcnt vmcnt(" #n ")" ::: "memory")
#define PG8_WAIT_L(n) asm volatile("s_waitcnt lgkmcnt(" #n ")" ::: "memory")
#define PG8_BAR __builtin_amdgcn_s_barrier()
#define PG8_SCHED __builtin_amdgcn_sched_barrier(0)
    Unit cur, nxt; int ui = 0;
    if (!S.next(0, cur)) return;
    f32x4 acc[2][2][4][2];
#pragma unroll
    for (int a = 0; a < 2; ++a)
#pragma unroll
        for (int b = 0; b < 2; ++b)
#pragma unroll
            for (int m = 0; m < 4; ++m)
#pragma unroll
                for (int n = 0; n < 2; ++n) acc[a][b][m][n] = (f32x4){0.f, 0.f, 0.f, 0.f};
    bf16x8 At[4][2], B0[2][2], B1[2][2];
    const char* cA = (const char*)g.A + (size_t)cur.pm * tstep; const char* cB = (const char*)g.Bt + (size_t)cur.pn * tstep;
    S.a_ready(cur);
    if constexpr (SP2) {
        PG8_STAGE(PG8_SB(0, 0), cB, voffB); PG8_STAGE(PG8_SB(0, 1), cB + hstep, voffB); PG8_STAGE(PG8_SA(0, 0), cA, voffA); PG8_STAGE(PG8_SA(0, 1), cA + hstep, voffA);
        if (wr == 1) PG8_BAR;
        PG8_WAIT_V(2); PG8_BAR;
        PG8_STAGE(PG8_SB(1, 0), cB + kstep, voffB); PG8_STAGE(PG8_SA(1, 0), cA + kstep, voffA); PG8_STAGE(PG8_SB(1, 1), cB + hstep + kstep, voffB);
        PG8_WAIT_V(6); PG8_BAR;
    } else {
        PG8_STAGE(PG8_SB(0, 0), cB, voffB); PG8_STAGE(PG8_SA(0, 0), cA, voffA); PG8_STAGE(PG8_SB(0, 1), cB + hstep, voffB); PG8_STAGE(PG8_SA(0, 1), cA + hstep, voffA);
        if (wr == 1) PG8_BAR;
        PG8_WAIT_V(4); PG8_BAR;
        PG8_STAGE(PG8_SB(1, 0), cB + kstep, voffB); PG8_STAGE(PG8_SA(1, 0), cA + kstep, voffA); PG8_STAGE(PG8_SB(1, 1), cB + hstep + kstep, voffB);
        PG8_WAIT_V(6); PG8_BAR;
    }
    for (;;) {
        const bool has_next = S.next(ui + 1, nxt);
        const char* nA = has_next ? (const char*)g.A + (size_t)nxt.pm * tstep : cA; const char* nB = has_next ? (const char*)g.Bt + (size_t)nxt.pn * tstep : cB;
        int t = 0;
        for (int kseg = 0; kseg < (Epi::MID_T > 0 ? 2 : 1); ++kseg) {
        const int t_end = (Epi::MID_T > 0 && kseg == 0) ? Epi::MID_T : nt;
        for (; t < t_end; t += 2) {
            const bool last = (t == nt - 2);
            const char* a1 = cA + (size_t)(t + 1) * kstep;
            const char* a2 = last ? nA : cA + (size_t)(t + 2) * kstep; const char* b2 = last ? nB : cB + (size_t)(t + 2) * kstep;
            const char* a3 = a2 + kstep; const char* b3 = b2 + kstep;
            if (last && has_next) S.a_ready(nxt);
            if constexpr (SP2) {
            PG8_LDB(B0, 0, 0); PG8_LDB(B1, 0, 1); PG8_SCHED; PG8_LDA(At, 0, 0); PG8_STAGE(PG8_SA(1, 1), a1 + hstep, voffA);
            PG8_WAIT_V(8); PG8_WAIT_L(0); PG8_BAR; PG8_MMA(0, 0, At, B0); PG8_MMA(0, 1, At, B1); PG8_BAR; PG8_SCHED;
            PG8_LDA(At, 0, 1); PG8_STAGE(PG8_SB(0, 0), b2, voffB); PG8_STAGE(PG8_SB(0, 1), b2 + hstep, voffB); PG8_STAGE(PG8_SA(0, 0), a2, voffA);
            PG8_WAIT_V(8); PG8_WAIT_L(0); PG8_BAR; PG8_MMA(1, 0, At, B0); PG8_MMA(1, 1, At, B1); PG8_BAR; PG8_SCHED;
            PG8_LDB(B0, 1, 0); PG8_LDB(B1, 1, 1); PG8_SCHED; PG8_LDA(At, 1, 0); PG8_STAGE(PG8_SA(0, 1), a2 + hstep, voffA);
            PG8_WAIT_V(8); PG8_WAIT_L(0); PG8_BAR; PG8_MMA(0, 0, At, B0); PG8_MMA(0, 1, At, B1); PG8_BAR; PG8_SCHED;
            PG8_LDA(At, 1, 1); PG8_STAGE(PG8_SB(1, 0), b3, voffB); PG8_STAGE(PG8_SB(1, 1), b3 + hstep, voffB); PG8_STAGE(PG8_SA(1, 0), a3, voffA);
            PG8_WAIT_V(8); PG8_WAIT_L(0); PG8_BAR; PG8_MMA(1, 0, At, B0); PG8_MMA(1, 1, At, B1); PG8_BAR; PG8_SCHED;
            } else {
            PG8_LDB(B0, 0, 0); PG8_SCHED; PG8_LDA(At, 0, 0); PG8_STAGE(PG8_SA(1, 1), a1 + hstep, voffA);
            PG8_WAIT_L(8); PG8_BAR; PG8_WAIT_L(0); PG8_MMA(0, 0, At, B0); PG8_BAR; PG8_SCHED;
            PG8_LDB(B1, 0, 1); PG8_STAGE(PG8_SB(0, 0), b2, voffB);
            PG8_BAR; PG8_WAIT_L(0); PG8_MMA(0, 1, At, B1); PG8_BAR;
            PG8_LDA(At, 0, 1); PG8_STAGE(PG8_SA(0, 0), a2, voffA);
            PG8_BAR; PG8_WAIT_L(0); PG8_MMA(1, 0, At, B0); PG8_BAR; PG8_SCHED;
            PG8_STAGE(PG8_SB(0, 1), b2 + hstep, voffB);
            PG8_WAIT_V(6); PG8_BAR; PG8_MMA(1, 1, At, B1); PG8_BAR;
            PG8_LDB(B0, 1, 0); PG8_SCHED; PG8_LDA(At, 1, 0); PG8_STAGE(PG8_SA(0, 1), a2 + hstep, voffA);
            PG8_WAIT_L(8); PG8_BAR; PG8_WAIT_L(0); PG8_MMA(0, 0, At, B0); PG8_BAR; PG8_SCHED;
            PG8_LDB(B1, 1, 1); PG8_STAGE(PG8_SB(1, 0), b3, voffB);
            PG8_BAR; PG8_WAIT_L(0); PG8_MMA(0, 1, At, B1); PG8_BAR;
            PG8_LDA(At, 1, 1); PG8_STAGE(PG8_SA(1, 0), a3, voffA);
            PG8_BAR; PG8_WAIT_L(0); PG8_MMA(1, 0, At, B0); PG8_BAR; PG8_SCHED;
            PG8_STAGE(PG8_SB(1, 1), b3 + hstep, voffB);
            PG8_WAIT_V(6); PG8_BAR; PG8_MMA(1, 1, At, B1); PG8_BAR;
            }
        }
        if constexpr (Epi::MID_T > 0) { if (kseg == 0) E.mid(acc, cur, wr, wc, fr, fq); }
        }
        if constexpr (ALIGN_EPI) { if (wr == 0) PG8_BAR; }
        if constexpr (!Epi::AFTER_DRAIN) { PG8_SEC_B(Epi::SEC_ID); E(acc, cur, wr, wc, fr, fq); PG8_SEC_E(Epi::SEC_ID); S.done(cur); }
        if (!has_next) break;
#pragma unroll
        for (int a = 0; a < 2; ++a)
#pragma unroll
            for (int b = 0; b < 2; ++b)
#pragma unroll
                for (int m = 0; m < 4; ++m)
#pragma unroll
                    for (int n = 0; n < 2; ++n) acc[a][b][m][n] = (f32x4){0.f, 0.f, 0.f, 0.f};
        cur = nxt; cA = nA; cB = nB; ++ui;
        if constexpr (ALIGN_EPI) { if (wr == 1) PG8_BAR; }
    }
    PG8_WAIT_V(0);
    if constexpr (!ALIGN_EPI) { if (wr == 0) PG8_BAR; }
    PG8_BAR;
    if constexpr (Epi::AFTER_DRAIN) { E.fused(acc, cur, wr, wc, fr, fq, lds, wid, lane); S.done(cur); }
#undef PG8_SA
#undef PG8_SB
#undef PG8_STAGE
#undef PG8_LDA
#undef PG8_LDB
#undef PG8_MMA
#undef PG8_WAIT_V
#undef PG8_WAIT_L
#undef PG8_BAR
#undef PG8_SCHED
}
}
#define GAS __attribute__((address_space(1)))
#define LAS __attribute__((address_space(3)))
typedef unsigned short bf16;
typedef unsigned v4u __attribute__((ext_vector_type(4)));
typedef float f32x4 __attribute__((ext_vector_type(4)));
typedef short bf16x8 __attribute__((ext_vector_type(8)));
typedef GAS unsigned gu32;
typedef GAS unsigned long long gu64;
#define RLX_AGENT __ATOMIC_RELAXED, __HIP_MEMORY_SCOPE_AGENT
#define LDS_WAIT() asm volatile("s_waitcnt lgkmcnt(0)" ::: "memory")
#define VM_WAIT() asm volatile("s_waitcnt vmcnt(0)" ::: "memory")
__device__ __forceinline__ unsigned long long rt() { return __builtin_amdgcn_s_memrealtime(); }
__device__ __forceinline__ unsigned f2bf(float f) { unsigned u = __builtin_bit_cast(unsigned, f); return (u + 0x7fffu + ((u >> 16) & 1u)) >> 16; }
__device__ __forceinline__ unsigned pk2(float lo, float hi) { return f2bf(lo) | (f2bf(hi) << 16); }

#define XB_TMO      128
#define XB_XCNT(j)  (256  + 64 * (j))
#define XB_XSUB(j)  (1280 + 64 * (j))
#define XB_XGEN(j)  (2304 + 64 * (j))
#define XB_TOP      3328
#define XB_TOPGEN   3392
#define XCD_BAR_WORDS 3456
#define XB_SPIN_CAP (1u << 18)

__device__ __forceinline__ unsigned xb_ld(unsigned* p)              { return __hip_atomic_load(p, __ATOMIC_RELAXED, __HIP_MEMORY_SCOPE_AGENT); }
__device__ __forceinline__ unsigned xb_add(unsigned* p, unsigned v) { return __hip_atomic_fetch_add(p, v, __ATOMIC_RELAXED, __HIP_MEMORY_SCOPE_AGENT); }
__device__ __forceinline__ unsigned xb_xcc_id() { return (unsigned)__builtin_amdgcn_s_getreg((3 << 11) | 20) & 0xFu; }
#define XB_SPIN(cond, bar) do { unsigned _sp = 0; while (cond) { __builtin_amdgcn_s_sleep(1); \
    if ((++_sp & 255u) == 0u) { if (xb_ld(&(bar)[XB_TMO])) break; if (_sp > XB_SPIN_CAP) { atomicAdd(&(bar)[XB_TMO], 1u); break; } } } } while (0)

struct XcdBarrier {
    unsigned* bar; unsigned x;
    volatile LAS unsigned* st;
};

__device__ __forceinline__ XcdBarrier xcd_barrier_post(unsigned* bar, volatile LAS unsigned* st) {
    XcdBarrier b; b.bar = bar; b.x = xb_xcc_id(); b.st = st;
    if (threadIdx.x == 0) (void)xb_add(&bar[XB_XCNT(b.x)], 1u);
    return b;
}
__device__ __forceinline__ void xcd_barrier_complete(unsigned* bar, unsigned x, unsigned& nloc, unsigned& nx) {
    const unsigned G = gridDim.x * gridDim.y * gridDim.z;
    unsigned sum, cnt, mine, sp = 0u;
    for (;;) {
        sum = 0u; cnt = 0u; mine = 0u;
#pragma unroll
        for (unsigned j = 0; j < 16; ++j) { const unsigned c = xb_ld(&bar[XB_XCNT(j)]); sum += c; cnt += (c > 0u) ? 1u : 0u; mine = (j == x) ? c : mine; }
        if (sum == G) break;
        __builtin_amdgcn_s_sleep(1);
        if ((++sp & 255u) == 0u) { if (xb_ld(&bar[XB_TMO])) break; if (sp > XB_SPIN_CAP) { atomicAdd(&bar[XB_TMO], 1u); break; } }
    }
    nloc = mine > 0u ? mine : 1u; nx = cnt > 0u ? cnt : 1u;
}

__device__ __noinline__ void xcd_barrier_fn(unsigned* bbar, unsigned bx_, volatile LAS unsigned* bst) {
    XcdBarrier b; b.bar = bbar; b.x = bx_; b.st = bst;
    asm volatile("s_waitcnt vmcnt(0)" ::: "memory");
    __syncthreads();
    if (threadIdx.x == 0) {
        unsigned* bar = b.bar;
        __builtin_amdgcn_s_waitcnt(0);
        unsigned nloc = b.st[0], nx = b.st[1];
        if (nloc == 0u) { xcd_barrier_complete(bar, b.x, nloc, nx); b.st[0] = nloc; b.st[1] = nx; }
        const unsigned old = xb_add(&bar[XB_XSUB(b.x)], 1u);
        const unsigned gen = old / nloc;
        if (old + 1u == (gen + 1u) * nloc) {
            __builtin_amdgcn_fence(__ATOMIC_RELEASE, "agent");
            asm volatile("s_waitcnt vmcnt(0)" ::: "memory");
            const unsigned og = xb_add(&bar[XB_TOP], 1u);
            const unsigned tg = og / nx;
            if (og + 1u == (tg + 1u) * nx) xb_add(&bar[XB_TOPGEN], 1u);
            else XB_SPIN(xb_ld(&bar[XB_TOPGEN]) == tg, bar);
            __builtin_amdgcn_fence(__ATOMIC_ACQUIRE, "agent");
            xb_add(&bar[XB_XGEN(b.x)], 1u);
            asm volatile("s_waitcnt vmcnt(0)" ::: "memory");
        } else {
            XB_SPIN(xb_ld(&bar[XB_XGEN(b.x)]) == gen, bar);
            __builtin_amdgcn_fence(__ATOMIC_ACQUIRE, "agent");
            asm volatile("s_waitcnt vmcnt(0)" ::: "memory");
        }
    }
    __syncthreads();
}

__device__ __forceinline__ void xcd_barrier(const XcdBarrier& b) { xcd_barrier_fn(b.bar, b.x, b.st); }
typedef unsigned u32x4 __attribute__((ext_vector_type(4)));

typedef short s16x4 __attribute__((ext_vector_type(4)));
typedef float f32x16 __attribute__((ext_vector_type(16)));
typedef float f32x2_t __attribute__((ext_vector_type(2)));
typedef __bf16 bf16x2_t __attribute__((ext_vector_type(2)));
typedef short v4i16_t __attribute__((ext_vector_type(4)));
typedef unsigned u32x2 __attribute__((ext_vector_type(2)));
#define MFMA32(a, b, c) __builtin_amdgcn_mfma_f32_32x32x16_bf16((a), (b), (c), 0, 0, 0)
__device__ __forceinline__ int crow(int r, int hi) { return (r & 3) + 8 * (r >> 2) + 4 * hi; }
__device__ __forceinline__ unsigned cvtpk(float lo, float hi) { f32x2_t v = {lo, hi}; bf16x2_t b = __builtin_convertvector(v, bf16x2_t); return __builtin_bit_cast(unsigned, b); }
__device__ __forceinline__ s16x4 tr_rd(LAS const unsigned char* p) { return __builtin_bit_cast(s16x4, __builtin_amdgcn_ds_read_tr16_b64_v4i16((LAS v4i16_t*)p)); }
__device__ __forceinline__ bf16x8 cat8(s16x4 lo, s16x4 hi) { return __builtin_shufflevector(lo, hi, 0, 1, 2, 3, 4, 5, 6, 7); }
__device__ __forceinline__ bf16x8 pack_step(const f32x16& x, int s) {
    u32x4 p; p.x = cvtpk(x[8 * s], x[8 * s + 1]); p.y = cvtpk(x[8 * s + 2], x[8 * s + 3]); p.z = cvtpk(x[8 * s + 4], x[8 * s + 5]); p.w = cvtpk(x[8 * s + 6], x[8 * s + 7]);
    return __builtin_bit_cast(bf16x8, p);
}
__device__ __forceinline__ bf16x8 row_frag(LAS const unsigned char* p) { const s16x4 lo = *(LAS const s16x4*)p, hi = *(LAS const s16x4*)(p + 16); return cat8(lo, hi); }

namespace swa {
constexpr int KOFF = 0, VOFF = 3 * 8192, LDS_NEED = 6 * 8192, NUNITS = BATCH * 2 * (SEQ / 64);
__device__ __forceinline__ void unit(int un, const bf16* QA, const bf16* KA, const bf16* VA, bf16* OC  , const float* sinks, LAS unsigned char* lds, int tid) {
    const int lane = tid & 63, r32 = lane & 31, hi = lane >> 5, w = __builtin_amdgcn_readfirstlane(tid >> 6);
    const int i = un & 127, hk = (un >> 7) & 1, b = un >> 8;
    const size_t rowb = (size_t)b * SEQ;
#pragma unroll
    for (int jt = 0; jt < 3; ++jt) {
        const int ti = i - 2 + jt; u32x4 kv = {0u, 0u, 0u, 0u}, vv = {0u, 0u, 0u, 0u};
        if (ti >= 0) {
            kv = *(const u32x4*)(KA + (rowb + ti * 64 + (tid & 63)) * 128 + hk * 64 + (tid >> 6) * 8);
            vv = *(const u32x4*)(VA + (rowb + ti * 64 + 16 * (w & 3) + (lane >> 2)) * 128 + hk * 64 + (w >> 2) * 32 + (lane & 3) * 8);
        }
        *(LAS u32x4*)(lds + KOFF + jt * 8192 + (tid >> 6) * 1024 + (tid & 63) * 16) = kv;
        *(LAS u32x4*)(lds + VOFF + jt * 8192 + tid * 16) = vv;
    }
    const int hq = 4 * hk + (w >> 1), qh = w & 1;
    const bf16* qp = QA + (rowb + 64 * i + 32 * qh + r32) * 512 + hq * 64 + hi * 8;
    bf16x8 qr[4];
#pragma unroll
    for (int d0 = 0; d0 < 4; ++d0) qr[d0] = *(const bf16x8*)(qp + d0 * 16);
    const float sink2 = sinks[hq] * LOG2E;
    __syncthreads();
    f32x16 p[5];
    const int tq = 64 * i + 32 * qh + r32;
    float mx = -INFINITY;
#pragma unroll
    for (int j = 0; j < 5; ++j) {
        const int st = qh + j, jt = st >> 1, kh = st & 1;
        f32x16 a = {};
#pragma unroll
        for (int d0 = 0; d0 < 4; ++d0) { const bf16x8 kf = *(LAS const bf16x8*)(lds + KOFF + jt * 8192 + (2 * d0 + hi) * 1024 + (32 * kh + r32) * 16); a = MFMA32(kf, qr[d0], a); }
        const int tk0 = 64 * (i - 2) + 32 * st;
#pragma unroll
        for (int r = 0; r < 16; ++r) { const int tk = tk0 + crow(r, hi); const bool ok = (tk >= 0) && (tk <= tq) && (tq - tk < 128); a[r] = ok ? a[r] : -INFINITY; mx = fmaxf(mx, a[r]); }
        p[j] = a;
    }
    mx = fmaxf(mx, __shfl_xor(mx, 32));
    const float mm = fmaxf(mx, sink2);
    float sum = 0.f;
#pragma unroll
    for (int j = 0; j < 5; ++j)
#pragma unroll
        for (int r = 0; r < 16; ++r) { const float e = __builtin_amdgcn_exp2f(p[j][r] - mm); p[j][r] = e; sum += e; }
    sum += __shfl_xor(sum, 32);
    const float inv = 1.0f / (sum + __builtin_amdgcn_exp2f(sink2 - mm));
    f32x16 o[2] = {{}, {}};
    LAS const unsigned char* vb = lds + VOFF + ((lane >> 4) & 1) * 32 + (lane & 3) * 8 + (4 * hi + ((lane & 15) >> 2)) * 64;
#pragma unroll
    for (int j = 0; j < 5; ++j) {
        const int st = qh + j, jt = st >> 1, kh = st & 1;
#pragma unroll
        for (int s = 0; s < 2; ++s) { const bf16x8 pf = pack_step(p[j], s); const int ks = 2 * kh + s;
#pragma unroll
            for (int d0 = 0; d0 < 2; ++d0) { LAS const unsigned char* vp = vb + jt * 8192 + d0 * 4096 + ks * 1024; const bf16x8 vf = cat8(tr_rd(vp), tr_rd(vp + 512)); o[d0] = MFMA32(vf, pf, o[d0]); } }
    }
    bf16* op = OC + (rowb + 64 * i + 32 * qh + r32) * 1536 + hq * 64 + 4 * hi;
#pragma unroll
    for (int d0 = 0; d0 < 2; ++d0)
#pragma unroll
        for (int g = 0; g < 4; ++g) { u32x2 wv; wv.x = cvtpk(o[d0][4 * g] * inv, o[d0][4 * g + 1] * inv); wv.y = cvtpk(o[d0][4 * g + 2] * inv, o[d0][4 * g + 3] * inv); *(u32x2*)(op + 32 * d0 + 8 * g) = wv; }
    __syncthreads();
}
}

#ifndef G3SEC
#define G3SEC 0
#endif
__device__ __noinline__ void probe_fn(int mode);
#define SEC_B(k) do { if (G3SEC == (k) && blockIdx.x == 0) probe_fn(0); } while (0)
#define SEC_E(k) do { if (G3SEC == (k) && blockIdx.x == 0) probe_fn(1); } while (0)
namespace gla {
constexpr int PQ = 264, PK3 = 320, PV = 576, PA = 136;
constexpr int O_Q1 = 0, O_Q2 = 16896, O_K2 = 33792, O_K3 = 50688, O_V = 71168, O_A = 108032, O_GLR = 116736, O_TOT = 120832, O_DV = 124928, O_PART = 125440, LDS_NEED = 127488;
constexpr int O_WG = 131072 + 2048;
constexpr int NSEG = 32, CPS = 4, NUNITS = 8 * NSEG, SELEMS = 128 * 256, SPAIRS = SELEMS / 2;
__device__ __forceinline__ unsigned short f2bf(float f) { unsigned u = __builtin_bit_cast(unsigned, f); return (unsigned short)((u + 0x7fffu + ((u >> 16) & 1u)) >> 16); }
__device__ __forceinline__ float bf2f(unsigned short h) { return __builtin_bit_cast(float, (unsigned)h << 16); }
__device__ __forceinline__ float logsig(float x) { return fminf(x, 0.f) - __logf(1.f + __expf(-fabsf(x))); }

struct KgRegs { u32x4 q[2], k[2]; f32x4 g; };
struct VRegs { u32x4 v[4]; };
template <bool FULL> __device__ __forceinline__ void fetch_kg(KgRegs& R, const bf16* QB, const bf16* KB, const float* GLR, size_t r0, int h, int tid) {
#pragma unroll
    for (int i = 0; i < 2; ++i) { const int p = tid + 512 * i, row = p >> 4, c = p & 15;
        R.k[i] = *(const u32x4*)(KB + (r0 + row) * 512 + h * 128 + c * 8);
        if (FULL) R.q[i] = *(const u32x4*)(QB + (r0 + row) * 512 + h * 128 + c * 8); }
    R.g = (f32x4){0.f, 0.f, 0.f, 0.f};
    if (tid < 256) R.g = *(const f32x4*)(GLR + r0 * 16 + tid * 4);
}
__device__ __forceinline__ void fetch_v(VRegs& R, const bf16* VB, size_t r0, int h, int tid) {
#pragma unroll
    for (int i = 0; i < 4; ++i) { const int p = tid + 512 * i, row = p >> 5, c = p & 31; R.v[i] = *(const u32x4*)(VB + (r0 + row) * 1024 + h * 256 + c * 8); }
}
template <bool FULL> __device__ __forceinline__ void put_kg(const KgRegs& R, LAS unsigned char* lds, int tid) {
#pragma unroll
    for (int i = 0; i < 2; ++i) { const int p = tid + 512 * i, row = p >> 4, c = p & 15;
        LAS u32x2* kd = (LAS u32x2*)(lds + O_K2 + row * PQ + c * 16); kd[0] = (u32x2){R.k[i].x, R.k[i].y}; kd[1] = (u32x2){R.k[i].z, R.k[i].w};
        if (FULL) { LAS u32x2* qd = (LAS u32x2*)(lds + O_Q1 + row * PQ + c * 16); qd[0] = (u32x2){R.q[i].x, R.q[i].y}; qd[1] = (u32x2){R.q[i].z, R.q[i].w}; } }
    if (tid < 256) *(LAS f32x4*)(lds + O_GLR + tid * 16) = R.g;
}
__device__ __forceinline__ void put_v(const VRegs& R, LAS unsigned char* lds, int tid) {
#pragma unroll
    for (int i = 0; i < 4; ++i) { const int p = tid + 512 * i, row = p >> 5, c = p & 31; *(LAS u32x4*)(lds + O_V + row * PV + c * 16) = R.v[i]; }
}
__device__ __forceinline__ void load_wg(const float* wgate, const float* gbias, int h, LAS unsigned char* lds, int tid) {
    LAS float* W = (LAS float*)(lds + O_WG);
#pragma unroll
    for (int i = 0; i < 4; ++i) { const int e = tid + 512 * i, j = e >> 7, c = e & 127; W[e] = wgate[j * 512 + h * 128 + c]; }
    if (tid < 128) W[2048 + tid] = gbias[h * 128 + tid];
}
template <bool FULL> __device__ __forceinline__ void prep(LAS unsigned char* lds, int tid, float& blast0, float& blast1, unsigned* e1out = nullptr, float* ccout = nullptr) {
    const int cp = tid & 63, w = tid >> 6;
    __syncthreads();
    LAS const float* W = (LAS const float*)(lds + O_WG);
    float wa[16], wb[16];
#pragma unroll
    for (int j = 0; j < 16; ++j) { const f32x2_t t = *(LAS const f32x2_t*)(W + j * 128 + 2 * cp); wa[j] = t.x; wb[j] = t.y; }
    const f32x2_t bias = *(LAS const f32x2_t*)(W + 2048 + 2 * cp);
    float bl0[8], bl1[8]; float run0 = 0.f, run1 = 0.f;
#pragma unroll
    for (int i = 0; i < 8; ++i) { LAS const f32x4* g = (LAS const f32x4*)(lds + O_GLR + (8 * w + i) * 64); const f32x4 g0 = g[0], g1 = g[1], g2 = g[2], g3 = g[3];
        float x0 = bias.x, x1 = bias.y;
#pragma unroll
        for (int j = 0; j < 4; ++j) { x0 += g0[j] * wa[j]; x1 += g0[j] * wb[j]; }
#pragma unroll
        for (int j = 0; j < 4; ++j) { x0 += g1[j] * wa[4 + j]; x1 += g1[j] * wb[4 + j]; }
#pragma unroll
        for (int j = 0; j < 4; ++j) { x0 += g2[j] * wa[8 + j]; x1 += g2[j] * wb[8 + j]; }
#pragma unroll
        for (int j = 0; j < 4; ++j) { x0 += g3[j] * wa[12 + j]; x1 += g3[j] * wb[12 + j]; }
        run0 += logsig(x0) * 0.0625f; run1 += logsig(x1) * 0.0625f; bl0[i] = run0; bl1[i] = run1; }
    LAS f32x2_t* TOT = (LAS f32x2_t*)(lds + O_TOT);
    TOT[w * 64 + cp] = (f32x2_t){run0, run1};
    __syncthreads();
    float pre0 = 0.f, pre1 = 0.f, rr0 = 0.f, rr1 = 0.f, bt0 = 0.f, bt1 = 0.f;
#pragma unroll
    for (int g = 0; g < 8; ++g) { const f32x2_t t = TOT[g * 64 + cp]; if (g < w) { pre0 += t.x; pre1 += t.y; } if (g < 4) { rr0 += t.x; rr1 += t.y; } bt0 += t.x; bt1 += t.y; }
    const float c40 = __expf(bt0), c41 = __expf(bt1), c20 = __expf(-rr0), c21 = __expf(-rr1), c30 = __expf(rr0), c31 = __expf(rr1);
    if (!FULL && ccout && w == 0) { *(f32x4*)(ccout + cp * 8) = (f32x4){c20, c21, c30, c31}; *(f32x4*)(ccout + cp * 8 + 4) = (f32x4){c40, c41, 0.f, 0.f}; }
#pragma unroll
    for (int i = 0; i < 8; ++i) { const int t = 8 * w + i; const float e10 = __expf(pre0 + bl0[i]), e11 = __expf(pre1 + bl1[i]); const float i10 = __builtin_amdgcn_rcpf(e10), i11 = __builtin_amdgcn_rcpf(e11);
        if (!FULL && e1out) e1out[t * 64 + cp] = cvtpk(e10, e11);
        const unsigned kk = *(LAS const unsigned*)(lds + O_K2 + t * PQ + cp * 4); const float k0 = __builtin_bit_cast(float, kk << 16), k1 = __builtin_bit_cast(float, kk & 0xffff0000u);
        *(LAS unsigned*)(lds + O_K3 + t * PK3 + cp * 4) = cvtpk(k0 * (i10 * c40), k1 * (i11 * c41));
        if (FULL) { const unsigned qq = *(LAS const unsigned*)(lds + O_Q1 + t * PQ + cp * 4); const float q0 = __builtin_bit_cast(float, qq << 16), q1 = __builtin_bit_cast(float, qq & 0xffff0000u);
            *(LAS unsigned*)(lds + O_Q1 + t * PQ + cp * 4) = cvtpk(q0 * e10, q1 * e11);
            *(LAS unsigned*)(lds + O_Q2 + t * PQ + cp * 4) = cvtpk(q0 * (e10 * c20), q1 * (e11 * c21));
            *(LAS unsigned*)(lds + O_K2 + t * PQ + cp * 4) = cvtpk(k0 * (i10 * c30), k1 * (i11 * c31)); } }
    if (w == 7) *(LAS f32x2_t*)(lds + O_DV + cp * 8) = (f32x2_t){c40, c41};
    blast0 = bt0; blast1 = bt1;
}
__device__ __forceinline__ void prep_lite(LAS unsigned char* lds, int tid, const unsigned (&e1w)[8], const f32x4 ca, const f32x4 cb) {
    const int cp = tid & 63, w = tid >> 6;
    __syncthreads();
    const float c20 = ca[0], c21 = ca[1], c30 = ca[2], c31 = ca[3], c40 = cb[0], c41 = cb[1];
#pragma unroll
    for (int i = 0; i < 8; ++i) { const int t = 8 * w + i; const float e10 = __builtin_bit_cast(float, e1w[i] << 16), e11 = __builtin_bit_cast(float, e1w[i] & 0xffff0000u); const float i10 = __builtin_amdgcn_rcpf(e10), i11 = __builtin_amdgcn_rcpf(e11);
        const unsigned kk = *(LAS const unsigned*)(lds + O_K2 + t * PQ + cp * 4); const float k0 = __builtin_bit_cast(float, kk << 16), k1 = __builtin_bit_cast(float, kk & 0xffff0000u);
        const unsigned qq = *(LAS const unsigned*)(lds + O_Q1 + t * PQ + cp * 4); const float q0 = __builtin_bit_cast(float, qq << 16), q1 = __builtin_bit_cast(float, qq & 0xffff0000u);
        *(LAS unsigned*)(lds + O_K3 + t * PK3 + cp * 4) = cvtpk(k0 * (i10 * c40), k1 * (i11 * c41));
        *(LAS unsigned*)(lds + O_Q1 + t * PQ + cp * 4) = cvtpk(q0 * e10, q1 * e11);
        *(LAS unsigned*)(lds + O_Q2 + t * PQ + cp * 4) = cvtpk(q0 * (e10 * c20), q1 * (e11 * c21));
        *(LAS unsigned*)(lds + O_K2 + t * PQ + cp * 4) = cvtpk(k0 * (i10 * c30), k1 * (i11 * c31)); }
    if (w == 7) *(LAS f32x2_t*)(lds + O_DV + cp * 8) = (f32x2_t){c40, c41};
}
__device__ __forceinline__ void state_update(f32x16 (&S)[4], LAS unsigned char* lds, int w, int lane) {
    const int hi = lane >> 5, i16 = lane & 15, g16 = (lane >> 4) & 1;
    LAS const float* DVp = (LAS const float*)(lds + O_DV);
#pragma unroll
    for (int tile = 0; tile < 4; ++tile) {
#pragma unroll
        for (int r = 0; r < 16; ++r) S[tile][r] *= DVp[32 * tile + crow(r, hi)];
        asm volatile("" ::: "memory"); }
    LAS const unsigned char* vb = lds + O_V + (4 * hi + (i16 >> 2)) * PV + (32 * w + 16 * g16 + 4 * (i16 & 3)) * 2;
    LAS const unsigned char* kb = lds + O_K3 + (4 * hi + (i16 >> 2)) * PK3 + (16 * g16 + 4 * (i16 & 3)) * 2;
#pragma unroll
    for (int ks = 0; ks < 4; ++ks) { const bf16x8 vf = cat8(tr_rd(vb + ks * 16 * PV), tr_rd(vb + (ks * 16 + 8) * PV));
#pragma unroll
        for (int tile = 0; tile < 4; ++tile) { const bf16x8 kf = cat8(tr_rd(kb + ks * 16 * PK3 + tile * 64), tr_rd(kb + (ks * 16 + 8) * PK3 + tile * 64)); S[tile] = MFMA32(kf, vf, S[tile]); } }
}
struct Tensors { const bf16 *QB, *KB, *VB, *RB; bf16* OB; const float *GLR, *wgate, *gbias, *onorm; float *R, *SST, *DSEG; unsigned* E1; float* CC; };

__device__ __forceinline__ void g1_unit(int un, const Tensors& T, LAS unsigned char* lds, int tid) {
    const int lane = tid & 63, w = __builtin_amdgcn_readfirstlane(tid >> 6);
    const int chain = un >> 5, seg = un & 31, b = chain >> 2, h = chain & 3;
    const size_t rb = (size_t)b * SEQ + (size_t)(seg * CPS) * 64;
    KgRegs KG; fetch_kg<false>(KG, T.QB, T.KB, T.GLR, rb, h, tid);
    load_wg(T.wgate, T.gbias, h, lds, tid);
    f32x16 S[4] = {{}, {}, {}, {}}; float bs0 = 0.f, bs1 = 0.f;
#pragma unroll 1
    for (int c = 0; c < CPS; ++c) {
        int tl = tid; asm volatile("" : "+v"(tl));
        put_kg<false>(KG, lds, tl);
        VRegs VR; fetch_v(VR, T.VB, rb + (size_t)c * 64, h, tl);
        float b0, b1; prep<false>(lds, tid, b0, b1, T.E1 + (size_t)(un * CPS + c) * 4096, T.CC + (size_t)(un * CPS + c) * 512); bs0 += b0; bs1 += b1;
        if (c + 1 < CPS) fetch_kg<false>(KG, T.QB, T.KB, T.GLR, rb + (size_t)(c + 1) * 64, h, tl);
        put_v(VR, lds, tl);
        __syncthreads();
        state_update(S, lds, w, lane);
        __syncthreads();
    }
    unsigned* Rp = (unsigned*)T.R + (size_t)un * SPAIRS + tid;
#pragma unroll
    for (int tile = 0; tile < 4; ++tile)
#pragma unroll
        for (int r = 0; r < 16; r += 2) Rp[(tile * 8 + (r >> 1)) * 512] = cvtpk(S[tile][r], S[tile][r + 1]);
    if (tid >= 448) *(f32x2_t*)(T.DSEG + un * 128 + 2 * (tid & 63)) = (f32x2_t){__expf(bs0), __expf(bs1)};
}
__device__ __forceinline__ void g2_scan(const Tensors& T, int gtid, int gthreads) {
    for (int e = gtid; e < 8 * SPAIRS; e += gthreads) {
        const int chain = e / SPAIRS, idx = e % SPAIRS, k = idx >> 9, ln = idx & 63, reg = 2 * k;
        const int dk = 32 * (reg >> 4) + crow(reg & 15, ln >> 5);
        const unsigned* Rp = (const unsigned*)T.R + (size_t)chain * NSEG * SPAIRS + idx; unsigned* Sp = (unsigned*)T.SST + (size_t)chain * NSEG * SPAIRS + idx; const float* Dp = T.DSEG + chain * NSEG * 128 + dk;
        float sa = 0.f, sb = 0.f;
#pragma unroll 1
        for (int s0 = 0; s0 < NSEG; s0 += 16) { unsigned r[16]; f32x2_t d[16];
#pragma unroll
            for (int j = 0; j < 16; ++j) { r[j] = __builtin_nontemporal_load(Rp + (size_t)(s0 + j) * SPAIRS); d[j] = *(const f32x2_t*)(Dp + (s0 + j) * 128); }
#pragma unroll
            for (int j = 0; j < 16; ++j) { Sp[(size_t)(s0 + j) * SPAIRS] = cvtpk(sa, sb);
                sa = sa * d[j].x + __builtin_bit_cast(float, r[j] << 16); sb = sb * d[j].y + __builtin_bit_cast(float, r[j] & 0xffff0000u); } }
    }
}
__device__ __forceinline__ void g3_unit(int un, const Tensors& T, LAS unsigned char* lds, int tid) {
    const int lane = tid & 63, r32 = lane & 31, hi = lane >> 5, w = __builtin_amdgcn_readfirstlane(tid >> 6), i16 = lane & 15, g16 = (lane >> 4) & 1;
    const int chain = un >> 5, seg = un & 31, b = chain >> 2, h = chain & 3;
    const size_t rb = (size_t)b * SEQ + (size_t)(seg * CPS) * 64;
    f32x16 S[4];
    { const unsigned* Sp = (const unsigned*)T.SST + (size_t)un * SPAIRS + tid;
#pragma unroll
      for (int tile = 0; tile < 4; ++tile)
#pragma unroll
          for (int r = 0; r < 16; r += 2) { const unsigned w2 = Sp[(tile * 8 + (r >> 1)) * 512]; S[tile][r] = __builtin_bit_cast(float, w2 << 16); S[tile][r + 1] = __builtin_bit_cast(float, w2 & 0xffff0000u); } }
#pragma unroll 1
    for (int c = 0; c < CPS; ++c) {
        const size_t r0 = rb + (size_t)c * 64;
        int tl = tid; asm volatile("" : "+v"(tl));
        SEC_B(1);
        { KgRegs KG; VRegs VR; fetch_kg<true>(KG, T.QB, T.KB, T.GLR, r0, h, tl); fetch_v(VR, T.VB, r0, h, tl);
          unsigned e1w[8]; const unsigned* e1p = T.E1 + (size_t)(un * CPS + c) * 4096 + (tl >> 6) * 512 + (tl & 63);
#pragma unroll
          for (int i = 0; i < 8; ++i) e1w[i] = e1p[i * 64];
          const f32x4 ca = *(const f32x4*)(T.CC + (size_t)(un * CPS + c) * 512 + (tl & 63) * 8), cb = *(const f32x4*)(T.CC + (size_t)(un * CPS + c) * 512 + (tl & 63) * 8 + 4);
          put_kg<true>(KG, lds, tl);
          prep_lite(lds, tid, e1w, ca, cb);
          put_v(VR, lds, tl); }
        __syncthreads(); SEC_E(1); SEC_B(2);
        if (w < 3) { const int tt = (w >= 1), st = (w == 2); f32x16 d = {};
            LAS const unsigned char* kp = lds + O_K2 + (32 * st + r32) * PQ + 8 * hi; LAS const unsigned char* qp = lds + O_Q2 + (32 * tt + r32) * PQ + 8 * hi;
#pragma unroll
            for (int kc = 0; kc < 8; ++kc) d = MFMA32(row_frag(kp + kc * 32), row_frag(qp + kc * 32), d);
            const int t = 32 * tt + r32;
#pragma unroll
            for (int g = 0; g < 4; ++g) { const int s0 = 32 * st + 8 * g + 4 * hi; float v[4];
#pragma unroll
                for (int e = 0; e < 4; ++e) v[e] = (s0 + e <= t) ? d[4 * g + e] : 0.f;
                *(LAS u32x2*)(lds + O_A + t * PA + s0 * 2) = (u32x2){cvtpk(v[0], v[1]), cvtpk(v[2], v[3])}; } }
        f32x16 o[2] = {{}, {}};
#pragma unroll
        for (int tile = 0; tile < 4; ++tile)
#pragma unroll
            for (int s = 0; s < 2; ++s) { const bf16x8 sf = pack_step(S[tile], s);
#pragma unroll
                for (int tt = 0; tt < 2; ++tt) o[tt] = MFMA32(sf, row_frag(lds + O_Q1 + (32 * tt + r32) * PQ + (32 * tile + 16 * s + 4 * hi) * 2), o[tt]); }
        __syncthreads();
        SEC_E(2); SEC_B(3);
        u32x2 rrv[2][4];
#pragma unroll
        for (int tt = 0; tt < 2; ++tt)
#pragma unroll
            for (int g = 0; g < 4; ++g) rrv[tt][g] = *(const u32x2*)(T.RB + (r0 + 32 * tt + r32) * 1024 + h * 256 + 32 * w + 4 * hi + 8 * g);
        LAS const unsigned char* vb = lds + O_V + (4 * hi + (i16 >> 2)) * PV + (32 * w + 16 * g16 + 4 * (i16 & 3)) * 2;
#pragma unroll
        for (int ks = 0; ks < 4; ++ks) { const bf16x8 vf = cat8(tr_rd(vb + ks * 16 * PV), tr_rd(vb + (ks * 16 + 8) * PV));
            if (ks < 2) o[0] = MFMA32(vf, row_frag(lds + O_A + r32 * PA + (16 * ks + 4 * hi) * 2), o[0]);
            o[1] = MFMA32(vf, row_frag(lds + O_A + (32 + r32) * PA + (16 * ks + 4 * hi) * 2), o[1]); }
        state_update(S, lds, w, lane);
        SEC_E(3); SEC_B(4);
        LAS float* PART = (LAS float*)(lds + O_PART);
        f32x4 gn4[4];
#pragma unroll
        for (int g = 0; g < 4; ++g) gn4[g] = *(const f32x4*)(T.onorm + h * 256 + 32 * w + 8 * g + 4 * hi);
#pragma unroll
        for (int tt = 0; tt < 2; ++tt) { float ss = 0.f;
#pragma unroll
            for (int r = 0; r < 16; ++r) ss += o[tt][r] * o[tt][r];
            ss += __shfl_xor(ss, 32); if (hi == 0) PART[w * 64 + 32 * tt + r32] = ss; }
        __syncthreads();
#pragma unroll
        for (int tt = 0; tt < 2; ++tt) { const int t = 32 * tt + r32; float tot = 0.f;
#pragma unroll
            for (int ww = 0; ww < 8; ++ww) tot += PART[ww * 64 + t];
            const float rstd = __builtin_amdgcn_rsqf(tot * (1.0f / 256.0f) + 1e-6f);
            const size_t obase = (r0 + t) * 1536 + 512 + h * 256 + 32 * w + 4 * hi;
#pragma unroll
            for (int g = 0; g < 4; ++g) { const u32x2 rr = rrv[tt][g];
                const float v0 = o[tt][4 * g] * rstd * gn4[g][0] * __builtin_bit_cast(float, rr.x << 16), v1 = o[tt][4 * g + 1] * rstd * gn4[g][1] * __builtin_bit_cast(float, rr.x & 0xffff0000u);
                const float v2 = o[tt][4 * g + 2] * rstd * gn4[g][2] * __builtin_bit_cast(float, rr.y << 16), v3 = o[tt][4 * g + 3] * rstd * gn4[g][3] * __builtin_bit_cast(float, rr.y & 0xffff0000u);
                *(u32x2*)(T.OB + obase + 8 * g) = (u32x2){cvtpk(v0, v1), cvtpk(v2, v3)}; } }
        __syncthreads();
        SEC_E(4);
    }
}
}
#define CAS __attribute__((address_space(4)))

constexpr size_t MiB = 1u << 20;
constexpr size_t WS_CTL = 0, CTL_ZERO_BYTES = 1 * MiB;
constexpr size_t WS_ROPEC = 1 * MiB, WS_ROPES = 2 * MiB;
constexpr size_t WS_STATS = 3 * MiB;
constexpr size_t WS_GLR = 4 * MiB;
constexpr size_t WS_DSEG = 5 * MiB;
constexpr size_t WS_W = 6 * MiB;
constexpr size_t WS_XB = 108 * MiB;
constexpr size_t WS_ZH = 140 * MiB;
constexpr size_t Z_QA = WS_ZH, Z_KA = WS_ZH + 16 * MiB, Z_VA = WS_ZH + 20 * MiB, Z_QB = WS_ZH + 24 * MiB, Z_KB = WS_ZH + 40 * MiB, Z_VB = WS_ZH + 56 * MiB, Z_RB = WS_ZH + 88 * MiB, Z_GA = WS_ZH + 120 * MiB, Z_GB = WS_ZH + 152 * MiB;
constexpr size_t WS_R = 324 * MiB, WS_SST = 356 * MiB;
constexpr size_t WS_E1 = WS_R + 16 * MiB, WS_CC = WS_SST + 16 * MiB;
constexpr size_t WS_OC = 388 * MiB, WS_END = 436 * MiB;
constexpr size_t WS_DBG = 436 * MiB;
constexpr int CW_BAR = 4096, CW_DBG = 16384;
constexpr int RING_BYTES = 131072, MISC_OFF = RING_BYTES + 320, RSTD_OFF = RING_BYTES + 1024, LDS_BYTES = 147456;
static_assert(pg8::EPI_ROPEC == WS_ROPEC && pg8::EPI_ROPES == WS_ROPES && pg8::EPI_STATS == WS_STATS && pg8::EPI_GLR == WS_GLR && pg8::EPI_QA == Z_QA && pg8::EPI_KA == Z_KA && pg8::EPI_VA == Z_VA && pg8::EPI_QB == Z_QB && pg8::EPI_KB == Z_KB && pg8::EPI_VB == Z_VB && pg8::EPI_RB == Z_RB && pg8::EPI_GA == Z_GA && pg8::EPI_GB == Z_GB, "w_in epilogue offsets match the workspace map");
static_assert(gla::O_WG >= RSTD_OFF + 1024 && gla::O_WG + 8704 <= LDS_BYTES, "gate-weight table above the ring");
static_assert(swa::LDS_NEED <= RING_BYTES && gla::LDS_NEED <= RING_BYTES, "phase scratch fits the ring region");

__device__ __forceinline__ void conv_item64(const float* W, int ldw, int c0a, int nva, int c0b, int nvb, const float* gain, int k0, bf16* WT, int drow0, int K, int kdst, LAS unsigned char* scr, int lane) {
    const int r = lane >> 4, c = lane & 15;
    const int col = (c < 8) ? c0a + 4 * c : c0b + 4 * (c - 8); const bool ok = (c < 8) ? (4 * c < nva) : (4 * (c - 8) < nvb);
    f32x4 v[16];
#pragma unroll
    for (int i = 0; i < 16; ++i) v[i] = ok ? __builtin_nontemporal_load((const f32x4*)(W + (size_t)(k0 + 4 * i + r) * ldw + col)) : (f32x4){0.f, 0.f, 0.f, 0.f};
    if (gain) {
#pragma unroll
        for (int i = 0; i < 16; ++i) v[i] = v[i] * gain[k0 + 4 * i + r]; }
#pragma unroll
    for (int i = 0; i < 16; ++i) *(LAS u32x2*)(scr + (4 * i + r) * 160 + c * 8) = (u32x2){cvtpk(v[i].x, v[i].y), cvtpk(v[i].z, v[i].w)};
    const int i16 = lane & 15, q = i16 >> 2, pp = i16 & 3;
#pragma unroll
    for (int nb = 0; nb < 4; ++nb)
#pragma unroll
        for (int kb = 0; kb < 4; ++kb) { const s16x4 t = tr_rd(scr + (16 * kb + 4 * r + q) * 160 + (16 * nb + 4 * pp) * 2);
            *(s16x4*)(WT + (size_t)(drow0 + 16 * nb + i16) * K + kdst + 16 * kb + 4 * r) = t; }
}
constexpr size_t W_GU1 = 0, W_D1 = 11 * MiB, W_IN = 17 * MiB, W_PA = 29 * MiB, W_PB = 30 * MiB, W_OUT = 32 * MiB, W_GU2 = 34 * MiB, W_D2 = 45 * MiB, W_SET = 51 * MiB;
constexpr int CI_GU = 16 * 88, CI_D = 44 * 16, CI_IN = 16 * 96, CI_PA = 8 * 16, CI_PB = 16 * 16, CI_OUT = 16 * 16, CI_ALL = 2 * CI_GU + 2 * CI_D + CI_IN + CI_PA + CI_PB + CI_OUT;
__device__ __forceinline__ void conv_run(const float* const CAS* in, int l, unsigned char* wset, int it_lo, int it_hi, int widx, int nworkers, LAS unsigned char* scr, int lane) {
    for (int it = it_lo + widx; it < it_hi; it += nworkers) {
        int r = it;
        if (r < 2 * CI_GU) { const int second = r >= CI_GU; r -= second * CI_GU; const int kb = r / 88, dg = 2 * (r % 88), tile = dg >> 3, bj = (dg >> 2) & 1, wc = dg & 3;
            const float* src = in[(second ? 17 : 2) + bj] + (size_t)l * DM * FF; const int c0 = 128 * tile + 32 * wc;
            conv_item64(src, FF, c0, 32, c0 + 32, 32, in[second ? 16 : 1] + (size_t)l * DM, 64 * kb, (bf16*)(wset + (second ? W_GU2 : W_GU1)), 32 * dg, DM, 64 * kb, scr, lane); continue; }
        r -= 2 * CI_GU;
        if (r < 2 * CI_D) { const int second = r >= CI_D; r -= second * CI_D; const int kb = r / 16, pr = r % 16;
            conv_item64(in[second ? 19 : 4] + (size_t)l * FF * DM, DM, 64 * pr, 32, 64 * pr + 32, 32, nullptr, 64 * kb, (bf16*)(wset + (second ? W_D2 : W_D1)), 64 * pr, FF, 64 * kb, scr, lane); continue; }
        r -= 2 * CI_D;
        if (r < CI_IN) { const int kb = r / 96, dg = 2 * (r % 96), tile = dg >> 3, bj = (dg >> 2) & 1, wc = dg & 3; int ca, cb, na = 32, nb = 32;
            if (tile < 2) { ca = 64 * (4 * tile + wc) + 32 * bj; cb = ca + 64; }
            else if (tile == 2) { ca = (wc < 2 ? 512 : 640) + 32 * bj; cb = ca + 64; }
            else if (tile < 15) { ca = 32 * dg; cb = ca + 32; }
            else if (tile < 23) { ca = 32 * dg + 16; cb = ca + 32; }
            else { ca = 3840; cb = 3840; na = (dg == 184) ? 16 : 0; nb = 0; }
            conv_item64(in[6] + (size_t)l * DM * IN_COLS, IN_COLS, ca, na, cb, nb, in[5] + (size_t)l * DM, 64 * kb, (bf16*)(wset + W_IN), 32 * dg, DM, 64 * kb, scr, lane); continue; }
        r -= CI_IN;
        if (r < CI_PA) { const int kb = r / 16, pr = r % 16; conv_item64(in[13] + (size_t)l * QAW * DM, DM, 64 * pr, 32, 64 * pr + 32, 32, nullptr, 64 * kb, (bf16*)(wset + W_PA), 64 * pr, QAW + GVW, 64 * kb, scr, lane); continue; }
        r -= CI_PA;
        if (r < CI_PB) { const int kb = r / 16, pr = r % 16; conv_item64(in[14] + (size_t)l * GVW * DM, DM, 64 * pr, 32, 64 * pr + 32, 32, nullptr, 64 * kb, (bf16*)(wset + W_PA), 64 * pr, QAW + GVW, QAW + 64 * kb, scr, lane); continue; }
        r -= CI_PB;
        { const int kb = r / 16, pr = r % 16; conv_item64(in[15] + (size_t)l * DM * DM, DM, 64 * pr, 32, 64 * pr + 32, 32, nullptr, 64 * kb, (bf16*)(wset + W_OUT), 64 * pr, DM, 64 * kb, scr, lane); }
    }
}
__device__ __forceinline__ float wave_sum(float v) {
#pragma unroll
    for (int o = 1; o < 64; o <<= 1) v += __shfl_xor(v, o);
    return v;
}
__device__ __forceinline__ void prologue_phase(const float* x, bf16* XB, float* stats, float* ropec, float* ropes, const float CAS* invf, int gw, int ngw, int lane, int gtid, int gthreads) {
    for (int m0 = gw * 2; m0 < M; m0 += ngw * 2) {
        f32x4 v[2][4];
#pragma unroll
        for (int rr = 0; rr < 2; ++rr) { const f32x4* xr = (const f32x4*)(x + (size_t)(m0 + rr) * DM) + lane;
#pragma unroll
            for (int j = 0; j < 4; ++j) v[rr][j] = __builtin_nontemporal_load(xr + 64 * j); }
        asm volatile("" ::: "memory");
#pragma unroll
        for (int rr = 0; rr < 2; ++rr) { const int m = m0 + rr; unsigned long long* o8 = (unsigned long long*)(XB + (size_t)m * DM) + lane; float s = 0.f;
#pragma unroll
            for (int j = 0; j < 4; ++j) { const f32x4 w = v[rr][j]; s += (w.x * w.x + w.y * w.y) + (w.z * w.z + w.w * w.w);
                o8[64 * j] = (unsigned long long)pk2(w.x, w.y) | ((unsigned long long)pk2(w.z, w.w) << 32); }
            s = wave_sum(s);
            if (lane < 16) stats[(size_t)m * 16 + lane] = (lane == 0) ? s : 0.f; }
    }
    for (int e = gtid; e < SEQ * 32; e += gthreads) { const int t = e >> 5, i = e & 31;
        const float ang = (float)t * invf[i];
        const double a = (double)ang, q = __builtin_rint(a * 0.63661977236758134308), r = __builtin_fma(-q, 6.123233995736766036e-17, __builtin_fma(-q, 1.57079632679489655800, a)), r2 = r * r;
        const double sn = r * (1.0 - r2 / 6.0 * (1.0 - r2 / 20.0 * (1.0 - r2 / 42.0 * (1.0 - r2 / 72.0 * (1.0 - r2 / 110.0 * (1.0 - r2 / 156.0 * (1.0 - r2 / 210.0 * (1.0 - r2 / 272.0))))))));
        const double cs = 1.0 - r2 / 2.0 * (1.0 - r2 / 12.0 * (1.0 - r2 / 30.0 * (1.0 - r2 / 56.0 * (1.0 - r2 / 90.0 * (1.0 - r2 / 132.0 * (1.0 - r2 / 182.0 * (1.0 - r2 / 240.0)))))));
        const int qi = (int)q & 3;
        const double c = (qi == 0) ? cs : (qi == 1) ? -sn : (qi == 2) ? -cs : sn, s_ = (qi == 0) ? sn : (qi == 1) ? cs : (qi == 2) ? -sn : -cs;
        ropec[e] = (float)c; ropes[e] = (float)s_; }
}

__device__ __forceinline__ void panel_rstd(const float* stats, int pm, LAS float* tab, int tid) {
    if (tid < 256) { const f32x4* p = (const f32x4*)(stats + (size_t)(pm * 256 + tid) * 16); const f32x4 t = (p[0] + p[1]) + (p[2] + p[3]);
        tab[tid] = __builtin_amdgcn_rsqf(((t[0] + t[1]) + (t[2] + t[3])) * (1.0f / 1024.0f) + 1e-6f); }
    __syncthreads();
}
struct Args { const float* in[20]; float* out; unsigned char* ws; float invf[32]; int s_lo, s_hi, ph_lo, ph_hi, do_pro, pad; };
enum { PH_CONV = 0, PH_GU = 1, PH_DN = 2, PH_IN = 3, PH_X1 = 4, PH_SCAN = 5, PH_G3 = 6, PH_PROJ = 7, PH_OUT = 8, N_PH = 9 };
#ifndef PHMASK
#define PHMASK 0x3ff
#endif
#define P_WSET(layer) (ws + WS_W + (size_t)((layer) & 1) * W_SET)
#define P_X     (ap->out)
#define P_XB    ((bf16*)(ws + WS_XB))
#define P_STATS ((float*)(ws + WS_STATS))
#define P_HID   ((bf16*)(ws + WS_ZH))
#define P_QA    ((bf16*)(ws + Z_QA))
#define P_KA    ((bf16*)(ws + Z_KA))
#define P_VA    ((bf16*)(ws + Z_VA))
#define P_QB    ((bf16*)(ws + Z_QB))
#define P_KB    ((bf16*)(ws + Z_KB))
#define P_VB    ((bf16*)(ws + Z_VB))
#define P_RB    ((bf16*)(ws + Z_RB))
#define P_GA    ((bf16*)(ws + Z_GA))
#define P_GB    ((bf16*)(ws + Z_GB))
#define P_GLR   ((float*)(ws + WS_GLR))
#define P_OC    ((bf16*)(ws + WS_OC))
#define P_ROPEC ((float*)(ws + WS_ROPEC))
#define P_ROPES ((float*)(ws + WS_ROPES))
#define PHASE_WS() const CAS Args* ap = (const CAS Args*)__builtin_amdgcn_kernarg_segment_ptr(); asm volatile("" : "+s"(ap)); unsigned char* ws = ap->ws; (void)ws; int bxl = bx, Gl = G; asm volatile("" : "+s"(bxl), "+s"(Gl)); (void)bxl; (void)Gl
#define PHASE_IDS() PHASE_WS(); int tid = tid0; asm volatile("" : "+v"(tid)); const int lane = tid & 63, wave = __builtin_amdgcn_readfirstlane(tid >> 6); const int gw = vcu * 8 + wave, gtid = vcu * 512 + tid; (void)lane; (void)gw; (void)gtid
#define GLA_TENSORS() gla::Tensors GT{P_QB, P_KB, P_VB, P_RB, P_OC, P_GLR, ap->in[10] + (size_t)l * 16 * GKW, ap->in[11] + (size_t)l * GKW, ap->in[12] + (size_t)l * GVW, (float*)(ws + WS_R), (float*)(ws + WS_SST), (float*)(ws + WS_DSEG), (unsigned*)(ws + WS_E1), (float*)(ws + WS_CC)}
#ifndef PROBE_MASK
#define PROBE_MASK 0
#endif
#define PB(k) do { if (PROBE_MASK && ((PROBE_MASK >> (k)) & 1) && bx == 0) probe_fn(0); } while (0)
#define PE(k) do { if (PROBE_MASK && ((PROBE_MASK >> (k)) & 1) && bx == 0) probe_fn(1); } while (0)
#ifndef PROBE_AMP
#define PROBE_AMP 4
#endif
__device__ __noinline__ void probe_fn(int mode) {
    volatile LAS unsigned* Mw = (volatile LAS unsigned*)(uintptr_t)(MISC_OFF);
    if (threadIdx.x != 0) return;
    const unsigned long long now = __builtin_amdgcn_s_memrealtime();
    if (mode == 0) { Mw[16] = (unsigned)now; Mw[17] = (unsigned)(now >> 32); }
    else if (mode == 1) { const unsigned long long a_ = (((unsigned long long)Mw[19] << 32) | Mw[18]) + (now - (((unsigned long long)Mw[17] << 32) | Mw[16])); Mw[18] = (unsigned)a_; Mw[19] = (unsigned)(a_ >> 32); }
    else { const unsigned long long end_ = now + (unsigned long long)PROBE_AMP * (((unsigned long long)Mw[19] << 32) | Mw[18]); while (__builtin_amdgcn_s_memrealtime() < end_) __builtin_amdgcn_s_sleep(16); }
}
__global__ void __launch_bounds__(512, 2) mega_fwd(Args args) {
    extern __shared__ __attribute__((aligned(16))) unsigned char lds_raw[];
    LAS unsigned char* lds = (LAS unsigned char*)lds_raw;
    volatile LAS unsigned* MISC = (volatile LAS unsigned*)(lds + MISC_OFF);
    const int tid0 = threadIdx.x;
    const int G = gridDim.x, bx = blockIdx.x, vcu = (G % 8 == 0) ? (bx % 8) * (G / 8) + bx / 8 : bx;
    const int ngw = G * 8, gthreads = G * 512;
    for (int u = tid0; u < (LDS_BYTES - RING_BYTES) / 4; u += 512) ((LAS unsigned*)(lds + RING_BYTES))[u] = 0u;
    __syncthreads();
#if !MULTI
    XcdBarrier bar = xcd_barrier_post((unsigned*)(args.ws + WS_CTL) + CW_BAR, MISC + 8);
#define GRID_BAR() do { SEC_B(7); xcd_barrier(bar); SEC_E(7); } while (0)
#else
    (void)MISC;
#define GRID_BAR() do { } while (0)
#endif
    if (((PHMASK >> 9) & 1) && (!MULTI || args.do_pro)) {
        PB(9); PHASE_IDS(); prologue_phase(ap->in[0], P_XB, P_STATS, P_ROPEC, P_ROPES, ap->invf, gw, ngw, lane, gtid, gthreads);
        conv_run(ap->in, 0, P_WSET(0), 0, CI_ALL, gw, ngw, lds + wave * 16384, lane);
        GRID_BAR(); PE(9);
    }
#if MULTI
    const int lo = args.ph_lo, hi = args.ph_hi, s_lo = args.s_lo, s_hi = args.s_hi;
#define IN(k) (((PHMASK >> (k)) & 1) && lo <= (k) && (k) < hi)
#else
    constexpr int s_lo = 0, s_hi = 2 * DEPTH;
#define IN(k) ((PHMASK >> (k)) & 1)
#endif
    for (int st = s_lo; st < s_hi; ++st) {
        const int l = st >> 1, odd = st & 1;
        if (IN(PH_GU)) { PB(PH_GU); PHASE_WS();
            pg8::Gemm g{P_XB, (const bf16*)(P_WSET(l) + (odd ? W_GU2 : W_GU1)), M, NGU, DM}; pg8::StaticOrder S; S.init(M, NGU, Gl, bxl);
            { pg8::Unit u0; S.next(0, u0); panel_rstd(P_STATS, u0.pm, (LAS float*)(lds + RSTD_OFF), tid0); }
            pg8::EpiGU E{P_HID, (const LAS float*)(lds + RSTD_OFF)};
            pg8::gemm_phase<pg8::EpiGU, pg8::StaticOrder, true, true>(lds, g, S, E);
            if (((PHMASK >> PH_CONV) & 1) && l + 1 < DEPTH) {
                constexpr int NU = (M / 256) * (NGU / 256); const int rounds = (NU + Gl - 1) / Gl, nshort = rounds * Gl - NU, first = nshort ? Gl - nshort : 0, nw = nshort ? nshort : Gl;
                if (bxl >= first) { int tid = tid0; asm volatile("" : "+v"(tid)); const int lane = tid & 63, wave = __builtin_amdgcn_readfirstlane(tid >> 6); __syncthreads(); conv_run(ap->in, l + 1, P_WSET(l + 1), odd ? CI_ALL / 2 : 0, odd ? CI_ALL : CI_ALL / 2, (bxl - first) * 8 + wave, nw * 8, lds + wave * 16384, lane); }
            }
            GRID_BAR(); PE(PH_GU);
        }
        if (IN(PH_DN)) { PB(PH_DN); PHASE_WS();
            pg8::Gemm g{P_HID, (const bf16*)(P_WSET(l) + (odd ? W_D2 : W_D1)), M, DM, FF}; pg8::StaticOrder S; S.init(M, DM, Gl, bxl);
            pg8::EpiRes E{st == 0 ? ap->in[0] : (const float*)P_X, P_X, P_XB, P_STATS, 0.5f};
            pg8::gemm_phase<pg8::EpiRes, pg8::StaticOrder, false, true>(lds, g, S, E);
            if (MULTI || st + 1 < s_hi) GRID_BAR();
            PE(PH_DN);
        }
        if (!odd) {
            if (IN(PH_IN)) { PB(PH_IN); PHASE_WS();
                pg8::Gemm g{P_XB, (const bf16*)(P_WSET(l) + W_IN), M, NIN, DM}; pg8::StaticOrder S; S.init(M, NIN, Gl, bxl);
                { pg8::Unit u0; S.next(0, u0); panel_rstd(P_STATS, u0.pm, (LAS float*)(lds + RSTD_OFF), tid0); }
                pg8::EpiIn E{ws, ap->in[7] + l * 64, ap->in[8] + l * 64, (const LAS float*)(lds + RSTD_OFF)};
                pg8::gemm_phase<pg8::EpiIn, pg8::StaticOrder, true, true>(lds, g, S, E);
                GRID_BAR(); PE(PH_IN);
            }
            if (IN(PH_X1)) { PB(PH_X1);
                SEC_B(5); { PHASE_IDS(); GLA_TENSORS(); for (int un = vcu; un < gla::NUNITS; un += G) gla::g1_unit(un, GT, lds, tid); } SEC_E(5);
                GRID_BAR(); PE(PH_X1);
            }
            if (IN(PH_SCAN)) { PB(PH_SCAN);
                { PHASE_IDS(); GLA_TENSORS(); gla::g2_scan(GT, gtid, gthreads); }
                SEC_B(6); { PHASE_IDS(); for (int un = vcu; un < swa::NUNITS; un += G) swa::unit(un, P_QA, P_KA, P_VA, P_OC, ap->in[9] + l * 8, lds, tid); } SEC_E(6);
                GRID_BAR(); PE(PH_SCAN);
            }
            if (IN(PH_G3)) { PB(PH_G3); PHASE_IDS(); GLA_TENSORS(); for (int un = vcu; un < gla::NUNITS; un += G) gla::g3_unit(un, GT, lds, tid); GRID_BAR(); PE(PH_G3); }
            if (IN(PH_PROJ)) { PB(PH_PROJ); PHASE_WS();
                pg8::Gemm g{P_OC, (const bf16*)(P_WSET(l) + W_PA), M, DM, QAW + GVW}; pg8::StaticOrder S; S.init(M, DM, Gl, bxl); pg8::EpiPF E{P_GA, P_GB};
                pg8::gemm_phase<pg8::EpiPF, pg8::StaticOrder, false, true>(lds, g, S, E);
                GRID_BAR(); PE(PH_PROJ);
            }
            if (IN(PH_OUT)) { PB(PH_OUT); PHASE_WS();
                pg8::Gemm g{P_GA, (const bf16*)(P_WSET(l) + W_OUT), M, DM, DM}; pg8::StaticOrder S; S.init(M, DM, Gl, bxl);
                pg8::EpiRes E{P_X, P_X, P_XB, P_STATS, 1.0f};
                pg8::gemm_phase<pg8::EpiRes, pg8::StaticOrder, false, true>(lds, g, S, E);
                GRID_BAR(); PE(PH_OUT);
            }
        }
    }
#ifdef EXTRA_BARS
    for (int i_ = 0; i_ < EXTRA_BARS; ++i_) xcd_barrier(bar);
#endif
    if (PROBE_MASK && bx == 0) probe_fn(2);
#undef IN
}
constexpr size_t WS_DBG_END = WS_END;
constexpr size_t WS_NEED = (DBG ? WS_DBG_END : WS_END);

extern "C" void kernel_launch(void* const* d_in, const int* in_sizes, int n_in, void* d_out, int out_size, void* d_ws, size_t ws_size, hipStream_t stream) {
    static int grid = 0;
    if (grid == 0) {
        if (n_in != 20 || in_sizes[0] != M * DM || out_size != M * DM || ws_size < WS_NEED) {
            fprintf(stderr, "kernel_launch: built for 20 inputs, x/out of %d floats, >= %zu bytes of workspace; got n_in %d, in0 %d, out %d, ws %zu; nothing launched\n", M * DM, (size_t)WS_NEED, n_in, n_in > 0 ? in_sizes[0] : -1, out_size, ws_size); grid = -1; return; }
        int dev = 0, cus = 0, per_cu = 0;
        if (hipGetDevice(&dev) != hipSuccess || hipDeviceGetAttribute(&cus, hipDeviceAttributeMultiprocessorCount, dev) != hipSuccess) { fprintf(stderr, "kernel_launch: device query failed\n"); grid = -1; return; }
        if (hipFuncSetAttribute((const void*)mega_fwd, hipFuncAttributeMaxDynamicSharedMemorySize, LDS_BYTES) != hipSuccess) { fprintf(stderr, "kernel_launch: hipFuncSetAttribute failed\n"); grid = -1; return; }
        if (hipOccupancyMaxActiveBlocksPerMultiprocessor(&per_cu, (const void*)mega_fwd, 512, LDS_BYTES) != hipSuccess || per_cu < 1)
            fprintf(stderr, "kernel_launch: note: occupancy query reports %d workgroups per CU\n", per_cu);
        (void)hipGetLastError();
        grid = cus;
        if (grid != 256) { fprintf(stderr, "kernel_launch: built for a 256-CU device (one workgroup per CU, one row panel per workgroup in the GEMM phases); found %d CUs; nothing launched\n", cus); grid = -1; return; }
    }
    if (grid < 0) return;
    if (hipMemsetAsync((char*)d_ws + WS_CTL, 0, CTL_ZERO_BYTES, stream) != hipSuccess) { fprintf(stderr, "kernel_launch: memset failed\n"); return; }
    Args a{};
    for (int i = 0; i < 20; ++i) a.in[i] = (const float*)d_in[i];
    a.out = (float*)d_out; a.ws = (unsigned char*)d_ws;
    for (int i = 0; i < 32; ++i) a.invf[i] = (float)pow(10000.0, -(double)(2 * i) / 64.0);
#if !MULTI
    a.s_lo = 0; a.s_hi = 2 * DEPTH; a.ph_lo = 0; a.ph_hi = N_PH; a.do_pro = 1;
    hipLaunchKernelGGL(mega_fwd, dim3(grid), dim3(512), LDS_BYTES, stream, a);
#else
    a.s_lo = 0; a.s_hi = 0; a.ph_lo = 0; a.ph_hi = 0; a.do_pro = 1;
    hipLaunchKernelGGL(mega_fwd, dim3(grid), dim3(512), LDS_BYTES, stream, a);
    a.do_pro = 0;
    for (int st = 0; st < 2 * DEPTH; ++st)
        for (int ph = 0; ph < N_PH; ++ph) {
            if (ph == PH_CONV || ((st & 1) && ph >= PH_IN)) continue;
            a.s_lo = st; a.s_hi = st + 1; a.ph_lo = ph; a.ph_hi = ph + 1;
#if DBG
            dbg_before(a, st, ph, stream);
#endif
            hipLaunchKernelGGL(mega_fwd, dim3(grid), dim3(512), LDS_BYTES, stream, a);
#if DBG
            dbg_after(a, st, ph, stream);
#endif
        }
#if DBG
    hipLaunchKernelGGL(dbg_report, dim3(1024), dim3(256), 0, stream, (const float*)((unsigned char*)d_ws + WS_CTL) + CW_DBG, (float*)d_out);
#endif
#endif
    const hipError_t le = hipPeekAtLastError();
    if (le != hipSuccess) fprintf(stderr, "kernel_launch: launch failed: %s (grid %d)\n", hipGetErrorName(le), grid);
}
```

```cpp
#include <hip/hip_runtime.h>
#include <hip/hip_bf16.h>
#include <cstdio>
#include <cstdint>
#include <cmath>

#ifndef DBG
#define DBG 0
#endif
#ifndef MULTI
#define MULTI 0
#endif

constexpr int BATCH = 2, SEQ = 8192, DM = 1024, DEPTH = 4, M = BATCH * SEQ;
constexpr int FF = 2816, NGU = 2 * FF;
constexpr int IN_COLS = 5904, NIN = 6144;
constexpr int QAW = 512, KVW = 128, GKW = 512, GVW = 1024;
constexpr float EPS = 1e-6f;
constexpr float LOG2E = 1.4426950408889634f;
#ifndef G3SEC
#define G3SEC 0
#endif
__device__ __noinline__ void probe_fn(int mode);
#define PG8_SEC_B(k) do { if (G3SEC != 0 && G3SEC == (k) && blockIdx.x == 0) probe_fn(0); } while (0)
#define PG8_SEC_E(k) do { if (G3SEC != 0 && G3SEC == (k) && blockIdx.x == 0) probe_fn(1); } while (0)
namespace pg8 {
#define PG8_LAS __attribute__((address_space(3)))
typedef unsigned short bf16_t;
typedef short bf16x8 __attribute__((ext_vector_type(8)));
typedef float f32x4 __attribute__((ext_vector_type(4)));
typedef unsigned u32x4 __attribute__((ext_vector_type(4)));
constexpr int BM = 256, BK = 64, HALF = 128, HTB = HALF * BK * 2  , STAGE_BYTES = 8 * HTB, NXCD = 8, WGM = 8;

#ifndef PG8_SWZ
#define PG8_SWZ(x) ((x) ^ ((((x) >> 9) & 1) << 5))
#endif
__host__ __device__ __forceinline__ int lds_byte(int r, int c) { const int st = (r >> 4) * 2 + (c >> 5), rr = r & 15, cc = c & 31, ob = rr * 64 + cc * 2; return st * 1024 + PG8_SWZ(ob); }
__host__ __device__ __forceinline__ void stage_rc(int b, int& R, int& C) { const int st = b / 1024, sb = b % 1024, swz = PG8_SWZ(sb); R = (st >> 1) * 16 + swz / 64; C = (st & 1) * 32 + (swz % 64) / 2; }
__host__ __device__ __forceinline__ int perm32(int rho) { const int n = rho >> 4, i = rho & 15; return 8 * (i >> 2) + 4 * n + (i & 3); }

struct Unit { int pm, pn; };
struct Gemm { const bf16_t* A; const bf16_t* Bt; int M, N, K; };

struct StaticOrder {
    int nM, nN, nwg, G, c;
    __host__ __device__ void init(int M, int N, int G_, int c_) { nM = M / BM; nN = N / BM; nwg = nM * nN; G = G_; c = c_; }
    __host__ __device__ bool next(int i, Unit& u) const {
        const long L = (long)i * G + c; if (L >= nwg) return false;
        int wgid = (int)L; { const int q = nwg / NXCD, r = nwg % NXCD, xcd = wgid % NXCD, off = wgid / NXCD; wgid = (xcd < r ? xcd * (q + 1) : r * (q + 1) + (xcd - r) * q) + off; }
        const int nig = WGM * nN, gid = wgid / nig, fm = gid * WGM, gsz = (nM - fm) < WGM ? (nM - fm) : WGM;
        u.pm = fm + ((wgid % nig) % gsz); u.pn = (wgid % nig) / gsz; return true;
    }
    __device__ __forceinline__ void a_ready(const Unit&) const {}
    __device__ __forceinline__ void done(const Unit&) const {}
};

typedef float f32x2 __attribute__((ext_vector_type(2)));
typedef __bf16 bf16x2v __attribute__((ext_vector_type(2)));
__device__ __forceinline__ unsigned cvt_pk_bf16(float lo, float hi) { f32x2 v = {lo, hi}; bf16x2v b = __builtin_convertvector(v, bf16x2v); return __builtin_bit_cast(unsigned, b); }
__device__ __forceinline__ float silu_f(float g) { return g * __builtin_amdgcn_rcpf(1.f + __builtin_amdgcn_exp2f(-1.4426950408889634f * g)); }
__device__ __forceinline__ float sigm_f(float g) { return __builtin_amdgcn_rcpf(1.f + __builtin_amdgcn_exp2f(-1.4426950408889634f * g)); }
__device__ __forceinline__ float bf_lo(unsigned w) { return __builtin_bit_cast(float, w << 16); }
__device__ __forceinline__ float bf_hi(unsigned w) { return __builtin_bit_cast(float, w & 0xffff0000u); }
__device__ __forceinline__ float row_rstd(const float* stats, int row) {
    const f32x4* p = (const f32x4*)(stats + (size_t)row * 16);
    const f32x4 a = p[0], b = p[1], c = p[2], d = p[3]; const f32x4 s = (a + b) + (c + d);
    return __builtin_amdgcn_rsqf(((s[0] + s[1]) + (s[2] + s[3])) * (1.0f / 1024.0f) + 1e-6f);
}
__device__ __forceinline__ u32x4 pack8(const f32x4 v0, const f32x4 v1) { u32x4 w; w.x = cvt_pk_bf16(v0[0], v0[1]); w.y = cvt_pk_bf16(v0[2], v0[3]); w.z = cvt_pk_bf16(v1[0], v1[1]); w.w = cvt_pk_bf16(v1[2], v1[3]); return w; }

__device__ __forceinline__ void rows_rstd(float (&rs)[8], const PG8_LAS float* tab, int rl0) {
#pragma unroll
    for (int i = 0; i < 8; ++i) rs[i] = tab[rl0 + (i >> 2) * HALF + (i & 3) * 16];
}
struct EpiGU {
    static constexpr bool PERM = true, AFTER_DRAIN = false; static constexpr int MID_T = 0, SEC_ID = 8;
    bf16_t* H; const PG8_LAS float* rtab;
    __device__ __forceinline__ void operator()(const f32x4 (&acc)[2][2][4][2], const Unit& u, int wr, int wc, int fr, int fq) const {
        int row0 = u.pm * BM + wr * 64 + fr; asm volatile("" : "+v"(row0)); const int col0 = u.pn * 128 + wc * 32 + 8 * fq;
        float rs[8]; rows_rstd(rs, rtab, wr * 64 + fr);
#pragma unroll
        for (int ai = 0; ai < 2; ++ai)
#pragma unroll
            for (int m = 0; m < 4; ++m) { const int row = row0 + ai * HALF + m * 16; const float r = rs[ai * 4 + m];
                f32x4 o[2];
#pragma unroll
                for (int n = 0; n < 2; ++n) { const f32x4 g = acc[ai][0][m][n] * r, up = acc[ai][1][m][n] * r;
#pragma unroll
                    for (int e = 0; e < 4; ++e) o[n][e] = silu_f(g[e]) * up[e]; }
                *(u32x4*)(H + (size_t)row * 2816 + col0) = pack8(o[0], o[1]); }
    }
};
struct EpiRes {
    static constexpr bool PERM = true, AFTER_DRAIN = false; static constexpr int MID_T = 0, SEC_ID = 10;
    const float* Xin; float* X; bf16_t* XB; float* stats; float scale;
    __device__ __forceinline__ void operator()(const f32x4 (&acc)[2][2][4][2], const Unit& u, int wr, int wc, int fr, int fq) const {
        int row0 = u.pm * BM + wr * 64 + fr; asm volatile("" : "+v"(row0)); const int col0 = u.pn * BM + wc * 32 + 8 * fq;
        f32x4 xa[2][2][2];
#define EPI_LDX(buf, it) do { const float* xp_ = Xin + (size_t)(row0 + ((it) >> 2) * HALF + ((it) & 3) * 16) * 1024 + col0; \
            xa[buf][0][0] = *(const f32x4*)xp_; xa[buf][0][1] = *(const f32x4*)(xp_ + 4); xa[buf][1][0] = *(const f32x4*)(xp_ + HALF); xa[buf][1][1] = *(const f32x4*)(xp_ + HALF + 4); } while (0)
        EPI_LDX(0, 0);
#pragma unroll
        for (int it = 0; it < 8; ++it) { const int ai = it >> 2, m = it & 3, row = row0 + ai * HALF + m * 16, cb = it & 1;
            if (it < 7) EPI_LDX(cb ^ 1, it + 1);
            asm volatile("" ::: "memory");
            float ss = 0.f;
#pragma unroll
            for (int bj = 0; bj < 2; ++bj) { float* xp = X + (size_t)row * 1024 + col0 + bj * HALF;
                const f32x4 v0 = xa[cb][bj][0] + acc[ai][bj][m][0] * scale, v1 = xa[cb][bj][1] + acc[ai][bj][m][1] * scale;
                *(f32x4*)xp = v0; *(f32x4*)(xp + 4) = v1;
                *(u32x4*)(XB + (size_t)row * 1024 + col0 + bj * HALF) = pack8(v0, v1);
                ss += ((v0[0] * v0[0] + v0[1] * v0[1]) + (v0[2] * v0[2] + v0[3] * v0[3])) + ((v1[0] * v1[0] + v1[1] * v1[1]) + (v1[2] * v1[2] + v1[3] * v1[3])); }
            ss += __shfl_xor(ss, 16); ss += __shfl_xor(ss, 32);
            if (fq == 0) stats[(size_t)row * 16 + u.pn * 4 + wc] = ss; }
#undef EPI_LDX
    }
};
constexpr size_t EPI_MiB = 1u << 20, EPI_ROPEC = 1 * EPI_MiB, EPI_ROPES = 2 * EPI_MiB, EPI_STATS = 3 * EPI_MiB, EPI_GLR = 4 * EPI_MiB, EPI_ZH = 140 * EPI_MiB;
constexpr size_t EPI_QA = EPI_ZH, EPI_KA = EPI_ZH + 16 * EPI_MiB, EPI_VA = EPI_ZH + 20 * EPI_MiB, EPI_QB = EPI_ZH + 24 * EPI_MiB, EPI_KB = EPI_ZH + 40 * EPI_MiB, EPI_VB = EPI_ZH + 56 * EPI_MiB, EPI_RB = EPI_ZH + 88 * EPI_MiB, EPI_GA = EPI_ZH + 120 * EPI_MiB, EPI_GB = EPI_ZH + 152 * EPI_MiB;
struct EpiIn {
    static constexpr bool PERM = true, AFTER_DRAIN = false; static constexpr int MID_T = 0, SEC_ID = 9;
    unsigned char* ws; const float* qgain; const float* kgain; const PG8_LAS float* rtab;
    template <int ACT> __device__ __forceinline__ void plain(const f32x4 (&acc)[2][2][4][2], const Unit& u, int wr, int wc, int fr, int fq, bf16_t* dst, int pitch, int colt, float sc) const {
        int row0 = u.pm * BM + wr * 64 + fr; asm volatile("" : "+v"(row0)); const int col0 = colt + wc * 32 + 8 * fq;
        float rs[8]; rows_rstd(rs, rtab, wr * 64 + fr);
#pragma unroll
        for (int ai = 0; ai < 2; ++ai)
#pragma unroll
            for (int m = 0; m < 4; ++m) { const int row = row0 + ai * HALF + m * 16; const float r = rs[ai * 4 + m] * sc;
#pragma unroll
                for (int bj = 0; bj < 2; ++bj) { f32x4 v0 = acc[ai][bj][m][0] * r, v1 = acc[ai][bj][m][1] * r;
                    if (ACT == 1) {
#pragma unroll
                        for (int e = 0; e < 4; ++e) { v0[e] = silu_f(v0[e]); v1[e] = silu_f(v1[e]); } }
                    if (ACT == 2) {
#pragma unroll
                        for (int e = 0; e < 4; ++e) { v0[e] = sigm_f(v0[e]); v1[e] = sigm_f(v1[e]); } }
                    *(u32x4*)(dst + (size_t)row * pitch + col0 + bj * HALF) = pack8(v0, v1); } }
    }
    __device__ __forceinline__ void normrope(const f32x4 (&acc)[2][2][4][2], const Unit& u, int wr, int fr, int fq, bf16_t* dst, int pitch, int colh, const float* gain, float osc) const {
        int row0 = u.pm * BM + wr * 64 + fr; asm volatile("" : "+v"(row0));
        const float* ropec = (const float*)(ws + EPI_ROPEC); const float* ropes = (const float*)(ws + EPI_ROPES);
        float rs[8]; rows_rstd(rs, rtab, wr * 64 + fr);
        f32x4 cs[2][2][2];
#define EPI_LDR(buf, it) do { const size_t t_ = (size_t)((row0 + ((it) >> 2) * HALF + ((it) & 3) * 16) & (SEQ - 1)) * 32 + 8 * fq; \
            cs[buf][0][0] = *(const f32x4*)(ropec + t_); cs[buf][0][1] = *(const f32x4*)(ropes + t_); cs[buf][1][0] = *(const f32x4*)(ropec + t_ + 4); cs[buf][1][1] = *(const f32x4*)(ropes + t_ + 4); } while (0)
#pragma unroll
        for (int it = 0; it < 8; ++it) { const int ai = it >> 2, m = it & 3, row = row0 + ai * HALF + m * 16, cb = it & 1;
            EPI_LDR(cb, it);
            const float r = rs[it]; float ss = 0.f;
            f32x4 g1[2], g2[2];
#pragma unroll
            for (int n = 0; n < 2; ++n) { g1[n] = *(const f32x4*)(gain + 8 * fq + 4 * n); g2[n] = *(const f32x4*)(gain + 32 + 8 * fq + 4 * n); }
#pragma unroll
            for (int bj = 0; bj < 2; ++bj)
#pragma unroll
                for (int n = 0; n < 2; ++n) { const f32x4 q = acc[ai][bj][m][n]; ss += (q[0] * q[0] + q[1] * q[1]) + (q[2] * q[2] + q[3] * q[3]); }
            ss += __shfl_xor(ss, 16); ss += __shfl_xor(ss, 32);
            const float sc2 = osc * r * __builtin_amdgcn_rsqf(ss * (r * r) * (1.0f / 64.0f) + 1e-6f);
            f32x4 o1[2], o2[2];
#pragma unroll
            for (int n = 0; n < 2; ++n) { const f32x4 c = cs[cb][n][0], sn = cs[cb][n][1];
                const f32x4 x1 = acc[ai][0][m][n] * sc2 * g1[n], x2 = acc[ai][1][m][n] * sc2 * g2[n];
                o1[n] = x1 * c - x2 * sn; o2[n] = x2 * c + x1 * sn; }
            bf16_t* p = dst + (size_t)row * pitch + colh + 8 * fq;
            *(u32x4*)p = pack8(o1[0], o1[1]); *(u32x4*)(p + 32) = pack8(o2[0], o2[1]); }
#undef EPI_LDR
    }
    __device__ __forceinline__ void operator()(const f32x4 (&acc)[2][2][4][2], const Unit& u, int wr, int wc, int fr, int fq) const {
        const int pn = u.pn;
        if (pn < 2) { normrope(acc, u, wr, fr, fq, (bf16_t*)(ws + EPI_QA), 512, (4 * pn + wc) * 64, qgain, 0.125f * 1.4426950408889634f); }
        else if (pn == 2) {
            if (wc < 2) normrope(acc, u, wr, fr, fq, (bf16_t*)(ws + EPI_KA), 128, wc * 64, kgain, 1.0f);
            else {
                int row0 = u.pm * BM + wr * 64 + fr; asm volatile("" : "+v"(row0));
                float rs[8]; rows_rstd(rs, rtab, wr * 64 + fr);
#pragma unroll
                for (int ai = 0; ai < 2; ++ai)
#pragma unroll
                    for (int m = 0; m < 4; ++m) { const int row = row0 + ai * HALF + m * 16; const float r = rs[ai * 4 + m];
#pragma unroll
                        for (int bj = 0; bj < 2; ++bj) *(u32x4*)((bf16_t*)(ws + EPI_VA) + (size_t)row * 128 + (wc - 2) * 64 + bj * 32 + 8 * fq) = pack8(acc[ai][bj][m][0] * r, acc[ai][bj][m][1] * r); } }
        }
        else if (pn < 5)  plain<0>(acc, u, wr, wc, fr, fq, (bf16_t*)(ws + EPI_QB), 512, (pn - 3) * 256, 0.08838834764831845f);
        else if (pn < 7)  plain<0>(acc, u, wr, wc, fr, fq, (bf16_t*)(ws + EPI_KB), 512, (pn - 5) * 256, 1.0f);
        else if (pn < 11) plain<0>(acc, u, wr, wc, fr, fq, (bf16_t*)(ws + EPI_VB), 1024, (pn - 7) * 256, 1.0f);
        else if (pn < 15) plain<1>(acc, u, wr, wc, fr, fq, (bf16_t*)(ws + EPI_RB), 1024, (pn - 11) * 256, 1.0f);
        else if (pn < 19) plain<2>(acc, u, wr, wc, fr, fq, (bf16_t*)(ws + EPI_GA), 1024, (pn - 15) * 256, 1.0f);
        else if (pn < 23) plain<2>(acc, u, wr, wc, fr, fq, (bf16_t*)(ws + EPI_GB), 1024, (pn - 19) * 256, 1.0f);
        else { if (wc == 0 && fq < 2) { int row0 = u.pm * BM + wr * 64 + fr; asm volatile("" : "+v"(row0)); float rs[8]; rows_rstd(rs, rtab, wr * 64 + fr);
#pragma unroll
                for (int ai = 0; ai < 2; ++ai)
#pragma unroll
                    for (int m = 0; m < 4; ++m) { const int row = row0 + ai * HALF + m * 16; const float r = rs[ai * 4 + m];
                        float* p = (float*)(ws + EPI_GLR) + (size_t)row * 16 + 8 * fq; *(f32x4*)p = acc[ai][0][m][0] * r; *(f32x4*)(p + 4) = acc[ai][0][m][1] * r; } } }
    }
};
struct EpiPF {
    static constexpr bool PERM = true, AFTER_DRAIN = false; static constexpr int MID_T = 8, SEC_ID = 0;
    bf16_t* MG; const bf16_t* GB;
    __device__ __forceinline__ void mid(f32x4 (&acc)[2][2][4][2], const Unit& u, int wr, int wc, int fr, int fq) const {
        int row0 = u.pm * BM + wr * 64 + fr; asm volatile("" : "+v"(row0)); const int col0 = u.pn * BM + wc * 32 + 8 * fq;
        u32x4 ab[2][2], gb[2][2];
#define EPI_LDG(buf, it) do { const size_t o_ = (size_t)(row0 + ((it) >> 2) * HALF + ((it) & 3) * 16) * 1024 + col0; ab[buf][0] = *(const u32x4*)(MG + o_); ab[buf][1] = *(const u32x4*)(MG + o_ + HALF); \
            gb[buf][0] = *(const u32x4*)(GB + o_); gb[buf][1] = *(const u32x4*)(GB + o_ + HALF); } while (0)
        EPI_LDG(0, 0);
#pragma unroll
        for (int it = 0; it < 8; ++it) { const int ai = it >> 2, m = it & 3, cb = it & 1;
            if (it < 7) EPI_LDG(cb ^ 1, it + 1);
            asm volatile("" ::: "memory");
#pragma unroll
            for (int bj = 0; bj < 2; ++bj) { const u32x4 a = ab[cb][bj], g = gb[cb][bj];
                const f32x4 a0 = {bf_lo(a.x), bf_hi(a.x), bf_lo(a.y), bf_hi(a.y)}, a1 = {bf_lo(a.z), bf_hi(a.z), bf_lo(a.w), bf_hi(a.w)};
                f32x4 g0 = {bf_lo(g.x), bf_hi(g.x), bf_lo(g.y), bf_hi(g.y)}, g1 = {bf_lo(g.z), bf_hi(g.z), bf_lo(g.w), bf_hi(g.w)};
#pragma unroll
                for (int e = 0; e < 4; ++e) { g0[e] = __builtin_amdgcn_rcpf(g0[e]); g1[e] = __builtin_amdgcn_rcpf(g1[e]); }
                acc[ai][bj][m][0] = acc[ai][bj][m][0] * (a0 * g0); acc[ai][bj][m][1] = acc[ai][bj][m][1] * (a1 * g1); } }
#undef EPI_LDG
    }
    __device__ __forceinline__ void operator()(const f32x4 (&acc)[2][2][4][2], const Unit& u, int wr, int wc, int fr, int fq) const {
        int row0 = u.pm * BM + wr * 64 + fr; asm volatile("" : "+v"(row0)); const int col0 = u.pn * BM + wc * 32 + 8 * fq;
        u32x4 gb[2][2];
#define EPI_LDG(buf, it) do { const bf16_t* p_ = GB + (size_t)(row0 + ((it) >> 2) * HALF + ((it) & 3) * 16) * 1024 + col0; gb[buf][0] = *(const u32x4*)p_; gb[buf][1] = *(const u32x4*)(p_ + HALF); } while (0)
        EPI_LDG(0, 0);
#pragma unroll
        for (int it = 0; it < 8; ++it) { const int ai = it >> 2, m = it & 3, row = row0 + ai * HALF + m * 16, cb = it & 1;
            if (it < 7) EPI_LDG(cb ^ 1, it + 1);
            asm volatile("" ::: "memory");
#pragma unroll
            for (int bj = 0; bj < 2; ++bj) { const u32x4 g = gb[cb][bj];
                const f32x4 g0 = {bf_lo(g.x), bf_hi(g.x), bf_lo(g.y), bf_hi(g.y)}, g1 = {bf_lo(g.z), bf_hi(g.z), bf_lo(g.w), bf_hi(g.w)};
                *(u32x4*)(MG + (size_t)row * 1024 + col0 + bj * HALF) = pack8(acc[ai][bj][m][0] * g0, acc[ai][bj][m][1] * g1); } }
#undef EPI_LDG
    }
};

template <class Epi, class Sched, bool ALIGN_EPI = false, bool SP2 = false>
__device__ __forceinline__ void gemm_phase(PG8_LAS unsigned char* lds, const Gemm g, const Sched& S, const Epi& E) {
    int tid_l = threadIdx.x; asm volatile("" : "+v"(tid_l));
    const int tid = tid_l, wid = __builtin_amdgcn_readfirstlane(tid >> 6), lane = tid & 63, wr = wid >> 2, wc = wid & 3, fr = lane & 15, fq = lane >> 4;
    const int K = g.K, nt = K / BK;
    unsigned voffA[2], voffB[2];
#pragma unroll
    for (int i = 0; i < 2; ++i) { int R, C; stage_rc(tid * 16 + i * 8192, R, C); const int Rb = Epi::PERM ? ((R & ~31) + perm32(R & 31)) : R;
        voffA[i] = (unsigned)(R * K + C) * 2u; voffB[i] = (unsigned)(Rb * K + C) * 2u; }
    const size_t kstep = (size_t)(BK * 2);
    const size_t hstep = (size_t)HALF * K * 2;
    const size_t tstep = 2 * hstep;
    const unsigned ldsw = (unsigned)wid * 1024u;
    const int aoff = lds_byte(wr * 64 + fr, fq * 8), boff = lds_byte(wc * 32 + fr, fq * 8);
#define PG8_SA(b, h) (((b) * 2 + (h)) * HTB)
#define PG8_SB(b, h) ((4 + (b) * 2 + (h)) * HTB)
#define PG8_STAGE(bufoff, gbase, voff) do { _Pragma("unroll") for (int _i = 0; _i < 2; ++_i) \
        __builtin_amdgcn_global_load_lds((const unsigned*)((const char*)(gbase) + (voff)[_i]), (PG8_LAS unsigned*)(lds + (bufoff) + ldsw + _i * 8192), 16, 0, 0); } while (0)
#define PG8_LDA(dst, b, h) do { _Pragma("unroll") for (int m = 0; m < 4; ++m) _Pragma("unroll") for (int k = 0; k < 2; ++k) dst[m][k] = *(const PG8_LAS bf16x8*)(lds + PG8_SA(b, h) + aoff + m * 2048 + k * 1024); } while (0)
#define PG8_LDB(dst, b, h) do { _Pragma("unroll") for (int n = 0; n < 2; ++n) _Pragma("unroll") for (int k = 0; k < 2; ++k) dst[n][k] = *(const PG8_LAS bf16x8*)(lds + PG8_SB(b, h) + boff + n * 2048 + k * 1024); } while (0)
#define PG8_MMA(ai, bj, At, Bt) do { __builtin_amdgcn_s_setprio(1); _Pragma("unroll") for (int m = 0; m < 4; ++m) _Pragma("unroll") for (int n = 0; n < 2; ++n) _Pragma("unroll") for (int k = 0; k < 2; ++k) \
        acc[ai][bj][m][n] = __builtin_amdgcn_mfma_f32_16x16x32_bf16(Bt[n][k], At[m][k], acc[ai][bj][m][n], 0, 0, 0); __builtin_amdgcn_s_setprio(0); } while (0)
#define PG8_WAIT_V(n) asm volatile("s_waitcnt vmcnt(" #n ")" ::: "memory")
#define PG8_WAIT_L(n) asm volatile("s_waitcnt lgkmcnt(" #n ")" ::: "memory")
#define PG8_BAR __builtin_amdgcn_s_barrier()
#define PG8_SCHED __builtin_amdgcn_sched_barrier(0)
    Unit cur, nxt; int ui = 0;
    if (!S.next(0, cur)) return;
    f32x4 acc[2][2][4][2];
#pragma unroll
    for (int a = 0; a < 2; ++a)
#pragma unroll
        for (int b = 0; b < 2; ++b)
#pragma unroll
            for (int m = 0; m < 4; ++m)
#pragma unroll
                for (int n = 0; n < 2; ++n) acc[a][b][m][n] = (f32x4){0.f, 0.f, 0.f, 0.f};
    bf16x8 At[4][2], B0[2][2], B1[2][2];
    const char* cA = (const char*)g.A + (size_t)cur.pm * tstep; const char* cB = (const char*)g.Bt + (size_t)cur.pn * tstep;
    S.a_ready(cur);
    if constexpr (SP2) {
        PG8_STAGE(PG8_SB(0, 0), cB, voffB); PG8_STAGE(PG8_SB(0, 1), cB + hstep, voffB); PG8_STAGE(PG8_SA(0, 0), cA, voffA); PG8_STAGE(PG8_SA(0, 1), cA + hstep, voffA);
        if (wr == 1) PG8_BAR;
        PG8_WAIT_V(2); PG8_BAR;
        PG8_STAGE(PG8_SB(1, 0), cB + kstep, voffB); PG8_STAGE(PG8_SA(1, 0), cA + kstep, voffA); PG8_STAGE(PG8_SB(1, 1), cB + hstep + kstep, voffB);
        PG8_WAIT_V(6); PG8_BAR;
    } else {
        PG8_STAGE(PG8_SB(0, 0), cB, voffB); PG8_STAGE(PG8_SA(0, 0), cA, voffA); PG8_STAGE(PG8_SB(0, 1), cB + hstep, voffB); PG8_STAGE(PG8_SA(0, 1), cA + hstep, voffA);
        if (wr == 1) PG8_BAR;
        PG8_WAIT_V(4); PG8_BAR;
        PG8_STAGE(PG8_SB(1, 0), cB + kstep, voffB); PG8_STAGE(PG8_SA(1, 0), cA + kstep, voffA); PG8_STAGE(PG8_SB(1, 1), cB + hstep + kstep, voffB);
        PG8_WAIT_V(6); PG8_BAR;
    }
    for (;;) {
        const bool has_next = S.next(ui + 1, nxt);
        const char* nA = has_next ? (const char*)g.A + (size_t)nxt.pm * tstep : cA; const char* nB = has_next ? (const char*)g.Bt + (size_t)nxt.pn * tstep : cB;
        int t = 0;
        for (int kseg = 0; kseg < (Epi::MID_T > 0 ? 2 : 1); ++kseg) {
        const int t_end = (Epi::MID_T > 0 && kseg == 0) ? Epi::MID_T : nt;
        for (; t < t_end; t += 2) {
            const bool last = (t == nt - 2);
            const char* a1 = cA + (size_t)(t + 1) * kstep;
            const char* a2 = last ? nA : cA + (size_t)(t + 2) * kstep; const char* b2 = last ? nB : cB + (size_t)(t + 2) * kstep;
            const char* a3 = a2 + kstep; const char* b3 = b2 + kstep;
            if (last && has_next) S.a_ready(nxt);
            if constexpr (SP2) {
            PG8_LDB(B0, 0, 0); PG8_LDB(B1, 0, 1); PG8_SCHED; PG8_LDA(At, 0, 0); PG8_STAGE(PG8_SA(1, 1), a1 + hstep, voffA);
            PG8_WAIT_V(8); PG8_WAIT_L(0); PG8_BAR; PG8_MMA(0, 0, At, B0); PG8_MMA(0, 1, At, B1); PG8_BAR; PG8_SCHED;
            PG8_LDA(At, 0, 1); PG8_STAGE(PG8_SB(0, 0), b2, voffB); PG8_STAGE(PG8_SB(0, 1), b2 + hstep, voffB); PG8_STAGE(PG8_SA(0, 0), a2, voffA);
            PG8_WAIT_V(8); PG8_WAIT_L(0); PG8_BAR; PG8_MMA(1, 0, At, B0); PG8_MMA(1, 1, At, B1); PG8_BAR; PG8_SCHED;
            PG8_LDB(B0, 1, 0); PG8_LDB(B1, 1, 1); PG8_SCHED; PG8_LDA(At, 1, 0); PG8_STAGE(PG8_SA(0, 1), a2 + hstep, voffA);
            PG8_WAIT_V(8); PG8_WAIT_L(0); PG8_BAR; PG8_MMA(0, 0, At, B0); PG8_MMA(0, 1, At, B1); PG8_BAR; PG8_SCHED;
            PG8_LDA(At, 1, 1); PG8_STAGE(PG8_SB(1, 0), b3, voffB); PG8_STAGE(PG8_SB(1, 1), b3 + hstep, voffB); PG8_STAGE(PG8_SA(1, 0), a3, voffA);
            PG8_WAIT_V(8); PG8_WAIT_L(0); PG8_BAR; PG8_MMA(1, 0, At, B0); PG8_MMA(1, 1, At, B1); PG8_BAR; PG8_SCHED;
            } else {
            PG8_LDB(B0, 0, 0); PG8_SCHED; PG8_LDA(At, 0, 0); PG8_STAGE(PG8_SA(1, 1), a1 + hstep, voffA);
            PG8_WAIT_L(8); PG8_BAR; PG8_WAIT_L(0); PG8_MMA(0, 0, At, B0); PG8_BAR; PG8_SCHED;
            PG8_LDB(B1, 0, 1); PG8_STAGE(PG8_SB(0, 0), b2, voffB);
            PG8_BAR; PG8_WAIT_L(0); PG8_MMA(0, 1, At, B1); PG8_BAR;
            PG8_LDA(At, 0, 1); PG8_STAGE(PG8_SA(0, 0), a2, voffA);
            PG8_BAR; PG8_WAIT_L(0); PG8_MMA(1, 0, At, B0); PG8_BAR; PG8_SCHED;
            PG8_STAGE(PG8_SB(0, 1), b2 + hstep, voffB);
            PG8_WAIT_V(6); PG8_BAR; PG8_MMA(1, 1, At, B1); PG8_BAR;
            PG8_LDB(B0, 1, 0); PG8_SCHED; PG8_LDA(At, 1, 0); PG8_STAGE(PG8_SA(0, 1), a2 + hstep, voffA);
            PG8_WAIT_L(8); PG8_BAR; PG8_WAIT_L(0); PG8_MMA(0, 0, At, B0); PG8_BAR; PG8_SCHED;
            PG8_LDB(B1, 1, 1); PG8_STAGE(PG8_SB(1, 0), b3, voffB);
            PG8_BAR; PG8_WAIT_L(0); PG8_MMA(0, 1, At, B1); PG8_BAR;
            PG8_LDA(At, 1, 1); PG8_STAGE(PG8_SA(1, 0), a3, voffA);
            PG8_BAR; PG8_WAIT_L(0); PG8_MMA(1, 0, At, B0); PG8_BAR; PG8_SCHED;
            PG8_STAGE(PG8_SB(1, 1), b3 + hstep, voffB);
            PG8_WAIT_V(6); PG8_BAR; PG8_MMA(1, 1, At, B1); PG8_BAR;
            }
        }
        if constexpr (Epi::MID_T > 0) { if (kseg == 0) E.mid(acc, cur, wr, wc, fr, fq); }
        }
        if constexpr (ALIGN_EPI) { if (wr == 0) PG8_BAR; }
        if constexpr (!Epi::AFTER_DRAIN) { PG8_SEC_B(Epi::SEC_ID); E(acc, cur, wr, wc, fr, fq); PG8_SEC_E(Epi::SEC_ID); S.done(cur); }
        if (!has_next) break;
#pragma unroll
        for (int a = 0; a < 2; ++a)
#pragma unroll
            for (int b = 0; b < 2; ++b)
#pragma unroll
                for (int m = 0; m < 4; ++m)
#pragma unroll
                    for (int n = 0; n < 2; ++n) acc[a][b][m][n] = (f32x4){0.f, 0.f, 0.f, 0.f};
        cur = nxt; cA = nA; cB = nB; ++ui;
        if constexpr (ALIGN_EPI) { if (wr == 1) PG8_BAR; }
    }
    PG8_WAIT_V(0);
    if constexpr (!ALIGN_EPI) { if (wr == 0) PG8_BAR; }
    PG8_BAR;
    if constexpr (Epi::AFTER_DRAIN) { E.fused(acc, cur, wr, wc, fr, fq, lds, wid, lane); S.done(cur); }
#undef PG8_SA
#undef PG8_SB
#undef PG8_STAGE
#undef PG8_LDA
#undef PG8_LDB
#undef PG8_MMA
#undef PG8_WAIT_V
#undef PG8_WAIT_L
#undef PG8_BAR
#undef PG8_SCHED
}
}
#define GAS __attribute__((address_space(1)))
#define LAS __attribute__((address_space(3)))
typedef unsigned short bf16;
typedef unsigned v4u __attribute__((ext_vector_type(4)));
typedef float f32x4 __attribute__((ext_vector_type(4)));
typedef short bf16x8 __attribute__((ext_vector_type(8)));
typedef GAS unsigned gu32;
typedef GAS unsigned long long gu64;
#define RLX_AGENT __ATOMIC_RELAXED, __HIP_MEMORY_SCOPE_AGENT
#define LDS_WAIT() asm volatile("s_waitcnt lgkmcnt(0)" ::: "memory")
#define VM_WAIT() asm volatile("s_waitcnt vmcnt(0)" ::: "memory")
__device__ __forceinline__ unsigned long long rt() { return __builtin_amdgcn_s_memrealtime(); }
__device__ __forceinline__ unsigned f2bf(float f) { unsigned u = __builtin_bit_cast(unsigned, f); return (u + 0x7fffu + ((u >> 16) & 1u)) >> 16; }
__device__ __forceinline__ unsigned pk2(float lo, float hi) { return f2bf(lo) | (f2bf(hi) << 16); }

#define XB_TMO      128
#define XB_XCNT(j)  (256  + 64 * (j))
#define XB_XSUB(j)  (1280 + 64 * (j))
#define XB_XGEN(j)  (2304 + 64 * (j))
#define XB_TOP      3328
#define XB_TOPGEN   3392
#define XCD_BAR_WORDS 3456
#define XB_SPIN_CAP (1u << 18)

__device__ __forceinline__ unsigned xb_ld(unsigned* p)              { return __hip_atomic_load(p, __ATOMIC_RELAXED, __HIP_MEMORY_SCOPE_AGENT); }
__device__ __forceinline__ unsigned xb_add(unsigned* p, unsigned v) { return __hip_atomic_fetch_add(p, v, __ATOMIC_RELAXED, __HIP_MEMORY_SCOPE_AGENT); }
__device__ __forceinline__ unsigned xb_xcc_id() { return (unsigned)__builtin_amdgcn_s_getreg((3 << 11) | 20) & 0xFu; }
#define XB_SPIN(cond, bar) do { unsigned _sp = 0; while (cond) { __builtin_amdgcn_s_sleep(1); \
    if ((++_sp & 255u) == 0u) { if (xb_ld(&(bar)[XB_TMO])) break; if (_sp > XB_SPIN_CAP) { atomicAdd(&(bar)[XB_TMO], 1u); break; } } } } while (0)

struct XcdBarrier {
    unsigned* bar; unsigned x;
    volatile LAS unsigned* st;
};

__device__ __forceinline__ XcdBarrier xcd_barrier_post(unsigned* bar, volatile LAS unsigned* st) {
    XcdBarrier b; b.bar = bar; b.x = xb_xcc_id(); b.st = st;
    if (threadIdx.x == 0) (void)xb_add(&bar[XB_XCNT(b.x)], 1u);
    return b;
}
__device__ __forceinline__ void xcd_barrier_complete(unsigned* bar, unsigned x, unsigned& nloc, unsigned& nx) {
    const unsigned G = gridDim.x * gridDim.y * gridDim.z;
    unsigned sum, cnt, mine, sp = 0u;
    for (;;) {
        sum = 0u; cnt = 0u; mine = 0u;
#pragma unroll
        for (unsigned j = 0; j < 16; ++j) { const unsigned c = xb_ld(&bar[XB_XCNT(j)]); sum += c; cnt += (c > 0u) ? 1u : 0u; mine = (j == x) ? c : mine; }
        if (sum == G) break;
        __builtin_amdgcn_s_sleep(1);
        if ((++sp & 255u) == 0u) { if (xb_ld(&bar[XB_TMO])) break; if (sp > XB_SPIN_CAP) { atomicAdd(&bar[XB_TMO], 1u); break; } }
    }
    nloc = mine > 0u ? mine : 1u; nx = cnt > 0u ? cnt : 1u;
}

__device__ __noinline__ void xcd_barrier_fn(unsigned* bbar, unsigned bx_, volatile LAS unsigned* bst) {
    XcdBarrier b; b.bar = bbar; b.x = bx_; b.st = bst;
    asm volatile("s_waitcnt vmcnt(0)" ::: "memory");
    __syncthreads();
    if (threadIdx.x == 0) {
        unsigned* bar = b.bar;
        __builtin_amdgcn_s_waitcnt(0);
        unsigned nloc = b.st[0], nx = b.st[1];
        if (nloc == 0u) { xcd_barrier_complete(bar, b.x, nloc, nx); b.st[0] = nloc; b.st[1] = nx; }
        const unsigned old = xb_add(&bar[XB_XSUB(b.x)], 1u);
        const unsigned gen = old / nloc;
        if (old + 1u == (gen + 1u) * nloc) {
            __builtin_amdgcn_fence(__ATOMIC_RELEASE, "agent");
            asm volatile("s_waitcnt vmcnt(0)" ::: "memory");
            const unsigned og = xb_add(&bar[XB_TOP], 1u);
            const unsigned tg = og / nx;
            if (og + 1u == (tg + 1u) * nx) xb_add(&bar[XB_TOPGEN], 1u);
            else XB_SPIN(xb_ld(&bar[XB_TOPGEN]) == tg, bar);
            __builtin_amdgcn_fence(__ATOMIC_ACQUIRE, "agent");
            xb_add(&bar[XB_XGEN(b.x)], 1u);
            asm volatile("s_waitcnt vmcnt(0)" ::: "memory");
        } else {
            XB_SPIN(xb_ld(&bar[XB_XGEN(b.x)]) == gen, bar);
            __builtin_amdgcn_fence(__ATOMIC_ACQUIRE, "agent");
            asm volatile("s_waitcnt vmcnt(0)" ::: "memory");
        }
    }
    __syncthreads();
}

__device__ __forceinline__ void xcd_barrier(const XcdBarrier& b) { xcd_barrier_fn(b.bar, b.x, b.st); }
typedef unsigned u32x4 __attribute__((ext_vector_type(4)));

typedef short s16x4 __attribute__((ext_vector_type(4)));
typedef float f32x16 __attribute__((ext_vector_type(16)));
typedef float f32x2_t __attribute__((ext_vector_type(2)));
typedef __bf16 bf16x2_t __attribute__((ext_vector_type(2)));
typedef short v4i16_t __attribute__((ext_vector_type(4)));
typedef unsigned u32x2 __attribute__((ext_vector_type(2)));
#define MFMA32(a, b, c) __builtin_amdgcn_mfma_f32_32x32x16_bf16((a), (b), (c), 0, 0, 0)
__device__ __forceinline__ int crow(int r, int hi) { return (r & 3) + 8 * (r >> 2) + 4 * hi; }
__device__ __forceinline__ unsigned cvtpk(float lo, float hi) { f32x2_t v = {lo, hi}; bf16x2_t b = __builtin_convertvector(v, bf16x2_t); return __builtin_bit_cast(unsigned, b); }
__device__ __forceinline__ s16x4 tr_rd(LAS const unsigned char* p) { return __builtin_bit_cast(s16x4, __builtin_amdgcn_ds_read_tr16_b64_v4i16((LAS v4i16_t*)p)); }
__device__ __forceinline__ bf16x8 cat8(s16x4 lo, s16x4 hi) { return __builtin_shufflevector(lo, hi, 0, 1, 2, 3, 4, 5, 6, 7); }
__device__ __forceinline__ bf16x8 pack_step(const f32x16& x, int s) {
    u32x4 p; p.x = cvtpk(x[8 * s], x[8 * s + 1]); p.y = cvtpk(x[8 * s + 2], x[8 * s + 3]); p.z = cvtpk(x[8 * s + 4], x[8 * s + 5]); p.w = cvtpk(x[8 * s + 6], x[8 * s + 7]);
    return __builtin_bit_cast(bf16x8, p);
}
__device__ __forceinline__ bf16x8 row_frag(LAS const unsigned char* p) { const s16x4 lo = *(LAS const s16x4*)p, hi = *(LAS const s16x4*)(p + 16); return cat8(lo, hi); }

namespace swa {
constexpr int KOFF = 0, VOFF = 3 * 8192, LDS_NEED = 6 * 8192, NUNITS = BATCH * 2 * (SEQ / 64);
__device__ __forceinline__ void unit(int un, const bf16* QA, const bf16* KA, const bf16* VA, bf16* OC  , const float* sinks, LAS unsigned char* lds, int tid) {
    const int lane = tid & 63, r32 = lane & 31, hi = lane >> 5, w = __builtin_amdgcn_readfirstlane(tid >> 6);
    const int i = un & 127, hk = (un >> 7) & 1, b = un >> 8;
    const size_t rowb = (size_t)b * SEQ;
#pragma unroll
    for (int jt = 0; jt < 3; ++jt) {
        const int ti = i - 2 + jt; u32x4 kv = {0u, 0u, 0u, 0u}, vv = {0u, 0u, 0u, 0u};
        if (ti >= 0) {
            kv = *(const u32x4*)(KA + (rowb + ti * 64 + (tid & 63)) * 128 + hk * 64 + (tid >> 6) * 8);
            vv = *(const u32x4*)(VA + (rowb + ti * 64 + 16 * (w & 3) + (lane >> 2)) * 128 + hk * 64 + (w >> 2) * 32 + (lane & 3) * 8);
        }
        *(LAS u32x4*)(lds + KOFF + jt * 8192 + (tid >> 6) * 1024 + (tid & 63) * 16) = kv;
        *(LAS u32x4*)(lds + VOFF + jt * 8192 + tid * 16) = vv;
    }
    const int hq = 4 * hk + (w >> 1), qh = w & 1;
    const bf16* qp = QA + (rowb + 64 * i + 32 * qh + r32) * 512 + hq * 64 + hi * 8;
    bf16x8 qr[4];
#pragma unroll
    for (int d0 = 0; d0 < 4; ++d0) qr[d0] = *(const bf16x8*)(qp + d0 * 16);
    const float sink2 = sinks[hq] * LOG2E;
    __syncthreads();
    f32x16 p[5];
    const int tq = 64 * i + 32 * qh + r32;
    float mx = -INFINITY;
#pragma unroll
    for (int j = 0; j < 5; ++j) {
        const int st = qh + j, jt = st >> 1, kh = st & 1;
        f32x16 a = {};
#pragma unroll
        for (int d0 = 0; d0 < 4; ++d0) { const bf16x8 kf = *(LAS const bf16x8*)(lds + KOFF + jt * 8192 + (2 * d0 + hi) * 1024 + (32 * kh + r32) * 16); a = MFMA32(kf, qr[d0], a); }
        const int tk0 = 64 * (i - 2) + 32 * st;
#pragma unroll
        for (int r = 0; r < 16; ++r) { const int tk = tk0 + crow(r, hi); const bool ok = (tk >= 0) && (tk <= tq) && (tq - tk < 128); a[r] = ok ? a[r] : -INFINITY; mx = fmaxf(mx, a[r]); }
        p[j] = a;
    }
    mx = fmaxf(mx, __shfl_xor(mx, 32));
    const float mm = fmaxf(mx, sink2);
    float sum = 0.f;
#pragma unroll
    for (int j = 0; j < 5; ++j)
#pragma unroll
        for (int r = 0; r < 16; ++r) { const float e = __builtin_amdgcn_exp2f(p[j][r] - mm); p[j][r] = e; sum += e; }
    sum += __shfl_xor(sum, 32);
    const float inv = 1.0f / (sum + __builtin_amdgcn_exp2f(sink2 - mm));
    f32x16 o[2] = {{}, {}};
    LAS const unsigned char* vb = lds + VOFF + ((lane >> 4) & 1) * 32 + (lane & 3) * 8 + (4 * hi + ((lane & 15) >> 2)) * 64;
#pragma unroll
    for (int j = 0; j < 5; ++j) {
        const int st = qh + j, jt = st >> 1, kh = st & 1;
#pragma unroll
        for (int s = 0; s < 2; ++s) { const bf16x8 pf = pack_step(p[j], s); const int ks = 2 * kh + s;
#pragma unroll
            for (int d0 = 0; d0 < 2; ++d0) { LAS const unsigned char* vp = vb + jt * 8192 + d0 * 4096 + ks * 1024; const bf16x8 vf = cat8(tr_rd(vp), tr_rd(vp + 512)); o[d0] = MFMA32(vf, pf, o[d0]); } }
    }
    bf16* op = OC + (rowb + 64 * i + 32 * qh + r32) * 1536 + hq * 64 + 4 * hi;
#pragma unroll
    for (int d0 = 0; d0 < 2; ++d0)
#pragma unroll
        for (int g = 0; g < 4; ++g) { u32x2 wv; wv.x = cvtpk(o[d0][4 * g] * inv, o[d0][4 * g + 1] * inv); wv.y = cvtpk(o[d0][4 * g + 2] * inv, o[d0][4 * g + 3] * inv); *(u32x2*)(op + 32 * d0 + 8 * g) = wv; }
    __syncthreads();
}
}

#ifndef G3SEC
#define G3SEC 0
#endif
__device__ __noinline__ void probe_fn(int mode);
#define SEC_B(k) do { if (G3SEC == (k) && blockIdx.x == 0) probe_fn(0); } while (0)
#define SEC_E(k) do { if (G3SEC == (k) && blockIdx.x == 0) probe_fn(1); } while (0)
namespace gla {
constexpr int PQ = 264, PK3 = 320, PV = 576, PA = 136;
constexpr int O_Q1 = 0, O_Q2 = 16896, O_K2 = 33792, O_K3 = 50688, O_V = 71168, O_A = 108032, O_GLR = 116736, O_TOT = 120832, O_DV = 124928, O_PART = 125440, LDS_NEED = 127488;
constexpr int O_WG = 131072 + 2048;
constexpr int NSEG = 32, CPS = 4, NUNITS = 8 * NSEG, SELEMS = 128 * 256, SPAIRS = SELEMS / 2;
__device__ __forceinline__ unsigned short f2bf(float f) { unsigned u = __builtin_bit_cast(unsigned, f); return (unsigned short)((u + 0x7fffu + ((u >> 16) & 1u)) >> 16); }
__device__ __forceinline__ float bf2f(unsigned short h) { return __builtin_bit_cast(float, (unsigned)h << 16); }
__device__ __forceinline__ float logsig(float x) { return fminf(x, 0.f) - __logf(1.f + __expf(-fabsf(x))); }

struct KgRegs { u32x4 q[2], k[2]; f32x4 g; };
struct VRegs { u32x4 v[4]; };
template <bool FULL> __device__ __forceinline__ void fetch_kg(KgRegs& R, const bf16* QB, const bf16* KB, const float* GLR, size_t r0, int h, int tid) {
#pragma unroll
    for (int i = 0; i < 2; ++i) { const int p = tid + 512 * i, row = p >> 4, c = p & 15;
        R.k[i] = *(const u32x4*)(KB + (r0 + row) * 512 + h * 128 + c * 8);
        if (FULL) R.q[i] = *(const u32x4*)(QB + (r0 + row) * 512 + h * 128 + c * 8); }
    R.g = (f32x4){0.f, 0.f, 0.f, 0.f};
    if (tid < 256) R.g = *(const f32x4*)(GLR + r0 * 16 + tid * 4);
}
__device__ __forceinline__ void fetch_v(VRegs& R, const bf16* VB, size_t r0, int h, int tid) {
#pragma unroll
    for (int i = 0; i < 4; ++i) { const int p = tid + 512 * i, row = p >> 5, c = p & 31; R.v[i] = *(const u32x4*)(VB + (r0 + row) * 1024 + h * 256 + c * 8); }
}
template <bool FULL> __device__ __forceinline__ void put_kg(const KgRegs& R, LAS unsigned char* lds, int tid) {
#pragma unroll
    for (int i = 0; i < 2; ++i) { const int p = tid + 512 * i, row = p >> 4, c = p & 15;
        LAS u32x2* kd = (LAS u32x2*)(lds + O_K2 + row * PQ + c * 16); kd[0] = (u32x2){R.k[i].x, R.k[i].y}; kd[1] = (u32x2){R.k[i].z, R.k[i].w};
        if (FULL) { LAS u32x2* qd = (LAS u32x2*)(lds + O_Q1 + row * PQ + c * 16); qd[0] = (u32x2){R.q[i].x, R.q[i].y}; qd[1] = (u32x2){R.q[i].z, R.q[i].w}; } }
    if (tid < 256) *(LAS f32x4*)(lds + O_GLR + tid * 16) = R.g;
}
__device__ __forceinline__ void put_v(const VRegs& R, LAS unsigned char* lds, int tid) {
#pragma unroll
    for (int i = 0; i < 4; ++i) { const int p = tid + 512 * i, row = p >> 5, c = p & 31; *(LAS u32x4*)(lds + O_V + row * PV + c * 16) = R.v[i]; }
}
__device__ __forceinline__ void load_wg(const float* wgate, const float* gbias, int h, LAS unsigned char* lds, int tid) {
    LAS float* W = (LAS float*)(lds + O_WG);
#pragma unroll
    for (int i = 0; i < 4; ++i) { const int e = tid + 512 * i, j = e >> 7, c = e & 127; W[e] = wgate[j * 512 + h * 128 + c]; }
    if (tid < 128) W[2048 + tid] = gbias[h * 128 + tid];
}
template <bool FULL> __device__ __forceinline__ void prep(LAS unsigned char* lds, int tid, float& blast0, float& blast1, unsigned* e1out = nullptr, float* ccout = nullptr) {
    const int cp = tid & 63, w = tid >> 6;
    __syncthreads();
    LAS const float* W = (LAS const float*)(lds + O_WG);
    float wa[16], wb[16];
#pragma unroll
    for (int j = 0; j < 16; ++j) { const f32x2_t t = *(LAS const f32x2_t*)(W + j * 128 + 2 * cp); wa[j] = t.x; wb[j] = t.y; }
    const f32x2_t bias = *(LAS const f32x2_t*)(W + 2048 + 2 * cp);
    float bl0[8], bl1[8]; float run0 = 0.f, run1 = 0.f;
#pragma unroll
    for (int i = 0; i < 8; ++i) { LAS const f32x4* g = (LAS const f32x4*)(lds + O_GLR + (8 * w + i) * 64); const f32x4 g0 = g[0], g1 = g[1], g2 = g[2], g3 = g[3];
        float x0 = bias.x, x1 = bias.y;
#pragma unroll
        for (int j = 0; j < 4; ++j) { x0 += g0[j] * wa[j]; x1 += g0[j] * wb[j]; }
#pragma unroll
        for (int j = 0; j < 4; ++j) { x0 += g1[j] * wa[4 + j]; x1 += g1[j] * wb[4 + j]; }
#pragma unroll
        for (int j = 0; j < 4; ++j) { x0 += g2[j] * wa[8 + j]; x1 += g2[j] * wb[8 + j]; }
#pragma unroll
        for (int j = 0; j < 4; ++j) { x0 += g3[j] * wa[12 + j]; x1 += g3[j] * wb[12 + j]; }
        run0 += logsig(x0) * 0.0625f; run1 += logsig(x1) * 0.0625f; bl0[i] = run0; bl1[i] = run1; }
    LAS f32x2_t* TOT = (LAS f32x2_t*)(lds + O_TOT);
    TOT[w * 64 + cp] = (f32x2_t){run0, run1};
    __syncthreads();
    float pre0 = 0.f, pre1 = 0.f, rr0 = 0.f, rr1 = 0.f, bt0 = 0.f, bt1 = 0.f;
#pragma unroll
    for (int g = 0; g < 8; ++g) { const f32x2_t t = TOT[g * 64 + cp]; if (g < w) { pre0 += t.x; pre1 += t.y; } if (g < 4) { rr0 += t.x; rr1 += t.y; } bt0 += t.x; bt1 += t.y; }
    const float c40 = __expf(bt0), c41 = __expf(bt1), c20 = __expf(-rr0), c21 = __expf(-rr1), c30 = __expf(rr0), c31 = __expf(rr1);
    if (!FULL && ccout && w == 0) { *(f32x4*)(ccout + cp * 8) = (f32x4){c20, c21, c30, c31}; *(f32x4*)(ccout + cp * 8 + 4) = (f32x4){c40, c41, 0.f, 0.f}; }
#pragma unroll
    for (int i = 0; i < 8; ++i) { const int t = 8 * w + i; const float e10 = __expf(pre0 + bl0[i]), e11 = __expf(pre1 + bl1[i]); const float i10 = __builtin_amdgcn_rcpf(e10), i11 = __builtin_amdgcn_rcpf(e11);
        if (!FULL && e1out) e1out[t * 64 + cp] = cvtpk(e10, e11);
        const unsigned kk = *(LAS const unsigned*)(lds + O_K2 + t * PQ + cp * 4); const float k0 = __builtin_bit_cast(float, kk << 16), k1 = __builtin_bit_cast(float, kk & 0xffff0000u);
        *(LAS unsigned*)(lds + O_K3 + t * PK3 + cp * 4) = cvtpk(k0 * (i10 * c40), k1 * (i11 * c41));
        if (FULL) { const unsigned qq = *(LAS const unsigned*)(lds + O_Q1 + t * PQ + cp * 4); const float q0 = __builtin_bit_cast(float, qq << 16), q1 = __builtin_bit_cast(float, qq & 0xffff0000u);
            *(LAS unsigned*)(lds + O_Q1 + t * PQ + cp * 4) = cvtpk(q0 * e10, q1 * e11);
            *(LAS unsigned*)(lds + O_Q2 + t * PQ + cp * 4) = cvtpk(q0 * (e10 * c20), q1 * (e11 * c21));
            *(LAS unsigned*)(lds + O_K2 + t * PQ + cp * 4) = cvtpk(k0 * (i10 * c30), k1 * (i11 * c31)); } }
    if (w == 7) *(LAS f32x2_t*)(lds + O_DV + cp * 8) = (f32x2_t){c40, c41};
    blast0 = bt0; blast1 = bt1;
}
__device__ __forceinline__ void prep_lite(LAS unsigned char* lds, int tid, const unsigned (&e1w)[8], const f32x4 ca, const f32x4 cb) {
    const int cp = tid & 63, w = tid >> 6;
    __syncthreads();
    const float c20 = ca[0], c21 = ca[1], c30 = ca[2], c31 = ca[3], c40 = cb[0], c41 = cb[1];
#pragma unroll
    for (int i = 0; i < 8; ++i) { const int t = 8 * w + i; const float e10 = __builtin_bit_cast(float, e1w[i] << 16), e11 = __builtin_bit_cast(float, e1w[i] & 0xffff0000u); const float i10 = __builtin_amdgcn_rcpf(e10), i11 = __builtin_amdgcn_rcpf(e11);
        const unsigned kk = *(LAS const unsigned*)(lds + O_K2 + t * PQ + cp * 4); const float k0 = __builtin_bit_cast(float, kk << 16), k1 = __builtin_bit_cast(float, kk & 0xffff0000u);
        const unsigned qq = *(LAS const unsigned*)(lds + O_Q1 + t * PQ + cp * 4); const float q0 = __builtin_bit_cast(float, qq << 16), q1 = __builtin_bit_cast(float, qq & 0xffff0000u);
        *(LAS unsigned*)(lds + O_K3 + t * PK3 + cp * 4) = cvtpk(k0 * (i10 * c40), k1 * (i11 * c41));
        *(LAS unsigned*)(lds + O_Q1 + t * PQ + cp * 4) = cvtpk(q0 * e10, q1 * e11);
        *(LAS unsigned*)(lds + O_Q2 + t * PQ + cp * 4) = cvtpk(q0 * (e10 * c20), q1 * (e11 * c21));
        *(LAS unsigned*)(lds + O_K2 + t * PQ + cp * 4) = cvtpk(k0 * (i10 * c30), k1 * (i11 * c31)); }
    if (w == 7) *(LAS f32x2_t*)(lds + O_DV + cp * 8) = (f32x2_t){c40, c41};
}
__device__ __forceinline__ void state_update(f32x16 (&S)[4], LAS unsigned char* lds, int w, int lane) {
    const int hi = lane >> 5, i16 = lane & 15, g16 = (lane >> 4) & 1;
    LAS const float* DVp = (LAS const float*)(lds + O_DV);
#pragma unroll
    for (int tile = 0; tile < 4; ++tile) {
#pragma unroll
        for (int r = 0; r < 16; ++r) S[tile][r] *= DVp[32 * tile + crow(r, hi)];
        asm volatile("" ::: "memory"); }
    LAS const unsigned char* vb = lds + O_V + (4 * hi + (i16 >> 2)) * PV + (32 * w + 16 * g16 + 4 * (i16 & 3)) * 2;
    LAS const unsigned char* kb = lds + O_K3 + (4 * hi + (i16 >> 2)) * PK3 + (16 * g16 + 4 * (i16 & 3)) * 2;
#pragma unroll
    for (int ks = 0; ks < 4; ++ks) { const bf16x8 vf = cat8(tr_rd(vb + ks * 16 * PV), tr_rd(vb + (ks * 16 + 8) * PV));
#pragma unroll
        for (int tile = 0; tile < 4; ++tile) { const bf16x8 kf = cat8(tr_rd(kb + ks * 16 * PK3 + tile * 64), tr_rd(kb + (ks * 16 + 8) * PK3 + tile * 64)); S[tile] = MFMA32(kf, vf, S[tile]); } }
}
struct Tensors { const bf16 *QB, *KB, *VB, *RB; bf16* OB; const float *GLR, *wgate, *gbias, *onorm; float *R, *SST, *DSEG; unsigned* E1; float* CC; };

__device__ __forceinline__ void g1_unit(int un, const Tensors& T, LAS unsigned char* lds, int tid) {
    const int lane = tid & 63, w = __builtin_amdgcn_readfirstlane(tid >> 6);
    const int chain = un >> 5, seg = un & 31, b = chain >> 2, h = chain & 3;
    const size_t rb = (size_t)b * SEQ + (size_t)(seg * CPS) * 64;
    KgRegs KG; fetch_kg<false>(KG, T.QB, T.KB, T.GLR, rb, h, tid);
    load_wg(T.wgate, T.gbias, h, lds, tid);
    f32x16 S[4] = {{}, {}, {}, {}}; float bs0 = 0.f, bs1 = 0.f;
#pragma unroll 1
    for (int c = 0; c < CPS; ++c) {
        int tl = tid; asm volatile("" : "+v"(tl));
        put_kg<false>(KG, lds, tl);
        VRegs VR; fetch_v(VR, T.VB, rb + (size_t)c * 64, h, tl);
        float b0, b1; prep<false>(lds, tid, b0, b1, T.E1 + (size_t)(un * CPS + c) * 4096, T.CC + (size_t)(un * CPS + c) * 512); bs0 += b0; bs1 += b1;
        if (c + 1 < CPS) fetch_kg<false>(KG, T.QB, T.KB, T.GLR, rb + (size_t)(c + 1) * 64, h, tl);
        put_v(VR, lds, tl);
        __syncthreads();
        state_update(S, lds, w, lane);
        __syncthreads();
    }
    unsigned* Rp = (unsigned*)T.R + (size_t)un * SPAIRS + tid;
#pragma unroll
    for (int tile = 0; tile < 4; ++tile)
#pragma unroll
        for (int r = 0; r < 16; r += 2) Rp[(tile * 8 + (r >> 1)) * 512] = cvtpk(S[tile][r], S[tile][r + 1]);
    if (tid >= 448) *(f32x2_t*)(T.DSEG + un * 128 + 2 * (tid & 63)) = (f32x2_t){__expf(bs0), __expf(bs1)};
}
__device__ __forceinline__ void g2_scan(const Tensors& T, int gtid, int gthreads) {
    for (int e = gtid; e < 8 * SPAIRS; e += gthreads) {
        const int chain = e / SPAIRS, idx = e % SPAIRS, k = idx >> 9, ln = idx & 63, reg = 2 * k;
        const int dk = 32 * (reg >> 4) + crow(reg & 15, ln >> 5);
        const unsigned* Rp = (const unsigned*)T.R + (size_t)chain * NSEG * SPAIRS + idx; unsigned* Sp = (unsigned*)T.SST + (size_t)chain * NSEG * SPAIRS + idx; const float* Dp = T.DSEG + chain * NSEG * 128 + dk;
        float sa = 0.f, sb = 0.f;
#pragma unroll 1
        for (int s0 = 0; s0 < NSEG; s0 += 16) { unsigned r[16]; f32x2_t d[16];
#pragma unroll
            for (int j = 0; j < 16; ++j) { r[j] = __builtin_nontemporal_load(Rp + (size_t)(s0 + j) * SPAIRS); d[j] = *(const f32x2_t*)(Dp + (s0 + j) * 128); }
#pragma unroll
            for (int j = 0; j < 16; ++j) { Sp[(size_t)(s0 + j) * SPAIRS] = cvtpk(sa, sb);
                sa = sa * d[j].x + __builtin_bit_cast(float, r[j] << 16); sb = sb * d[j].y + __builtin_bit_cast(float, r[j] & 0xffff0000u); } }
    }
}
__device__ __forceinline__ void g3_unit(int un, const Tensors& T, LAS unsigned char* lds, int tid) {
    const int lane = tid & 63, r32 = lane & 31, hi = lane >> 5, w = __builtin_amdgcn_readfirstlane(tid >> 6), i16 = lane & 15, g16 = (lane >> 4) & 1;
    const int chain = un >> 5, seg = un & 31, b = chain >> 2, h = chain & 3;
    const size_t rb = (size_t)b * SEQ + (size_t)(seg * CPS) * 64;
    f32x16 S[4];
    { const unsigned* Sp = (const unsigned*)T.SST + (size_t)un * SPAIRS + tid;
#pragma unroll
      for (int tile = 0; tile < 4; ++tile)
#pragma unroll
          for (int r = 0; r < 16; r += 2) { const unsigned w2 = Sp[(tile * 8 + (r >> 1)) * 512]; S[tile][r] = __builtin_bit_cast(float, w2 << 16); S[tile][r + 1] = __builtin_bit_cast(float, w2 & 0xffff0000u); } }
#pragma unroll 1
    for (int c = 0; c < CPS; ++c) {
        const size_t r0 = rb + (size_t)c * 64;
        int tl = tid; asm volatile("" : "+v"(tl));
        SEC_B(1);
        { KgRegs KG; VRegs VR; fetch_kg<true>(KG, T.QB, T.KB, T.GLR, r0, h, tl); fetch_v(VR, T.VB, r0, h, tl);
          unsigned e1w[8]; const unsigned* e1p = T.E1 + (size_t)(un * CPS + c) * 4096 + (tl >> 6) * 512 + (tl & 63);
#pragma unroll
          for (int i = 0; i < 8; ++i) e1w[i] = e1p[i * 64];
          const f32x4 ca = *(const f32x4*)(T.CC + (size_t)(un * CPS + c) * 512 + (tl & 63) * 8), cb = *(const f32x4*)(T.CC + (size_t)(un * CPS + c) * 512 + (tl & 63) * 8 + 4);
          put_kg<true>(KG, lds, tl);
          prep_lite(lds, tid, e1w, ca, cb);
          put_v(VR, lds, tl); }
        __syncthreads(); SEC_E(1); SEC_B(2);
        if (w < 3) { const int tt = (w >= 1), st = (w == 2); f32x16 d = {};
            LAS const unsigned char* kp = lds + O_K2 + (32 * st + r32) * PQ + 8 * hi; LAS const unsigned char* qp = lds + O_Q2 + (32 * tt + r32) * PQ + 8 * hi;
#pragma unroll
            for (int kc = 0; kc < 8; ++kc) d = MFMA32(row_frag(kp + kc * 32), row_frag(qp + kc * 32), d);
            const int t = 32 * tt + r32;
#pragma unroll
            for (int g = 0; g < 4; ++g) { const int s0 = 32 * st + 8 * g + 4 * hi; float v[4];
#pragma unroll
                for (int e = 0; e < 4; ++e) v[e] = (s0 + e <= t) ? d[4 * g + e] : 0.f;
                *(LAS u32x2*)(lds + O_A + t * PA + s0 * 2) = (u32x2){cvtpk(v[0], v[1]), cvtpk(v[2], v[3])}; } }
        f32x16 o[2] = {{}, {}};
#pragma unroll
        for (int tile = 0; tile < 4; ++tile)
#pragma unroll
            for (int s = 0; s < 2; ++s) { const bf16x8 sf = pack_step(S[tile], s);
#pragma unroll
                for (int tt = 0; tt < 2; ++tt) o[tt] = MFMA32(sf, row_frag(lds + O_Q1 + (32 * tt + r32) * PQ + (32 * tile + 16 * s + 4 * hi) * 2), o[tt]); }
        __syncthreads();
        SEC_E(2); SEC_B(3);
        u32x2 rrv[2][4];
#pragma unroll
        for (int tt = 0; tt < 2; ++tt)
#pragma unroll
            for (int g = 0; g < 4; ++g) rrv[tt][g] = *(const u32x2*)(T.RB + (r0 + 32 * tt + r32) * 1024 + h * 256 + 32 * w + 4 * hi + 8 * g);
        LAS const unsigned char* vb = lds + O_V + (4 * hi + (i16 >> 2)) * PV + (32 * w + 16 * g16 + 4 * (i16 & 3)) * 2;
#pragma unroll
        for (int ks = 0; ks < 4; ++ks) { const bf16x8 vf = cat8(tr_rd(vb + ks * 16 * PV), tr_rd(vb + (ks * 16 + 8) * PV));
            if (ks < 2) o[0] = MFMA32(vf, row_frag(lds + O_A + r32 * PA + (16 * ks + 4 * hi) * 2), o[0]);
            o[1] = MFMA32(vf, row_frag(lds + O_A + (32 + r32) * PA + (16 * ks + 4 * hi) * 2), o[1]); }
        state_update(S, lds, w, lane);
        SEC_E(3); SEC_B(4);
        LAS float* PART = (LAS float*)(lds + O_PART);
        f32x4 gn4[4];
#pragma unroll
        for (int g = 0; g < 4; ++g) gn4[g] = *(const f32x4*)(T.onorm + h * 256 + 32 * w + 8 * g + 4 * hi);
#pragma unroll
        for (int tt = 0; tt < 2; ++tt) { float ss = 0.f;
#pragma unroll
            for (int r = 0; r < 16; ++r) ss += o[tt][r] * o[tt][r];
            ss += __shfl_xor(ss, 32); if (hi == 0) PART[w * 64 + 32 * tt + r32] = ss; }
        __syncthreads();
#pragma unroll
        for (int tt = 0; tt < 2; ++tt) { const int t = 32 * tt + r32; float tot = 0.f;
#pragma unroll
            for (int ww = 0; ww < 8; ++ww) tot += PART[ww * 64 + t];
            const float rstd = __builtin_amdgcn_rsqf(tot * (1.0f / 256.0f) + 1e-6f);
            const size_t obase = (r0 + t) * 1536 + 512 + h * 256 + 32 * w + 4 * hi;
#pragma unroll
            for (int g = 0; g < 4; ++g) { const u32x2 rr = rrv[tt][g];
                const float v0 = o[tt][4 * g] * rstd * gn4[g][0] * __builtin_bit_cast(float, rr.x << 16), v1 = o[tt][4 * g + 1] * rstd * gn4[g][1] * __builtin_bit_cast(float, rr.x & 0xffff0000u);
                const float v2 = o[tt][4 * g + 2] * rstd * gn4[g][2] * __builtin_bit_cast(float, rr.y << 16), v3 = o[tt][4 * g + 3] * rstd * gn4[g][3] * __builtin_bit_cast(float, rr.y & 0xffff0000u);
                *(u32x2*)(T.OB + obase + 8 * g) = (u32x2){cvtpk(v0, v1), cvtpk(v2, v3)}; } }
        __syncthreads();
        SEC_E(4);
    }
}
}
#define CAS __attribute__((address_space(4)))

constexpr size_t MiB = 1u << 20;
constexpr size_t WS_CTL = 0, CTL_ZERO_BYTES = 1 * MiB;
constexpr size_t WS_ROPEC = 1 * MiB, WS_ROPES = 2 * MiB;
constexpr size_t WS_STATS = 3 * MiB;
constexpr size_t WS_GLR = 4 * MiB;
constexpr size_t WS_DSEG = 5 * MiB;
constexpr size_t WS_W = 6 * MiB;
constexpr size_t WS_XB = 108 * MiB;
constexpr size_t WS_ZH = 140 * MiB;
constexpr size_t Z_QA = WS_ZH, Z_KA = WS_ZH + 16 * MiB, Z_VA = WS_ZH + 20 * MiB, Z_QB = WS_ZH + 24 * MiB, Z_KB = WS_ZH + 40 * MiB, Z_VB = WS_ZH + 56 * MiB, Z_RB = WS_ZH + 88 * MiB, Z_GA = WS_ZH + 120 * MiB, Z_GB = WS_ZH + 152 * MiB;
constexpr size_t WS_R = 324 * MiB, WS_SST = 356 * MiB;
constexpr size_t WS_E1 = WS_R + 16 * MiB, WS_CC = WS_SST + 16 * MiB;
constexpr size_t WS_OC = 388 * MiB, WS_END = 436 * MiB;
constexpr int CW_BAR = 4096;
constexpr int RING_BYTES = 131072, MISC_OFF = RING_BYTES + 320, RSTD_OFF = RING_BYTES + 1024, LDS_BYTES = 147456;
static_assert(pg8::EPI_ROPEC == WS_ROPEC && pg8::EPI_ROPES == WS_ROPES && pg8::EPI_STATS == WS_STATS && pg8::EPI_GLR == WS_GLR && pg8::EPI_QA == Z_QA && pg8::EPI_KA == Z_KA && pg8::EPI_VA == Z_VA && pg8::EPI_QB == Z_QB && pg8::EPI_KB == Z_KB && pg8::EPI_VB == Z_VB && pg8::EPI_RB == Z_RB && pg8::EPI_GA == Z_GA && pg8::EPI_GB == Z_GB, "w_in epilogue offsets match the workspace map");
static_assert(gla::O_WG >= RSTD_OFF + 1024 && gla::O_WG + 8704 <= LDS_BYTES, "gate-weight table above the ring");
static_assert(swa::LDS_NEED <= RING_BYTES && gla::LDS_NEED <= RING_BYTES, "phase scratch fits the ring region");

__device__ __forceinline__ void conv_item64(const float* W, int ldw, int c0a, int nva, int c0b, int nvb, const float* gain, int k0, bf16* WT, int drow0, int K, int kdst, LAS unsigned char* scr, int lane) {
    const int r = lane >> 4, c = lane & 15;
    const int col = (c < 8) ? c0a + 4 * c : c0b + 4 * (c - 8); const bool ok = (c < 8) ? (4 * c < nva) : (4 * (c - 8) < nvb);
    f32x4 v[16];
#pragma unroll
    for (int i = 0; i < 16; ++i) v[i] = ok ? __builtin_nontemporal_load((const f32x4*)(W + (size_t)(k0 + 4 * i + r) * ldw + col)) : (f32x4){0.f, 0.f, 0.f, 0.f};
    if (gain) {
#pragma unroll
        for (int i = 0; i < 16; ++i) v[i] = v[i] * gain[k0 + 4 * i + r]; }
#pragma unroll
    for (int i = 0; i < 16; ++i) *(LAS u32x2*)(scr + (4 * i + r) * 160 + c * 8) = (u32x2){cvtpk(v[i].x, v[i].y), cvtpk(v[i].z, v[i].w)};
    const int i16 = lane & 15, q = i16 >> 2, pp = i16 & 3;
#pragma unroll
    for (int nb = 0; nb < 4; ++nb)
#pragma unroll
        for (int kb = 0; kb < 4; ++kb) { const s16x4 t = tr_rd(scr + (16 * kb + 4 * r + q) * 160 + (16 * nb + 4 * pp) * 2);
            *(s16x4*)(WT + (size_t)(drow0 + 16 * nb + i16) * K + kdst + 16 * kb + 4 * r) = t; }
}
constexpr size_t W_GU1 = 0, W_D1 = 11 * MiB, W_IN = 17 * MiB, W_PA = 29 * MiB, W_PB = 30 * MiB, W_OUT = 32 * MiB, W_GU2 = 34 * MiB, W_D2 = 45 * MiB, W_SET = 51 * MiB;
constexpr int CI_GU = 16 * 88, CI_D = 44 * 16, CI_IN = 16 * 96, CI_PA = 8 * 16, CI_PB = 16 * 16, CI_OUT = 16 * 16, CI_ALL = 2 * CI_GU + 2 * CI_D + CI_IN + CI_PA + CI_PB + CI_OUT;
__device__ __forceinline__ void conv_run(const float* const CAS* in, int l, unsigned char* wset, int it_lo, int it_hi, int widx, int nworkers, LAS unsigned char* scr, int lane) {
    for (int it = it_lo + widx; it < it_hi; it += nworkers) {
        int r = it;
        if (r < 2 * CI_GU) { const int second = r >= CI_GU; r -= second * CI_GU; const int kb = r / 88, dg = 2 * (r % 88), tile = dg >> 3, bj = (dg >> 2) & 1, wc = dg & 3;
            const float* src = in[(second ? 17 : 2) + bj] + (size_t)l * DM * FF; const int c0 = 128 * tile + 32 * wc;
            conv_item64(src, FF, c0, 32, c0 + 32, 32, in[second ? 16 : 1] + (size_t)l * DM, 64 * kb, (bf16*)(wset + (second ? W_GU2 : W_GU1)), 32 * dg, DM, 64 * kb, scr, lane); continue; }
        r -= 2 * CI_GU;
        if (r < 2 * CI_D) { const int second = r >= CI_D; r -= second * CI_D; const int kb = r / 16, pr = r % 16;
            conv_item64(in[second ? 19 : 4] + (size_t)l * FF * DM, DM, 64 * pr, 32, 64 * pr + 32, 32, nullptr, 64 * kb, (bf16*)(wset + (second ? W_D2 : W_D1)), 64 * pr, FF, 64 * kb, scr, lane); continue; }
        r -= 2 * CI_D;
        if (r < CI_IN) { const int kb = r / 96, dg = 2 * (r % 96), tile = dg >> 3, bj = (dg >> 2) & 1, wc = dg & 3; int ca, cb, na = 32, nb = 32;
            if (tile < 2) { ca = 64 * (4 * tile + wc) + 32 * bj; cb = ca + 64; }
            else if (tile == 2) { ca = (wc < 2 ? 512 : 640) + 32 * bj; cb = ca + 64; }
            else if (tile < 15) { ca = 32 * dg; cb = ca + 32; }
            else if (tile < 23) { ca = 32 * dg + 16; cb = ca + 32; }
            else { ca = 3840; cb = 3840; na = (dg == 184) ? 16 : 0; nb = 0; }
            conv_item64(in[6] + (size_t)l * DM * IN_COLS, IN_COLS, ca, na, cb, nb, in[5] + (size_t)l * DM, 64 * kb, (bf16*)(wset + W_IN), 32 * dg, DM, 64 * kb, scr, lane); continue; }
        r -= CI_IN;
        if (r < CI_PA) { const int kb = r / 16, pr = r % 16; conv_item64(in[13] + (size_t)l * QAW * DM, DM, 64 * pr, 32, 64 * pr + 32, 32, nullptr, 64 * kb, (bf16*)(wset + W_PA), 64 * pr, QAW + GVW, 64 * kb, scr, lane); continue; }
        r -= CI_PA;
        if (r < CI_PB) { const int kb = r / 16, pr = r % 16; conv_item64(in[14] + (size_t)l * GVW * DM, DM, 64 * pr, 32, 64 * pr + 32, 32, nullptr, 64 * kb, (bf16*)(wset + W_PA), 64 * pr, QAW + GVW, QAW + 64 * kb, scr, lane); continue; }
        r -= CI_PB;
        { const int kb = r / 16, pr = r % 16; conv_item64(in[15] + (size_t)l * DM * DM, DM, 64 * pr, 32, 64 * pr + 32, 32, nullptr, 64 * kb, (bf16*)(wset + W_OUT), 64 * pr, DM, 64 * kb, scr, lane); }
    }
}
__device__ __forceinline__ float wave_sum(float v) {
#pragma unroll
    for (int o = 1; o < 64; o <<= 1) v += __shfl_xor(v, o);
    return v;
}
__device__ __forceinline__ void prologue_phase(const float* x, bf16* XB, float* stats, float* ropec, float* ropes, const float CAS* invf, int gw, int ngw, int lane, int gtid, int gthreads) {
    for (int m0 = gw * 2; m0 < M; m0 += ngw * 2) {
        f32x4 v[2][4];
#pragma unroll
        for (int rr = 0; rr < 2; ++rr) { const f32x4* xr = (const f32x4*)(x + (size_t)(m0 + rr) * DM) + lane;
#pragma unroll
            for (int j = 0; j < 4; ++j) v[rr][j] = __builtin_nontemporal_load(xr + 64 * j); }
        asm volatile("" ::: "memory");
#pragma unroll
        for (int rr = 0; rr < 2; ++rr) { const int m = m0 + rr; unsigned long long* o8 = (unsigned long long*)(XB + (size_t)m * DM) + lane; float s = 0.f;
#pragma unroll
            for (int j = 0; j < 4; ++j) { const f32x4 w = v[rr][j]; s += (w.x * w.x + w.y * w.y) + (w.z * w.z + w.w * w.w);
                o8[64 * j] = (unsigned long long)pk2(w.x, w.y) | ((unsigned long long)pk2(w.z, w.w) << 32); }
            s = wave_sum(s);
            if (lane < 16) stats[(size_t)m * 16 + lane] = (lane == 0) ? s : 0.f; }
    }
    for (int e = gtid; e < SEQ * 32; e += gthreads) { const int t = e >> 5, i = e & 31;
        const float ang = (float)t * invf[i];
        const double a = (double)ang, q = __builtin_rint(a * 0.63661977236758134308), r = __builtin_fma(-q, 6.123233995736766036e-17, __builtin_fma(-q, 1.57079632679489655800, a)), r2 = r * r;
        const double sn = r * (1.0 - r2 / 6.0 * (1.0 - r2 / 20.0 * (1.0 - r2 / 42.0 * (1.0 - r2 / 72.0 * (1.0 - r2 / 110.0 * (1.0 - r2 / 156.0 * (1.0 - r2 / 210.0 * (1.0 - r2 / 272.0))))))));
        const double cs = 1.0 - r2 / 2.0 * (1.0 - r2 / 12.0 * (1.0 - r2 / 30.0 * (1.0 - r2 / 56.0 * (1.0 - r2 / 90.0 * (1.0 - r2 / 132.0 * (1.0 - r2 / 182.0 * (1.0 - r2 / 240.0)))))));
        const int qi = (int)q & 3;
        const double c = (qi == 0) ? cs : (qi == 1) ? -sn : (qi == 2) ? -cs : sn, s_ = (qi == 0) ? sn : (qi == 1) ? cs : (qi == 2) ? -sn : -cs;
        ropec[e] = (float)c; ropes[e] = (float)s_; }
}

__device__ __forceinline__ void panel_rstd(const float* stats, int pm, LAS float* tab, int tid) {
    if (tid < 256) { const f32x4* p = (const f32x4*)(stats + (size_t)(pm * 256 + tid) * 16); const f32x4 t = (p[0] + p[1]) + (p[2] + p[3]);
        tab[tid] = __builtin_amdgcn_rsqf(((t[0] + t[1]) + (t[2] + t[3])) * (1.0f / 1024.0f) + 1e-6f); }
    __syncthreads();
}
struct Args { const float* in[20]; float* out; unsigned char* ws; float invf[32]; int s_lo, s_hi, ph_lo, ph_hi, do_pro, pad; };
enum { PH_CONV = 0, PH_GU = 1, PH_DN = 2, PH_IN = 3, PH_X1 = 4, PH_SCAN = 5, PH_G3 = 6, PH_PROJ = 7, PH_OUT = 8, N_PH = 9 };
#ifndef PHMASK
#define PHMASK 0x3ff
#endif
#define P_WSET(layer) (ws + WS_W + (size_t)((layer) & 1) * W_SET)
#define P_X     (ap->out)
#define P_XB    ((bf16*)(ws + WS_XB))
#define P_STATS ((float*)(ws + WS_STATS))
#define P_HID   ((bf16*)(ws + WS_ZH))
#define P_QA    ((bf16*)(ws + Z_QA))
#define P_KA    ((bf16*)(ws + Z_KA))
#define P_VA    ((bf16*)(ws + Z_VA))
#define P_QB    ((bf16*)(ws + Z_QB))
#define P_KB    ((bf16*)(ws + Z_KB))
#define P_VB    ((bf16*)(ws + Z_VB))
#define P_RB    ((bf16*)(ws + Z_RB))
#define P_GA    ((bf16*)(ws + Z_GA))
#define P_GB    ((bf16*)(ws + Z_GB))
#define P_GLR   ((float*)(ws + WS_GLR))
#define P_OC    ((bf16*)(ws + WS_OC))
#define P_ROPEC ((float*)(ws + WS_ROPEC))
#define P_ROPES ((float*)(ws + WS_ROPES))
#define PHASE_WS() const CAS Args* ap = (const CAS Args*)__builtin_amdgcn_kernarg_segment_ptr(); asm volatile("" : "+s"(ap)); unsigned char* ws = ap->ws; (void)ws; int bxl = bx, Gl = G; asm volatile("" : "+s"(bxl), "+s"(Gl)); (void)bxl; (void)Gl
#define PHASE_IDS() PHASE_WS(); int tid = tid0; asm volatile("" : "+v"(tid)); const int lane = tid & 63, wave = __builtin_amdgcn_readfirstlane(tid >> 6); const int gw = vcu * 8 + wave, gtid = vcu * 512 + tid; (void)lane; (void)gw; (void)gtid
#define GLA_TENSORS() gla::Tensors GT{P_QB, P_KB, P_VB, P_RB, P_OC, P_GLR, ap->in[10] + (size_t)l * 16 * GKW, ap->in[11] + (size_t)l * GKW, ap->in[12] + (size_t)l * GVW, (float*)(ws + WS_R), (float*)(ws + WS_SST), (float*)(ws + WS_DSEG), (unsigned*)(ws + WS_E1), (float*)(ws + WS_CC)}
#ifndef PROBE_MASK
#define PROBE_MASK 0
#endif
#define PB(k) do { if (PROBE_MASK && ((PROBE_MASK >> (k)) & 1) && bx == 0) probe_fn(0); } while (0)
#define PE(k) do { if (PROBE_MASK && ((PROBE_MASK >> (k)) & 1) && bx == 0) probe_fn(1); } while (0)
#ifndef PROBE_AMP
#define PROBE_AMP 4
#endif
__device__ __noinline__ void probe_fn(int mode) {
    volatile LAS unsigned* Mw = (volatile LAS unsigned*)(uintptr_t)(MISC_OFF);
    if (threadIdx.x != 0) return;
    const unsigned long long now = __builtin_amdgcn_s_memrealtime();
    if (mode == 0) { Mw[16] = (unsigned)now; Mw[17] = (unsigned)(now >> 32); }
    else if (mode == 1) { const unsigned long long a_ = (((unsigned long long)Mw[19] << 32) | Mw[18]) + (now - (((unsigned long long)Mw[17] << 32) | Mw[16])); Mw[18] = (unsigned)a_; Mw[19] = (unsigned)(a_ >> 32); }
    else { const unsigned long long end_ = now + (unsigned long long)PROBE_AMP * (((unsigned long long)Mw[19] << 32) | Mw[18]); while (__builtin_amdgcn_s_memrealtime() < end_) __builtin_amdgcn_s_sleep(16); }
}
__global__ void __launch_bounds__(512, 2) mega_fwd(Args args) {
    extern __shared__ __attribute__((aligned(16))) unsigned char lds_raw[];
    LAS unsigned char* lds = (LAS unsigned char*)lds_raw;
    volatile LAS unsigned* MISC = (volatile LAS unsigned*)(lds + MISC_OFF);
    const int tid0 = threadIdx.x;
    const int G = gridDim.x, bx = blockIdx.x, vcu = (G % 8 == 0) ? (bx % 8) * (G / 8) + bx / 8 : bx;
    const int ngw = G * 8, gthreads = G * 512;
    for (int u = tid0; u < (LDS_BYTES - RING_BYTES) / 4; u += 512) ((LAS unsigned*)(lds + RING_BYTES))[u] = 0u;
    __syncthreads();
#if !MULTI
    XcdBarrier bar = xcd_barrier_post((unsigned*)(args.ws + WS_CTL) + CW_BAR, MISC + 8);
#define GRID_BAR() do { SEC_B(7); xcd_barrier(bar); SEC_E(7); } while (0)
#else
    (void)MISC;
#define GRID_BAR() do { } while (0)
#endif
    if (((PHMASK >> 9) & 1) && (!MULTI || args.do_pro)) {
        PB(9); PHASE_IDS(); prologue_phase(ap->in[0], P_XB, P_STATS, P_ROPEC, P_ROPES, ap->invf, gw, ngw, lane, gtid, gthreads);
        conv_run(ap->in, 0, P_WSET(0), 0, CI_ALL, gw, ngw, lds + wave * 16384, lane);
        GRID_BAR(); PE(9);
    }
#if MULTI
    const int lo = args.ph_lo, hi = args.ph_hi, s_lo = args.s_lo, s_hi = args.s_hi;
#define IN(k) (((PHMASK >> (k)) & 1) && lo <= (k) && (k) < hi)
#else
    constexpr int s_lo = 0, s_hi = 2 * DEPTH;
#define IN(k) ((PHMASK >> (k)) & 1)
#endif
    for (int st = s_lo; st < s_hi; ++st) {
        const int l = st >> 1, odd = st & 1;
        if (IN(PH_GU)) { PB(PH_GU); PHASE_WS();
            pg8::Gemm g{P_XB, (const bf16*)(P_WSET(l) + (odd ? W_GU2 : W_GU1)), M, NGU, DM}; pg8::StaticOrder S; S.init(M, NGU, Gl, bxl);
            { pg8::Unit u0; S.next(0, u0); panel_rstd(P_STATS, u0.pm, (LAS float*)(lds + RSTD_OFF), tid0); }
            pg8::EpiGU E{P_HID, (const LAS float*)(lds + RSTD_OFF)};
            pg8::gemm_phase<pg8::EpiGU, pg8::StaticOrder, true, true>(lds, g, S, E);
            if (((PHMASK >> PH_CONV) & 1) && l + 1 < DEPTH) {
                constexpr int NU = (M / 256) * (NGU / 256); const int rounds = (NU + Gl - 1) / Gl, nshort = rounds * Gl - NU, first = nshort ? Gl - nshort : 0, nw = nshort ? nshort : Gl;
                if (bxl >= first) { int tid = tid0; asm volatile("" : "+v"(tid)); const int lane = tid & 63, wave = __builtin_amdgcn_readfirstlane(tid >> 6); __syncthreads(); conv_run(ap->in, l + 1, P_WSET(l + 1), odd ? CI_ALL / 2 : 0, odd ? CI_ALL : CI_ALL / 2, (bxl - first) * 8 + wave, nw * 8, lds + wave * 16384, lane); }
            }
            GRID_BAR(); PE(PH_GU);
        }
        if (IN(PH_DN)) { PB(PH_DN); PHASE_WS();
            pg8::Gemm g{P_HID, (const bf16*)(P_WSET(l) + (odd ? W_D2 : W_D1)), M, DM, FF}; pg8::StaticOrder S; S.init(M, DM, Gl, bxl);
            pg8::EpiRes E{st == 0 ? ap->in[0] : (const float*)P_X, P_X, P_XB, P_STATS, 0.5f};
            pg8::gemm_phase<pg8::EpiRes, pg8::StaticOrder, false, true>(lds, g, S, E);
            if (MULTI || st + 1 < s_hi) GRID_BAR();
            PE(PH_DN);
        }
        if (!odd) {
            if (IN(PH_IN)) { PB(PH_IN); PHASE_WS();
                pg8::Gemm g{P_XB, (const bf16*)(P_WSET(l) + W_IN), M, NIN, DM}; pg8::StaticOrder S; S.init(M, NIN, Gl, bxl);
                { pg8::Unit u0; S.next(0, u0); panel_rstd(P_STATS, u0.pm, (LAS float*)(lds + RSTD_OFF), tid0); }
                pg8::EpiIn E{ws, ap->in[7] + l * 64, ap->in[8] + l * 64, (const LAS float*)(lds + RSTD_OFF)};
                pg8::gemm_phase<pg8::EpiIn, pg8::StaticOrder, true, true>(lds, g, S, E);
                GRID_BAR(); PE(PH_IN);
            }
            if (IN(PH_X1)) { PB(PH_X1);
                SEC_B(5); { PHASE_IDS(); GLA_TENSORS(); for (int un = vcu; un < gla::NUNITS; un += G) gla::g1_unit(un, GT, lds, tid); } SEC_E(5);
                GRID_BAR(); PE(PH_X1);
            }
            if (IN(PH_SCAN)) { PB(PH_SCAN);
                { PHASE_IDS(); GLA_TENSORS(); gla::g2_scan(GT, gtid, gthreads); }
                SEC_B(6); { PHASE_IDS(); for (int un = vcu; un < swa::NUNITS; un += G) swa::unit(un, P_QA, P_KA, P_VA, P_OC, ap->in[9] + l * 8, lds, tid); } SEC_E(6);
                GRID_BAR(); PE(PH_SCAN);
            }
            if (IN(PH_G3)) { PB(PH_G3); PHASE_IDS(); GLA_TENSORS(); for (int un = vcu; un < gla::NUNITS; un += G) gla::g3_unit(un, GT, lds, tid); GRID_BAR(); PE(PH_G3); }
            if (IN(PH_PROJ)) { PB(PH_PROJ); PHASE_WS();
                pg8::Gemm g{P_OC, (const bf16*)(P_WSET(l) + W_PA), M, DM, QAW + GVW}; pg8::StaticOrder S; S.init(M, DM, Gl, bxl); pg8::EpiPF E{P_GA, P_GB};
                pg8::gemm_phase<pg8::EpiPF, pg8::StaticOrder, false, true>(lds, g, S, E);
                GRID_BAR(); PE(PH_PROJ);
            }
            if (IN(PH_OUT)) { PB(PH_OUT); PHASE_WS();
                pg8::Gemm g{P_GA, (const bf16*)(P_WSET(l) + W_OUT), M, DM, DM}; pg8::StaticOrder S; S.init(M, DM, Gl, bxl);
                pg8::EpiRes E{P_X, P_X, P_XB, P_STATS, 1.0f};
                pg8::gemm_phase<pg8::EpiRes, pg8::StaticOrder, false, true>(lds, g, S, E);
                GRID_BAR(); PE(PH_OUT);
            }
        }
    }
#ifdef EXTRA_BARS
    for (int i_ = 0; i_ < EXTRA_BARS; ++i_) xcd_barrier(bar);
#endif
    if (PROBE_MASK && bx == 0) probe_fn(2);
#undef IN
}
constexpr size_t WS_DBG_END = WS_END;
constexpr size_t WS_NEED = (DBG ? WS_DBG_END : WS_END);

extern "C" void kernel_launch(void* const* d_in, const int* in_sizes, int n_in, void* d_out, int out_size, void* d_ws, size_t ws_size, hipStream_t stream) {
    static int grid = 0;
    if (grid == 0) {
        if (n_in != 20 || in_sizes[0] != M * DM || out_size != M * DM || ws_size < WS_NEED) {
            fprintf(stderr, "kernel_launch: built for 20 inputs, x/out of %d floats, >= %zu bytes of workspace; got n_in %d, in0 %d, out %d, ws %zu; nothing launched\n", M * DM, (size_t)WS_NEED, n_in, n_in > 0 ? in_sizes[0] : -1, out_size, ws_size); grid = -1; return; }
        int dev = 0, cus = 0, per_cu = 0;
        if (hipGetDevice(&dev) != hipSuccess || hipDeviceGetAttribute(&cus, hipDeviceAttributeMultiprocessorCount, dev) != hipSuccess) { fprintf(stderr, "kernel_launch: device query failed\n"); grid = -1; return; }
        if (hipFuncSetAttribute((const void*)mega_fwd, hipFuncAttributeMaxDynamicSharedMemorySize, LDS_BYTES) != hipSuccess) { fprintf(stderr, "kernel_launch: hipFuncSetAttribute failed\n"); grid = -1; return; }
        if (hipOccupancyMaxActiveBlocksPerMultiprocessor(&per_cu, (const void*)mega_fwd, 512, LDS_BYTES) != hipSuccess || per_cu < 1)
            fprintf(stderr, "kernel_launch: note: occupancy query reports %d workgroups per CU\n", per_cu);
        (void)hipGetLastError();
        grid = cus;
        if (grid != 256) { fprintf(stderr, "kernel_launch: built for a 256-CU device (one workgroup per CU, one row panel per workgroup in the GEMM phases); found %d CUs; nothing launched\n", cus); grid = -1; return; }
    }
    if (grid < 0) return;
    if (hipMemsetAsync((char*)d_ws + WS_CTL, 0, CTL_ZERO_BYTES, stream) != hipSuccess) { fprintf(stderr, "kernel_launch: memset failed\n"); return; }
    Args a{};
    for (int i = 0; i < 20; ++i) a.in[i] = (const float*)d_in[i];
    a.out = (float*)d_out; a.ws = (unsigned char*)d_ws;
    for (int i = 0; i < 32; ++i) a.invf[i] = (float)pow(10000.0, -(double)(2 * i) / 64.0);
#if !MULTI
    a.s_lo = 0; a.s_hi = 2 * DEPTH; a.ph_lo = 0; a.ph_hi = N_PH; a.do_pro = 1;
    hipLaunchKernelGGL(mega_fwd, dim3(grid), dim3(512), LDS_BYTES, stream, a);
#else
    a.s_lo = 0; a.s_hi = 0; a.ph_lo = 0; a.ph_hi = 0; a.do_pro = 1;
    hipLaunchKernelGGL(mega_fwd, dim3(grid), dim3(512), LDS_BYTES, stream, a);
    a.do_pro = 0;
    for (int st = 0; st < 2 * DEPTH; ++st)
        for (int ph = 0; ph < N_PH; ++ph) {
            if (ph == PH_CONV || ((st & 1) && ph >= PH_IN)) continue;
            a.s_lo = st; a.s_hi = st + 1; a.ph_lo = ph; a.ph_hi = ph + 1;
            hipLaunchKernelGGL(mega_fwd, dim3(grid), dim3(512), LDS_BYTES, stream, a);
        }
#endif
    const hipError_t le = hipPeekAtLastError();
    if (le != hipSuccess) fprintf(stderr, "kernel_launch: launch failed: %s (grid %d)\n", hipGetErrorName(le), grid);
}
```
